# Optimizing an MI355X kernel written in HIP

```python
import math
import jax, jax.numpy as jnp
from jax import lax
import numpy as np

D_MODEL = 1024
BATCH = 2
SEQ = 8192
DEPTH = 1
DEC_BATCH = 128
DEC_SEQ = 8
PAST_LEN = 2048
PAGE_SIZE = 128

D_ATTN = D_MODEL // 2
D_HGRN = D_MODEL - D_ATTN
D_MIX = D_ATTN + D_HGRN
A_HEADS = 4
A_DV = D_ATTN // A_HEADS
A_DQK = A_DV // 2
ROT_DIM = A_DQK // 4
ROPE_THETA = 500000.0
H_HEADS = 4
H_DK = D_HGRN // H_HEADS
H_DV = D_HGRN // H_HEADS
HGRN_CHUNK = 64
Q_BLOCK = 128
EPS = 1e-6

kernel_name = "hymba_diffattn_hgrn2_step"


def _split_points():
    sizes = [A_HEADS * 2 * A_DQK, A_HEADS * 2 * A_DQK, A_HEADS * A_DV, D_ATTN,
             H_HEADS * H_DK, H_HEADS * H_DK, H_HEADS * H_DV, D_HGRN]
    return [int(c) for c in np.cumsum(sizes)[:-1]]


def _rms_norm(x, g):
    xf = x.astype(jnp.float32)
    y = xf * lax.rsqrt(jnp.mean(xf * xf, axis=-1, keepdims=True) + EPS)
    return (y * g.astype(jnp.float32)).astype(x.dtype)


def _rope(x, pos):
    inv = ROPE_THETA ** (-jnp.arange(0, ROT_DIM, 2, dtype=jnp.float32) / ROT_DIM)
    ang = pos.astype(jnp.float32)[:, None] * inv[None, :]
    cos = jnp.cos(ang)[None, :, None, None, :]
    sin = jnp.sin(ang)[None, :, None, None, :]
    xf = x.astype(jnp.float32)
    half = ROT_DIM // 2
    x1, x2 = xf[..., :half], xf[..., half:ROT_DIM]
    out = jnp.concatenate([x1 * cos - x2 * sin, x2 * cos + x1 * sin, xf[..., ROT_DIM:]], axis=-1)
    return out.astype(x.dtype)


def _mixer_inputs(x, pos, norm_g, w_in, q_norm_g, k_norm_g, lb):
    B, T, _ = x.shape
    h = _rms_norm(x, norm_g)
    aq, ak, av, ag, hq, hf, hi, hg = jnp.split(h @ w_in, _split_points(), axis=-1)
    aq = _rope(_rms_norm(aq.reshape(B, T, A_HEADS, 2, A_DQK), q_norm_g), pos)
    ak = _rope(_rms_norm(ak.reshape(B, T, A_HEADS, 2, A_DQK), k_norm_g), pos)
    av = av.reshape(B, T, A_HEADS, A_DV)
    hq = jax.nn.silu(hq).reshape(B, T, H_HEADS, H_DK)
    f = lb + (1.0 - lb) * jax.nn.sigmoid(hf.astype(jnp.float32))
    logf = jnp.log(f).reshape(B, T, H_HEADS, H_DK)
    hk = (1.0 - f).reshape(B, T, H_HEADS, H_DK)
    hi = hi.reshape(B, T, H_HEADS, H_DV)
    return aq, ak, av, ag, hq, hk, logf, hi, hg


def _diff_attend(q, k, v, q_pos, k_pos, lam):
    s = jnp.einsum('bqhmd,bshmd->bhmqs', q.astype(jnp.float32), k.astype(jnp.float32)) * (A_DQK ** -0.5)
    mask = k_pos[None, :] <= q_pos[:, None]
    s = jnp.where(mask, s, -jnp.inf)
    p = jax.nn.softmax(s, axis=-1)
    w = p[:, :, 0] - lam * p[:, :, 1]
    return jnp.einsum('bhqs,bshd->bqhd', w, v.astype(jnp.float32))


def _prompt_attend(q, k, v, pos, lam):
    B, T = q.shape[:2]
    nb = T // Q_BLOCK
    qb = q.reshape(B, nb, Q_BLOCK, A_HEADS, 2, A_DQK).swapaxes(0, 1)
    pb = pos.reshape(nb, Q_BLOCK)
    o = lax.map(lambda a: _diff_attend(a[0], k, v, a[1], pos, lam), (qb, pb))
    return o.swapaxes(0, 1).reshape(B, T, A_HEADS, A_DV)


def _hgrn2(q, k, logf, v, S0):
    B, T, H, DK = q.shape
    DV = v.shape[-1]
    C = HGRN_CHUNK if T % HGRN_CHUNK == 0 else T
    n = T // C
    def to_chunks(a):
        return a.astype(jnp.float32).reshape(B, n, C, H, a.shape[-1]).swapaxes(0, 1)
    xs = (to_chunks(q), to_chunks(k), to_chunks(logf), to_chunks(v))
    tri = jnp.tril(jnp.ones((C, C), dtype=bool))[None, :, :, None, None]
    def step(S, inp):
        qc, kc, lfc, vc = inp
        b = jnp.cumsum(lfc, axis=1)
        diff = b[:, :, None] - b[:, None, :]
        decay = jnp.exp(jnp.where(tri, diff, -jnp.inf))
        att = jnp.einsum('bthd,bshd,btshd->bhts', qc, kc, decay)
        o = jnp.einsum('bhts,bshv->bthv', att, vc) + jnp.einsum('bthd,bhdv->bthv', qc * jnp.exp(b), S)
        bC = b[:, -1]
        S_new = jnp.exp(bC)[..., None] * S + jnp.einsum('bshd,bshv->bhdv', kc * jnp.exp(bC[:, None] - b), vc)
        return S_new, o
    S_fin, o = lax.scan(step, S0.astype(jnp.float32), xs)
    return o.swapaxes(0, 1).reshape(B, T, H, DV), S_fin


def _merge(x, o_attn, ag, o_hgrn, hg, subln_g, hgrn_norm_g, lam_init, w_out):
    B, T, _ = x.shape
    a = (_rms_norm(o_attn, subln_g) * (1.0 - lam_init)).reshape(B, T, D_ATTN) * jax.nn.silu(ag.astype(jnp.float32))
    r = _rms_norm(o_hgrn, hgrn_norm_g).reshape(B, T, D_HGRN) * jax.nn.silu(hg.astype(jnp.float32))
    mix = jnp.concatenate([a, r], axis=-1).astype(x.dtype)
    return x + mix @ w_out


def setup_inputs(seed: int = 0) -> dict:
    key = jax.random.key(seed)
    ks = jax.random.split(key, 20)
    n_pages = PAST_LEN // PAGE_SIZE
    n_used = DEC_BATCH * n_pages
    n_pool = n_used + max(1, n_used // 4)
    f32 = jnp.float32
    d_in = 2 * A_HEADS * 2 * A_DQK + A_HEADS * A_DV + D_ATTN + 2 * H_HEADS * H_DK + H_HEADS * H_DV + D_HGRN
    page_table = jax.random.permutation(ks[5], n_pool)[:n_used].reshape(DEC_BATCH, n_pages).astype(jnp.int32)
    return {
        "x_prompt": jax.random.normal(ks[0], (BATCH, SEQ, D_MODEL), f32),
        "x_sample": jax.random.normal(ks[1], (DEC_BATCH, DEC_SEQ, D_MODEL), f32),
        "cache_k": jax.random.normal(ks[2], (DEPTH, n_pool, PAGE_SIZE, A_HEADS, 2 * A_DQK), f32),
        "cache_v": jax.random.normal(ks[3], (DEPTH, n_pool, PAGE_SIZE, A_HEADS, A_DV), f32),
        "state_hgrn": 0.5 * jax.random.normal(ks[4], (DEPTH, DEC_BATCH, H_HEADS, H_DK, H_DV), f32),
        "page_table": page_table,
        "norm_g": 1.0 + 0.02 * jax.random.normal(ks[6], (DEPTH, D_MODEL), f32),
        "w_in": jax.random.normal(ks[7], (DEPTH, D_MODEL, d_in), f32) * D_MODEL ** -0.5,
        "q_norm_g": 1.0 + 0.02 * jax.random.normal(ks[8], (DEPTH, A_DQK), f32),
        "k_norm_g": 1.0 + 0.02 * jax.random.normal(ks[9], (DEPTH, A_DQK), f32),
        "lambda_q1": 0.1 * jax.random.normal(ks[10], (DEPTH, A_DQK), f32),
        "lambda_k1": 0.1 * jax.random.normal(ks[11], (DEPTH, A_DQK), f32),
        "lambda_q2": 0.1 * jax.random.normal(ks[12], (DEPTH, A_DQK), f32),
        "lambda_k2": 0.1 * jax.random.normal(ks[13], (DEPTH, A_DQK), f32),
        "subln_g": 1.0 + 0.02 * jax.random.normal(ks[14], (DEPTH, A_DV), f32),
        "hgrn_lb_logits": 0.1 * jax.random.normal(ks[15], (DEPTH + 1, H_HEADS * H_DK), f32),
        "hgrn_norm_g": 1.0 + 0.02 * jax.random.normal(ks[16], (DEPTH, H_DV), f32),
        "w_out": jax.random.normal(ks[17], (DEPTH, D_MIX, D_MODEL), f32) * D_MIX ** -0.5,
    }


def reference(x_prompt, x_sample, cache_k, cache_v, state_hgrn, page_table, norm_g, w_in, q_norm_g,
              k_norm_g, lambda_q1, lambda_k1, lambda_q2, lambda_k2, subln_g, hgrn_lb_logits,
              hgrn_norm_g, w_out):
    Bp, Tp, _ = x_prompt.shape
    Bs, Ts, _ = x_sample.shape
    past_len = page_table.shape[1] * cache_k.shape[2]
    pos_p = jnp.arange(Tp, dtype=jnp.int32)
    pos_s = past_len + jnp.arange(Ts, dtype=jnp.int32)
    kpos_s = jnp.arange(past_len + Ts, dtype=jnp.int32)
    lb_all = jnp.cumsum(jax.nn.softmax(hgrn_lb_logits.astype(jnp.float32), axis=0), axis=0)
    xp, xs = x_prompt, x_sample
    nk_p, nv_p, ns_p, nk_s, nv_s, ns_s = [], [], [], [], [], []
    for l in range(DEPTH):
        lam_init = 0.8 - 0.6 * math.exp(-0.3 * l)
        lam = (jnp.exp(jnp.sum(lambda_q1[l].astype(jnp.float32) * lambda_k1[l].astype(jnp.float32)))
               - jnp.exp(jnp.sum(lambda_q2[l].astype(jnp.float32) * lambda_k2[l].astype(jnp.float32)))
               + lam_init)
        lb = lb_all[l]
        aq, ak, av, ag, hq, hk, lf, hi, hg = _mixer_inputs(xp, pos_p, norm_g[l], w_in[l], q_norm_g[l], k_norm_g[l], lb)
        o_a = _prompt_attend(aq, ak, av, pos_p, lam)
        S0 = jnp.zeros((Bp, H_HEADS, H_DK, H_DV), jnp.float32)
        o_h, S_p = _hgrn2(hq, hk, lf, hi, S0)
        xp = _merge(xp, o_a, ag, o_h, hg, subln_g[l], hgrn_norm_g[l], lam_init, w_out[l])
        nk_p.append(ak.reshape(Bp, Tp, A_HEADS, 2 * A_DQK))
        nv_p.append(av)
        ns_p.append(S_p)
        saq, sak, sav, sag, shq, shk, slf, shi, shg = _mixer_inputs(xs, pos_s, norm_g[l], w_in[l], q_norm_g[l], k_norm_g[l], lb)
        pk = cache_k[l][page_table].reshape(Bs, past_len, A_HEADS, 2, A_DQK)
        pv = cache_v[l][page_table].reshape(Bs, past_len, A_HEADS, A_DV)
        k_all = jnp.concatenate([pk, sak.astype(pk.dtype)], axis=1)
        v_all = jnp.concatenate([pv, sav.astype(pv.dtype)], axis=1)
        so_a = _diff_attend(saq, k_all, v_all, pos_s, kpos_s, lam)
        so_h, S_s = _hgrn2(shq, shk, slf, shi, state_hgrn[l])
        xs = _merge(xs, so_a, sag, so_h, shg, subln_g[l], hgrn_norm_g[l], lam_init, w_out[l])
        nk_s.append(sak.reshape(Bs, Ts, A_HEADS, 2 * A_DQK))
        nv_s.append(sav)
        ns_s.append(S_s)
    return (xp, xs, jnp.stack(nk_p), jnp.stack(nv_p), jnp.stack(ns_p),
            jnp.stack(nk_s), jnp.stack(nv_s), jnp.stack(ns_s))
```

```cpp
#include <hip/hip_runtime.h>
#include <cstdio>
#include <cstdint>
#include <cmath>
namespace nv {
constexpr int DM = 1024, BATCH = 2, SEQ = 8192, DECB = 128, DECS = 8, PAST = 2048, PAGE = 128, NPAGES = 16;
constexpr int MP = BATCH * SEQ, MS = DECB * DECS, MT = MP + MS;
constexpr int DIN = 4096;
constexpr int C_AQ = 0, C_AK = 512, C_AV = 1024, C_AG = 1536, C_HQ = 2048, C_HF = 2560, C_HI = 3072, C_HG = 3584;
constexpr size_t O_YP = 0, O_YS = O_YP + (size_t)MP * DM, O_KP = O_YS + (size_t)MS * DM, O_VP = O_KP + (size_t)MP * 512,
                 O_SP = O_VP + (size_t)MP * 512, O_KS = O_SP + (size_t)BATCH * 4 * 128 * 128, O_VS = O_KS + (size_t)MS * 512,
                 O_SS = O_VS + (size_t)MS * 512, O_END = O_SS + (size_t)DECB * 4 * 128 * 128;

__device__ __forceinline__ float siluf(float x) { return x / (1.f + expf(-x)); }
__device__ __forceinline__ float wsum(float v) {
#pragma unroll
    for (int o = 1; o < 64; o <<= 1) v += __shfl_xor(v, o);
    return v;
}
__device__ __forceinline__ const float* xrow(const float* xp, const float* xs, int m) { return m < MP ? xp + (size_t)m * DM : xs + (size_t)(m - MP) * DM; }
__device__ __forceinline__ int row_pos(int m) { return m < MP ? (m % SEQ) : PAST + ((m - MP) % DECS); }

__device__ __forceinline__ void rope_cs(int pos, int i, float& cs, float& sn) {
    const double rev[8] = {0.15915494309189535, 0.03086376340470123, 0.005985185712713705, 0.001160663641240061, 0.00022507907903927653, 4.364795279280289e-05, 8.464330808241401e-06, 1.6414262627950345e-06};
    double r = rev[0];
#pragma unroll
    for (int k = 1; k < 8; ++k) r = (i == k) ? rev[k] : r;
    double x = (double)pos * r; x -= __builtin_rint(x);
    const float xf = (float)x;
    cs = __builtin_amdgcn_cosf(xf); sn = __builtin_amdgcn_sinf(xf);
}
__global__ void k_rms(const float* xp, const float* xs, const float* g, float* H) {
    const int w = (blockIdx.x * blockDim.x + threadIdx.x) >> 6, lane = threadIdx.x & 63;
    if (w >= MT) return;
    const float* x = xrow(xp, xs, w);
    float v[16]; float s = 0.f;
#pragma unroll
    for (int j = 0; j < 16; ++j) { v[j] = x[lane + 64 * j]; s += v[j] * v[j]; }
    s = wsum(s);
    const float r = rsqrtf(s * (1.f / DM) + 1e-6f);
#pragma unroll
    for (int j = 0; j < 16; ++j) H[(size_t)w * DM + lane + 64 * j] = v[j] * r * g[lane + 64 * j];
}
template <bool RES>
__global__ void k_gemm(const float* A, const float* B, float* C, int M, int N, int K, const float* xp, const float* xs, float* Cp, float* Cs) {
    __shared__ float As[16][65], Bs[16][65];
    const int tx = threadIdx.x & 15, ty = threadIdx.x >> 4, m0 = blockIdx.y * 64, n0 = blockIdx.x * 64;
    float acc[4][4];
#pragma unroll
    for (int i = 0; i < 4; ++i)
#pragma unroll
        for (int j = 0; j < 4; ++j) acc[i][j] = 0.f;
    for (int k0 = 0; k0 < K; k0 += 16) {
#pragma unroll
        for (int i = 0; i < 4; ++i) { const int e = threadIdx.x + 256 * i; const int r = e >> 4, c = e & 15; As[c][r] = A[(size_t)(m0 + r) * K + k0 + c]; }
#pragma unroll
        for (int i = 0; i < 4; ++i) { const int e = threadIdx.x + 256 * i; const int r = e >> 6, c = e & 63; Bs[r][c] = B[(size_t)(k0 + r) * N + n0 + c]; }
        __syncthreads();
#pragma unroll
        for (int kk = 0; kk < 16; ++kk) {
            float a[4], b[4];
#pragma unroll
            for (int i = 0; i < 4; ++i) { a[i] = As[kk][ty * 4 + i]; b[i] = Bs[kk][tx * 4 + i]; }
#pragma unroll
            for (int i = 0; i < 4; ++i)
#pragma unroll
                for (int j = 0; j < 4; ++j) acc[i][j] += a[i] * b[j];
        }
        __syncthreads();
    }
#pragma unroll
    for (int i = 0; i < 4; ++i) {
        const int m = m0 + ty * 4 + i;
#pragma unroll
        for (int j = 0; j < 4; ++j) {
            const int n = n0 + tx * 4 + j;
            if (RES) { const float r = xrow(xp, xs, m)[n] + acc[i][j]; if (m < MP) Cp[(size_t)m * N + n] = r; else Cs[(size_t)(m - MP) * N + n] = r; }
            else C[(size_t)m * N + n] = acc[i][j];
        }
    }
}
__global__ void k_post(const float* Z, const float* qg, const float* kg, const float* lbl, float* Qn, float* Kp, float* Ks, float* Vp, float* Vs, float* HQ, float* F) {
    const int w = (blockIdx.x * blockDim.x + threadIdx.x) >> 6, lane = threadIdx.x & 63;
    if (w >= MT) return;
    const float* z = Z + (size_t)w * DIN;
    const int pos = row_pos(w);
    float* Ko = w < MP ? Kp + (size_t)w * 512 : Ks + (size_t)(w - MP) * 512;
    float* Vo = w < MP ? Vp + (size_t)w * 512 : Vs + (size_t)(w - MP) * 512;
    float cs, sn; rope_cs(pos, lane & 7, cs, sn);
    for (int grp = 0; grp < 16; ++grp) {
        const bool isk = grp >= 8; const int g8 = grp & 7;
        const float x = z[(isk ? C_AK : C_AQ) + g8 * 64 + lane];
        const float ss = wsum(x * x);
        float y = x * rsqrtf(ss * (1.f / 64.f) + 1e-6f) * (isk ? kg[lane] : qg[lane]);
        const float other = __shfl_xor(y, 8);
        if (lane < 8) y = y * cs - other * sn; else if (lane < 16) y = y * cs + other * sn;
        if (isk) Ko[g8 * 64 + lane] = y; else Qn[(size_t)w * 512 + g8 * 64 + lane] = y;
    }
    for (int j = 0; j < 8; ++j) {
        const int c = lane + 64 * j;
        Vo[c] = z[C_AV + c];
        HQ[(size_t)w * 512 + c] = siluf(z[C_HQ + c]);
        const float lb = 1.f / (1.f + expf(lbl[512 + c] - lbl[c]));
        const float sg = 1.f / (1.f + expf(-z[C_HF + c]));
        F[(size_t)w * 512 + c] = lb + (1.f - lb) * sg;
    }
}
__device__ __forceinline__ float lam_of(const float* q1, const float* k1, const float* q2, const float* k2) {
    float a = 0.f, b = 0.f;
    for (int i = 0; i < 64; ++i) { a += q1[i] * k1[i]; b += q2[i] * k2[i]; }
    return expf(a) - expf(b) + 0.2f;
}
__global__ void __launch_bounds__(256) k_attn_p(const float* __restrict__ Qn, const float* __restrict__ Kp, const float* __restrict__ Vp, const float* lq1, const float* lk1, const float* lq2, const float* lk2, float* __restrict__ OA) {
    const int lane = threadIdx.x & 63, dvq = threadIdx.x >> 6;
    const int qb = blockIdx.x % (SEQ / 64), bh = blockIdx.x / (SEQ / 64), b = bh >> 2, h = bh & 3;
    const int q = qb * 64 + lane; const size_t row = (size_t)b * SEQ + q;
    const float lam = lam_of(lq1, lk1, lq2, lk2);
    float qv[128];
#pragma unroll
    for (int d = 0; d < 128; ++d) qv[d] = Qn[row * 512 + h * 128 + d] * 0.125f;
    float o0[32], o1[32];
#pragma unroll
    for (int d = 0; d < 32; ++d) { o0[d] = 0.f; o1[d] = 0.f; }
    float m0 = -INFINITY, m1 = -INFINITY, l0 = 0.f, l1 = 0.f;
    const int jmax = qb * 64 + 63;
    for (int j = 0; j <= jmax; ++j) {
        const float* kr = Kp + ((size_t)b * SEQ + j) * 512 + h * 128;
        const float* vr = Vp + ((size_t)b * SEQ + j) * 512 + h * 128 + dvq * 32;
        float s0 = 0.f, s1 = 0.f;
#pragma unroll
        for (int d = 0; d < 64; ++d) { s0 += qv[d] * kr[d]; s1 += qv[64 + d] * kr[64 + d]; }
        if (j <= q) {
            const float n0 = fmaxf(m0, s0), n1 = fmaxf(m1, s1);
            const float a0 = expf(m0 - n0), a1 = expf(m1 - n1), p0 = expf(s0 - n0), p1 = expf(s1 - n1);
            l0 = l0 * a0 + p0; l1 = l1 * a1 + p1; m0 = n0; m1 = n1;
#pragma unroll
            for (int d = 0; d < 32; ++d) { const float v = vr[d]; o0[d] = o0[d] * a0 + p0 * v; o1[d] = o1[d] * a1 + p1 * v; }
        }
    }
    const float i0 = 1.f / l0, i1 = lam / l1;
#pragma unroll
    for (int d = 0; d < 32; ++d) OA[row * 512 + h * 128 + dvq * 32 + d] = o0[d] * i0 - o1[d] * i1;
}
__global__ void __launch_bounds__(64) k_attn_s(const float* Qn, const float* Ks, const float* Vs, const float* ck, const float* cv, const int* pt,
                                                const float* lq1, const float* lk1, const float* lq2, const float* lk2, float* OA) {
    const int b = blockIdx.x >> 2, h = blockIdx.x & 3, t = threadIdx.x;
    if (t >= 32) return;
    const int q = t >> 2, dvq = t & 3; const size_t row = (size_t)MP + b * DECS + q;
    const float lam = lam_of(lq1, lk1, lq2, lk2);
    float qv[128];
#pragma unroll
    for (int d = 0; d < 128; ++d) qv[d] = Qn[row * 512 + h * 128 + d] * 0.125f;
    float o0[32], o1[32];
#pragma unroll
    for (int d = 0; d < 32; ++d) { o0[d] = 0.f; o1[d] = 0.f; }
    float m0 = -INFINITY, m1 = -INFINITY, l0 = 0.f, l1 = 0.f;
    for (int j = 0; j < PAST + DECS; ++j) {
        const float *kr, *vr;
        if (j < PAST) { const int pg = pt[b * NPAGES + (j >> 7)]; const size_t off = (((size_t)pg * PAGE + (j & 127)) * 4 + h) * 128; kr = ck + off; vr = cv + off + dvq * 32; }
        else { const size_t off = ((size_t)(b * DECS + (j - PAST))) * 512 + h * 128; kr = Ks + off; vr = Vs + off + dvq * 32; }
        if (j >= PAST && (j - PAST) > q) break;
        float s0 = 0.f, s1 = 0.f;
#pragma unroll
        for (int d = 0; d < 64; ++d) { s0 += qv[d] * kr[d]; s1 += qv[64 + d] * kr[64 + d]; }
        const float n0 = fmaxf(m0, s0), n1 = fmaxf(m1, s1);
        const float a0 = expf(m0 - n0), a1 = expf(m1 - n1), p0 = expf(s0 - n0), p1 = expf(s1 - n1);
        l0 = l0 * a0 + p0; l1 = l1 * a1 + p1; m0 = n0; m1 = n1;
#pragma unroll
        for (int d = 0; d < 32; ++d) { const float v = vr[d]; o0[d] = o0[d] * a0 + p0 * v; o1[d] = o1[d] * a1 + p1 * v; }
    }
    const float i0 = 1.f / l0, i1 = lam / l1;
#pragma unroll
    for (int d = 0; d < 32; ++d) OA[row * 512 + h * 128 + dvq * 32 + d] = o0[d] * i0 - o1[d] * i1;
}
__global__ void __launch_bounds__(128) k_hgrn(const float* HQ, const float* F, const float* Z, const float* S0, float* OH, float* Sout, int T, size_t row0) {
    const int v = threadIdx.x, sh = blockIdx.x, sq = sh >> 2, h = sh & 3;
    float S[128];
#pragma unroll
    for (int d = 0; d < 128; ++d) S[d] = S0 ? S0[((size_t)sh * 128 + d) * 128 + v] : 0.f;
    for (int t = 0; t < T; ++t) {
        const size_t row = row0 + (size_t)sq * T + t;
        const float* f = F + row * 512 + h * 128; const float* q = HQ + row * 512 + h * 128;
        const float vi = Z[row * DIN + C_HI + h * 128 + v];
        float o = 0.f;
#pragma unroll
        for (int d = 0; d < 128; ++d) { const float fd = f[d]; S[d] = fd * S[d] + (1.f - fd) * vi; o += q[d] * S[d]; }
        OH[row * 512 + h * 128 + v] = o;
    }
#pragma unroll
    for (int d = 0; d < 128; ++d) Sout[((size_t)sh * 128 + d) * 128 + v] = S[d];
}
__global__ void k_merge(const float* OA, const float* OH, const float* Z, const float* sg, const float* hg, float* MIX) {
    const int w = (blockIdx.x * blockDim.x + threadIdx.x) >> 6, lane = threadIdx.x & 63;
    if (w >= MT) return;
    for (int grp = 0; grp < 8; ++grp) {
        const bool ish = grp >= 4; const int h = grp & 3;
        const float* src = (ish ? OH : OA) + (size_t)w * 512 + h * 128;
        const float a = src[lane], b = src[lane + 64];
        const float r = rsqrtf(wsum(a * a + b * b) * (1.f / 128.f) + 1e-6f);
        const float* gn = ish ? hg : sg; const float sc = ish ? 1.f : 0.8f;
        const float* gate = Z + (size_t)w * DIN + (ish ? C_HG : C_AG) + h * 128;
        MIX[(size_t)w * DM + grp * 128 + lane] = a * r * gn[lane] * sc * siluf(gate[lane]);
        MIX[(size_t)w * DM + grp * 128 + lane + 64] = b * r * gn[lane + 64] * sc * siluf(gate[lane + 64]);
    }
}
struct Ws { float *H, *Z, *Qn, *HQ, *F, *OA, *OH, *MIX; };
inline Ws carve(void* d_ws, size_t base) {
    char* p = (char*)d_ws + base; Ws w;
    w.H = (float*)p; p += (size_t)MT * DM * 4; w.Z = (float*)p; p += (size_t)MT * DIN * 4; w.Qn = (float*)p; p += (size_t)MT * 512 * 4;
    w.HQ = (float*)p; p += (size_t)MT * 512 * 4; w.F = (float*)p; p += (size_t)MT * 512 * 4; w.OA = (float*)p; p += (size_t)MT * 512 * 4;
    w.OH = (float*)p; p += (size_t)MT * 512 * 4; w.MIX = (float*)p; p += (size_t)MT * DM * 4; return w;
}
inline void run_all(void* const* d_in, float* out, void* d_ws, size_t base, hipStream_t st) {
    const float* xp = (const float*)d_in[0]; const float* xs = (const float*)d_in[1]; const float* ck = (const float*)d_in[2]; const float* cv = (const float*)d_in[3];
    const float* s0 = (const float*)d_in[4]; const int* pt = (const int*)d_in[5]; const float* ng = (const float*)d_in[6]; const float* win = (const float*)d_in[7];
    const float* qg = (const float*)d_in[8]; const float* kg = (const float*)d_in[9]; const float* lq1 = (const float*)d_in[10]; const float* lk1 = (const float*)d_in[11];
    const float* lq2 = (const float*)d_in[12]; const float* lk2 = (const float*)d_in[13]; const float* sg = (const float*)d_in[14]; const float* lbl = (const float*)d_in[15];
    const float* hg = (const float*)d_in[16]; const float* wout = (const float*)d_in[17];
    Ws w = carve(d_ws, base);
    k_rms<<<MT / 4, 256, 0, st>>>(xp, xs, ng, w.H);
    k_gemm<false><<<dim3(DIN / 64, MT / 64), 256, 0, st>>>(w.H, win, w.Z, MT, DIN, DM, nullptr, nullptr, nullptr, nullptr);
    k_post<<<MT / 4, 256, 0, st>>>(w.Z, qg, kg, lbl, w.Qn, out + O_KP, out + O_KS, out + O_VP, out + O_VS, w.HQ, w.F);
    k_attn_p<<<BATCH * 4 * (SEQ / 64), 256, 0, st>>>(w.Qn, out + O_KP, out + O_VP, lq1, lk1, lq2, lk2, w.OA);
    k_attn_s<<<DECB * 4, 64, 0, st>>>(w.Qn, out + O_KS, out + O_VS, ck, cv, pt, lq1, lk1, lq2, lk2, w.OA);
    k_hgrn<<<BATCH * 4, 128, 0, st>>>(w.HQ, w.F, w.Z, nullptr, w.OH, out + O_SP, SEQ, 0);
    k_hgrn<<<DECB * 4, 128, 0, st>>>(w.HQ, w.F, w.Z, s0, w.OH, out + O_SS, DECS, (size_t)MP);
    k_merge<<<MT / 4, 256, 0, st>>>(w.OA, w.OH, w.Z, sg, hg, w.MIX);
    k_gemm<true><<<dim3(DM / 64, MT / 64), 256, 0, st>>>(w.MIX, wout, nullptr, MT, DM, DM, xp, xs, out + O_YP, out + O_YS);
}
}
extern "C" void kernel_launch(void* const* d_in, const int* in_sizes, int n_in,
                              void* d_out, int out_size, void* d_ws, size_t ws_size,
                              hipStream_t stream) {
    nv::run_all(d_in, (float*)d_out, d_ws, 0, stream);
}
```

```cpp
#include <hip/hip_runtime.h>
#include <cstdio>
#include <cstdint>
#include <cmath>
constexpr int NWAVES = 8;
constexpr int MP = 16384, MS = 1024, MT = 17408, DMODEL = 1024, DIN = 4096, SEQ = 8192;
constexpr float C2 = 0.125f * 1.4426950408889634f;
constexpr float LOG2E = 1.4426950408889634f, LN2 = 0.6931471805599453f;
constexpr size_t MiB = 1u << 20;
constexpr size_t WS_CTL = 0, CTL_ZERO_BYTES = 1 * MiB;
constexpr size_t WS_ROPE = 1 * MiB, WS_WIN = 2 * MiB, WS_WOUT = 10 * MiB, WS_XN = 16 * MiB, WS_Q = 52 * MiB, WS_K = 70 * MiB, WS_V = 88 * MiB,
                 WS_AG = 106 * MiB, WS_HQ = 124 * MiB, WS_HI = 142 * MiB, WS_HG = 160 * MiB, WS_LF = 178 * MiB, WS_OA = 212 * MiB, WS_MIX = 244 * MiB,
                 WS_UT = 280 * MiB, WS_GC = 344 * MiB, WS_ST = 346 * MiB, WS_FAST_END = 380 * MiB;
constexpr size_t WS_ORACLE = 1536 * MiB;
constexpr int CW_TMO = 0, CW_CODE = 1, CW_BAR = 4096, CW_DIAG = 65536;
constexpr size_t WS_FOUT = 1024 * MiB;
constexpr size_t O_YP = 0, O_YS = O_YP + (size_t)MP * 1024, O_KP = O_YS + (size_t)MS * 1024, O_VP = O_KP + (size_t)MP * 512,
                 O_SP = O_VP + (size_t)MP * 512, O_KS = O_SP + (size_t)2 * 4 * 128 * 128, O_VS = O_KS + (size_t)MS * 512,
                 O_SS = O_VS + (size_t)MS * 512;
constexpr int RING_OFF = 0, RING_BYTES = 131072, LDSCTL_OFF = RING_BYTES, MISC_OFF = LDSCTL_OFF + 320, LDS_BYTES = 147456;

__device__ __forceinline__ float wave_sum(float v) {
#pragma unroll
    for (int o = 1; o < 64; o <<= 1) v += __shfl_xor(v, o);
    return v;
}
__device__ __forceinline__ float fast_silu(float x) { return x * __builtin_amdgcn_rcpf(1.f + __builtin_amdgcn_exp2f(-x * LOG2E)); }
__device__ __forceinline__ float fast_sigmoid(float x) { return __builtin_amdgcn_rcpf(1.f + __builtin_amdgcn_exp2f(-x * LOG2E)); }
__device__ __forceinline__ unsigned pkbf(float lo, float hi) { typedef float f2 __attribute__((ext_vector_type(2))); typedef __bf16 b2 __attribute__((ext_vector_type(2)));
    f2 v = {lo, hi}; b2 b = __builtin_convertvector(v, b2); return __builtin_bit_cast(unsigned, b); }
__device__ __forceinline__ float bf2f(unsigned short b) { return __uint_as_float((unsigned)b << 16); }
__host__ __device__ __forceinline__ int win_row_of_col(int n) {
    if (n >= 1024) return n;
    const int pn = n >> 8, ca = n & 255, wc = ca >> 6, bj = (ca >> 5) & 1, r = ca & 31;
    return pn * 256 + 128 * bj + 32 * wc + r;
}
namespace pg8 {
#define PG8_LAS __attribute__((address_space(3)))
typedef unsigned short bf16_t;
typedef short bf16x8 __attribute__((ext_vector_type(8)));
typedef float f32x4 __attribute__((ext_vector_type(4)));
typedef unsigned u32x4 __attribute__((ext_vector_type(4)));
constexpr int BM = 256, BK = 64, HALF = 128, HTB = HALF * BK * 2  , STAGE_BYTES = 8 * HTB, NXCD = 8, WGM = 8;

__host__ __device__ __forceinline__ int lds_byte(int r, int c) { const int st = (r >> 4) * 2 + (c >> 5), rr = r & 15, cc = c & 31, ob = rr * 64 + cc * 2; return st * 1024 + (ob ^ (((ob >> 9) & 1) << 5)); }
__host__ __device__ __forceinline__ void stage_rc(int b, int& R, int& C) { const int st = b / 1024, sb = b % 1024, swz = sb ^ (((sb >> 9) & 1) << 5); R = (st >> 1) * 16 + swz / 64; C = (st & 1) * 32 + (swz % 64) / 2; }
__host__ __device__ __forceinline__ int perm32(int rho) { const int n = rho >> 4, i = rho & 15; return 8 * (i >> 2) + 4 * n + (i & 3); }

struct Unit { int pm, pn; };
struct Gemm { const bf16_t* A; const bf16_t* Bt; int M, N, K; };

struct StaticOrder {
    int nM, nN, nwg, G, c;
    __host__ __device__ void init(int M, int N, int G_, int c_) { nM = M / BM; nN = N / BM; nwg = nM * nN; G = G_; c = c_; }
    __host__ __device__ bool next(int i, Unit& u) const {
        const long L = (long)i * G + c; if (L >= nwg) return false;
        int wgid = (int)L; { const int q = nwg / NXCD, r = nwg % NXCD, xcd = wgid % NXCD, off = wgid / NXCD; wgid = (xcd < r ? xcd * (q + 1) : r * (q + 1) + (xcd - r) * q) + off; }
        const int nig = WGM * nN, gid = wgid / nig, fm = gid * WGM, gsz = (nM - fm) < WGM ? (nM - fm) : WGM;
        u.pm = fm + ((wgid % nig) % gsz); u.pn = (wgid % nig) / gsz; return true;
    }
    __device__ __forceinline__ void a_ready(const Unit&) const {}
    __device__ __forceinline__ void done(const Unit&) const {}
};

__device__ __forceinline__ unsigned cvt_pk_bf16(float lo, float hi) { unsigned r; asm volatile("v_cvt_pk_bf16_f32 %0, %1, %2" : "=v"(r) : "v"(lo), "v"(hi)); return r; }
typedef float f32x2 __attribute__((ext_vector_type(2)));
__device__ __forceinline__ f32x2 gelu_pk(f32x2 v) {
    const f32x2 av = __builtin_elementwise_abs(v), d = av * 0.2316418882f + 1.0f;
    f32x2 t; t.x = __builtin_amdgcn_rcpf(d.x); t.y = __builtin_amdgcn_rcpf(d.y);
    f32x2 q = t * 0.5307027145f + (-0.7265760135f); q = q * t + 0.7107068705f; q = q * t + (-0.142248368f); q = q * t + 0.127414796f; q = q * t;
    const f32x2 s = (v * v) * (-0.72134752044f);
    f32x2 e; e.x = __builtin_amdgcn_exp2f(s.x); e.y = __builtin_amdgcn_exp2f(s.y);
    const f32x2 m = v * (q * e), r = v - m;
    f32x2 o; o.x = v.x < 0.f ? m.x : r.x; o.y = v.y < 0.f ? m.y : r.y; return o;
}

template <int ACT  > struct EpiBf16 {
    static constexpr bool PERM = true, AFTER_DRAIN = false; static_assert(ACT == 0 || ACT == 1, "EpiBf16: ACT is 0 (none) or 1 (gelu_pk)");
    bf16_t* O; int ldc; const float* bias; int split_cols; size_t split_stride; float scale0;
    __device__ __forceinline__ void operator()(const f32x4 (&acc)[2][2][4][2], const Unit& u, int wr, int wc, int fr, int fq) const {
        const int row0 = u.pm * BM + wr * 64 + fr; int colt = u.pn * BM; bf16_t* base = O;
        float sc = 1.f; if (split_cols) { const int t = colt / split_cols; base += (size_t)t * split_stride; colt -= t * split_cols; if (t == 0) sc = scale0; }
        const int col0 = colt + wc * 32 + 8 * fq, bcol0 = u.pn * BM + wc * 32 + 8 * fq;
        f32x4 bv[2][2];
#pragma unroll
        for (int bj = 0; bj < 2; ++bj)
#pragma unroll
            for (int n = 0; n < 2; ++n) bv[bj][n] = bias ? *(const f32x4*)(bias + bcol0 + bj * HALF + 4 * n) : (f32x4){0.f, 0.f, 0.f, 0.f};
#pragma unroll
        for (int ai = 0; ai < 2; ++ai)
#pragma unroll
            for (int m = 0; m < 4; ++m) { bf16_t* rowp = base + (size_t)(row0 + ai * HALF + m * 16) * ldc + col0;
#pragma unroll
                for (int bj = 0; bj < 2; ++bj) { f32x4 v0 = acc[ai][bj][m][0] + bv[bj][0], v1 = acc[ai][bj][m][1] + bv[bj][1];
                    if (ACT == 1) { f32x2 a = gelu_pk((f32x2){v0[0], v0[1]}), b = gelu_pk((f32x2){v0[2], v0[3]}), c = gelu_pk((f32x2){v1[0], v1[1]}), d = gelu_pk((f32x2){v1[2], v1[3]});
                        v0 = (f32x4){a.x, a.y, b.x, b.y}; v1 = (f32x4){c.x, c.y, d.x, d.y}; }
                    v0 = v0 * sc; v1 = v1 * sc; u32x4 w; w.x = cvt_pk_bf16(v0[0], v0[1]); w.y = cvt_pk_bf16(v0[2], v0[3]); w.z = cvt_pk_bf16(v1[0], v1[1]); w.w = cvt_pk_bf16(v1[2], v1[3]);
                    *(u32x4*)(rowp + bj * HALF) = w; } }
    }
};

struct PanelStats {
    unsigned* xbuf;
    unsigned* cnt;
    unsigned* tmo;
    int ntn; float eps;
    unsigned code;
    __device__ __forceinline__ bool run(const f32x4 (&v)[2][2][4][2], const Unit& u, int wr, int wc, int fr, int fq, PG8_LAS unsigned char* lds, int wid, int lane) const {
        typedef float f32x2v __attribute__((ext_vector_type(2)));
        PG8_LAS f32x2v* P = (PG8_LAS f32x2v*)lds;
        PG8_LAS f32x2v* S = (PG8_LAS f32x2v*)(lds + 8192);
        PG8_LAS unsigned* flag = (PG8_LAS unsigned*)(lds + 8192 + 2048);
#pragma unroll
        for (int ai = 0; ai < 2; ++ai)
#pragma unroll
            for (int m = 0; m < 4; ++m) {
                float s = 0.f;
#pragma unroll
                for (int bj = 0; bj < 2; ++bj)
#pragma unroll
                    for (int n = 0; n < 2; ++n) { const f32x4 x = v[ai][bj][m][n]; s += (x[0] + x[1]) + (x[2] + x[3]); }
                s += __shfl_xor(s, 16); s += __shfl_xor(s, 32);
                const float mw = s * (1.0f / 64.0f); float q = 0.f;
#pragma unroll
                for (int bj = 0; bj < 2; ++bj)
#pragma unroll
                    for (int n = 0; n < 2; ++n) { const f32x4 d = v[ai][bj][m][n] - mw; q += (d[0] * d[0] + d[1] * d[1]) + (d[2] * d[2] + d[3] * d[3]); }
                q += __shfl_xor(q, 16); q += __shfl_xor(q, 32);
                if (fq == 0) P[(ai * HALF + wr * 64 + m * 16 + fr) * 4 + wc] = (f32x2v){mw, q};
            }
        asm volatile("s_waitcnt lgkmcnt(0)" ::: "memory"); __builtin_amdgcn_s_barrier(); asm volatile("" ::: "memory");
#if defined(BROKEN_EXCHANGE_NO_WAIT)
#warning BROKEN CONTROL BUILD: the row-statistics exchange does not wait; results are wrong by design
        if (blockIdx.x >= 64) { const long long t0_ = clock64(); while (clock64() - t0_ < 60000) __builtin_amdgcn_s_sleep(8); }
#endif
        const int row = wid * 32 + (lane & 31);
        if (lane < 32) {
            const f32x2v a = P[row * 4 + 0], b = P[row * 4 + 1], c = P[row * 4 + 2], d = P[row * 4 + 3];
            const float mt = (a.x + b.x + c.x + d.x) * 0.25f;
            const float da = a.x - mt, db = b.x - mt, dc = c.x - mt, dd = d.x - mt;
            const float m2 = (a.y + b.y) + (c.y + d.y) + 64.0f * ((da * da + db * db) + (dc * dc + dd * dd));
            unsigned long long* slot = (unsigned long long*)xbuf + ((size_t)(u.pm * BM + row) * 4 + u.pn);
            __hip_atomic_store(slot, ((unsigned long long)__float_as_uint(m2) << 32) | __float_as_uint(mt), __ATOMIC_RELAXED, __HIP_MEMORY_SCOPE_AGENT);
        }
        asm volatile("s_waitcnt vmcnt(0)" ::: "memory");
        if (lane == 0) __hip_atomic_fetch_add(cnt + 64 * u.pm, 1u, __ATOMIC_RELAXED, __HIP_MEMORY_SCOPE_AGENT);
        if (wid == 0) {
            bool dead = false; const unsigned long long t0 = __builtin_amdgcn_s_memrealtime(); const unsigned want = 8u * (unsigned)ntn;
            for (;;) {
#if defined(BROKEN_EXCHANGE_NO_WAIT)
                break;
#endif
                if ((unsigned)__builtin_amdgcn_readfirstlane(__hip_atomic_load(cnt + 64 * u.pm, __ATOMIC_RELAXED, __HIP_MEMORY_SCOPE_AGENT)) >= want) break;
                if (__builtin_amdgcn_s_memrealtime() - t0 > 2000000ull) {
                    if (lane == 0) { unsigned expect = 0u; __hip_atomic_compare_exchange_strong(tmo + 1, &expect, code | (unsigned)(u.pm & 0xff), __ATOMIC_RELAXED, __ATOMIC_RELAXED, __HIP_MEMORY_SCOPE_AGENT);
                                     __hip_atomic_store(tmo, 1u, __ATOMIC_RELAXED, __HIP_MEMORY_SCOPE_AGENT); }
                    dead = true; break; }
                __builtin_amdgcn_s_sleep(2);
            }
            __builtin_amdgcn_fence(__ATOMIC_ACQUIRE, "agent");
            if (lane == 0) flag[0] = dead ? 1u : 0u;
        }
        asm volatile("s_waitcnt vmcnt(0) lgkmcnt(0)" ::: "memory"); __builtin_amdgcn_s_barrier(); asm volatile("" ::: "memory");
        const bool bad = flag[0] != 0u;
        if (lane < 32) {
            const unsigned long long* slot = (const unsigned long long*)xbuf + (size_t)(u.pm * BM + row) * 4; float mt[4], m2[4]; float ms = 0.f;
#pragma unroll
            for (int t = 0; t < 4; ++t) { if (t < ntn) { const unsigned long long w = __hip_atomic_load(slot + t, __ATOMIC_RELAXED, __HIP_MEMORY_SCOPE_AGENT); mt[t] = __uint_as_float((unsigned)w); m2[t] = __uint_as_float((unsigned)(w >> 32)); } else { mt[t] = 0.f; m2[t] = 0.f; } ms += mt[t]; }
            const float mean = ms / (float)ntn; float q = 0.f;
#pragma unroll
            for (int t = 0; t < 4; ++t) if (t < ntn) { const float dm = mt[t] - mean; q += m2[t] + 256.0f * dm * dm; }
            S[row] = (f32x2v){mean, 1.0f / sqrtf(q / (256.0f * (float)ntn) + eps)};
        }
        asm volatile("s_waitcnt lgkmcnt(0)" ::: "memory"); __builtin_amdgcn_s_barrier(); asm volatile("" ::: "memory");
        return bad;
    }
};
struct EpiLnRes {
    static constexpr bool PERM = false, AFTER_DRAIN = true;
    const float* base; float* out; int ldc; const float* bias; PanelStats st; unsigned poison;
    __device__ __forceinline__ void fused(f32x4 (&acc)[2][2][4][2], const Unit& u, int wr, int wc, int fr, int fq, PG8_LAS unsigned char* lds, int wid, int lane) const {
        typedef float f32x2v __attribute__((ext_vector_type(2)));
        const PG8_LAS f32x2v* S = (const PG8_LAS f32x2v*)(lds + 8192);
        const int col0 = u.pn * BM + wc * 32 + 4 * fq;
#pragma unroll
        for (int bj = 0; bj < 2; ++bj)
#pragma unroll
            for (int n = 0; n < 2; ++n) { const f32x4 bv = bias ? *(const f32x4*)(bias + col0 + bj * HALF + n * 16) : (f32x4){0.f, 0.f, 0.f, 0.f};
#pragma unroll
                for (int ai = 0; ai < 2; ++ai)
#pragma unroll
                    for (int m = 0; m < 4; ++m) acc[ai][bj][m][n] += bv; }
        f32x4 pre[4][2][2];
#pragma unroll
        for (int m = 0; m < 4; ++m) { const size_t off = (size_t)(u.pm * BM + wr * 64 + m * 16 + fr) * ldc + col0;
#pragma unroll
            for (int bj = 0; bj < 2; ++bj)
#pragma unroll
                for (int n = 0; n < 2; ++n) pre[m][bj][n] = *(const f32x4*)(base + off + bj * HALF + n * 16); }
        const bool bad = st.run(acc, u, wr, wc, fr, fq, lds, wid, lane) || poison != 0u;
        const float qnan = __builtin_nanf("");
#pragma unroll
        for (int ai = 0; ai < 2; ++ai)
#pragma unroll
            for (int m = 0; m < 4; ++m) { const int r = ai * HALF + wr * 64 + m * 16 + fr; const f32x2v sr = S[r]; const size_t off = (size_t)(u.pm * BM + r) * ldc + col0;
#pragma unroll
                for (int bj = 0; bj < 2; ++bj)
#pragma unroll
                    for (int n = 0; n < 2; ++n) { const f32x4 bs = ai == 0 ? pre[m][bj][n] : *(const f32x4*)(base + off + bj * HALF + n * 16); f32x4 o = bs + (acc[ai][bj][m][n] - sr.x) * sr.y;
                        if (bad) o = (f32x4){qnan, qnan, qnan, qnan}; *(f32x4*)(out + off + bj * HALF + n * 16) = o; }
                if (m & 1) asm volatile("" ::: "memory"); }
    }
};
struct EpiLnResLn {
    static constexpr bool PERM = false, AFTER_DRAIN = true;
    const float* base; float* out; bf16_t* xn; int ldc; const float* bias; PanelStats st1, st2; unsigned poison;
    __device__ __forceinline__ void fused(f32x4 (&acc)[2][2][4][2], const Unit& u, int wr, int wc, int fr, int fq, PG8_LAS unsigned char* lds, int wid, int lane) const {
        typedef float f32x2v __attribute__((ext_vector_type(2))); typedef unsigned u32x2v __attribute__((ext_vector_type(2)));
        const PG8_LAS f32x2v* S = (const PG8_LAS f32x2v*)(lds + 8192);
        const int col0 = u.pn * BM + wc * 32 + 4 * fq;
#pragma unroll
        for (int bj = 0; bj < 2; ++bj)
#pragma unroll
            for (int n = 0; n < 2; ++n) { const f32x4 bv = bias ? *(const f32x4*)(bias + col0 + bj * HALF + n * 16) : (f32x4){0.f, 0.f, 0.f, 0.f};
#pragma unroll
                for (int ai = 0; ai < 2; ++ai)
#pragma unroll
                    for (int m = 0; m < 4; ++m) acc[ai][bj][m][n] += bv; }
        bool bad = st1.run(acc, u, wr, wc, fr, fq, lds, wid, lane) || poison != 0u;
        const float qnan = __builtin_nanf("");
#pragma unroll
        for (int ai = 0; ai < 2; ++ai)
#pragma unroll
            for (int m = 0; m < 4; ++m) { const int r = ai * HALF + wr * 64 + m * 16 + fr; const f32x2v sr = S[r]; const size_t off = (size_t)(u.pm * BM + r) * ldc + col0;
#pragma unroll
                for (int bj = 0; bj < 2; ++bj)
#pragma unroll
                    for (int n = 0; n < 2; ++n) { const f32x4 bs = *(const f32x4*)(base + off + bj * HALF + n * 16); acc[ai][bj][m][n] = bs + (acc[ai][bj][m][n] - sr.x) * sr.y; }
                asm volatile("" : "+v"(acc[ai][0][m][0]), "+v"(acc[ai][0][m][1]), "+v"(acc[ai][1][m][0]), "+v"(acc[ai][1][m][1]));
                if (m & 1) asm volatile("" ::: "memory"); }
        const bool bad1 = bad;
        bad = st2.run(acc, u, wr, wc, fr, fq, lds, wid, lane) || bad;
#pragma unroll
        for (int ai = 0; ai < 2; ++ai)
#pragma unroll
            for (int m = 0; m < 4; ++m) { const int r = ai * HALF + wr * 64 + m * 16 + fr; const f32x2v sr = S[r]; const size_t off = (size_t)(u.pm * BM + r) * ldc + col0;
#pragma unroll
                for (int bj = 0; bj < 2; ++bj)
#pragma unroll
                    for (int n = 0; n < 2; ++n) { const f32x4 x1 = acc[ai][bj][m][n]; *(f32x4*)(out + off + bj * HALF + n * 16) = bad1 ? (f32x4){qnan, qnan, qnan, qnan} : x1;
                        const f32x4 o = (x1 - sr.x) * sr.y; u32x2v w; w.x = cvt_pk_bf16(o[0], o[1]); w.y = cvt_pk_bf16(o[2], o[3]);
                        if (bad) { w.x = 0x7fc07fc0u; w.y = 0x7fc07fc0u; } *(u32x2v*)(xn + off + bj * HALF + n * 16) = w; }
                asm volatile("" ::: "memory"); }
    }
};

template <class Epi, class Sched, bool ALIGN_EPI = false, bool SP2 = false>
__device__ __forceinline__ void gemm_phase(PG8_LAS unsigned char* lds, const Gemm g, const Sched& S, const Epi& E) {
    int tid_ = threadIdx.x; asm volatile("" : "+v"(tid_));
    const int tid = tid_, wid = __builtin_amdgcn_readfirstlane(tid >> 6), lane = tid & 63, wr = wid >> 2, wc = wid & 3, fr = lane & 15, fq = lane >> 4;
    const int K = g.K, nt = K / BK;
    unsigned voffA[2], voffB[2];
#pragma unroll
    for (int i = 0; i < 2; ++i) { int R, C; stage_rc(tid * 16 + i * 8192, R, C); const int Rb = Epi::PERM ? ((R & ~31) + perm32(R & 31)) : R;
        voffA[i] = (unsigned)(R * K + C) * 2u; voffB[i] = (unsigned)(Rb * K + C) * 2u; }
    const size_t kstep = (size_t)(BK * 2);
    const size_t hstep = (size_t)HALF * K * 2;
    const size_t tstep = 2 * hstep;
    const unsigned ldsw = (unsigned)wid * 1024u;
    const int aoff = lds_byte(wr * 64 + fr, fq * 8), boff = lds_byte(wc * 32 + fr, fq * 8);
#define PG8_SA(b, h) (((b) * 2 + (h)) * HTB)
#define PG8_SB(b, h) ((4 + (b) * 2 + (h)) * HTB)
#define PG8_STAGE(bufoff, gbase, voff) do { _Pragma("unroll") for (int _i = 0; _i < 2; ++_i) \
        __builtin_amdgcn_global_load_lds((const unsigned*)((const char*)(gbase) + (voff)[_i]), (PG8_LAS unsigned*)(lds + (bufoff) + ldsw + _i * 8192), 16, 0, 0); } while (0)
#define PG8_LDA(dst, b, h) do { _Pragma("unroll") for (int m = 0; m < 4; ++m) _Pragma("unroll") for (int k = 0; k < 2; ++k) dst[m][k] = *(const PG8_LAS bf16x8*)(lds + PG8_SA(b, h) + aoff + m * 2048 + k * 1024); } while (0)
#define PG8_LDB(dst, b, h) do { _Pragma("unroll") for (int n = 0; n < 2; ++n) _Pragma("unroll") for (int k = 0; k < 2; ++k) dst[n][k] = *(const PG8_LAS bf16x8*)(lds + PG8_SB(b, h) + boff + n * 2048 + k * 1024); } while (0)
#define PG8_MMA(ai, bj, At, Bt) do { __builtin_amdgcn_s_setprio(1); _Pragma("unroll") for (int m = 0; m < 4; ++m) _Pragma("unroll") for (int n = 0; n < 2; ++n) _Pragma("unroll") for (int k = 0; k < 2; ++k) \
        acc[ai][bj][m][n] = __builtin_amdgcn_mfma_f32_16x16x32_bf16(Bt[n][k], At[m][k], acc[ai][bj][m][n], 0, 0, 0); __builtin_amdgcn_s_setprio(0); } while (0)
#define PG8_WAIT_V(n) asm volatile("s_waitcnt vmcnt(" #n ")" ::: "memory")
#define PG8_WAIT_L(n) asm volatile("s_waitcnt lgkmcnt(" #n ")" ::: "memory")
#define PG8_BAR __builtin_amdgcn_s_barrier()
#define PG8_SCHED __builtin_amdgcn_sched_barrier(0)
    Unit cur, nxt; int ui = 0;
    if (!S.next(0, cur)) return;
    f32x4 acc[2][2][4][2];
#pragma unroll
    for (int a = 0; a < 2; ++a)
#pragma unroll
        for (int b = 0; b < 2; ++b)
#pragma unroll
            for (int m = 0; m < 4; ++m)
#pragma unroll
                for (int n = 0; n < 2; ++n) acc[a][b][m][n] = (f32x4){0.f, 0.f, 0.f, 0.f};
    bf16x8 At[4][2], B0[2][2], B1[2][2];
    const char* cA = (const char*)g.A + (size_t)cur.pm * tstep; const char* cB = (const char*)g.Bt + (size_t)cur.pn * tstep;
    S.a_ready(cur);
    if constexpr (SP2) {
        PG8_STAGE(PG8_SB(0, 0), cB, voffB); PG8_STAGE(PG8_SB(0, 1), cB + hstep, voffB); PG8_STAGE(PG8_SA(0, 0), cA, voffA); PG8_STAGE(PG8_SA(0, 1), cA + hstep, voffA);
        if (wr == 1) PG8_BAR;
        PG8_WAIT_V(2); PG8_BAR;
        PG8_STAGE(PG8_SB(1, 0), cB + kstep, voffB); PG8_STAGE(PG8_SA(1, 0), cA + kstep, voffA); PG8_STAGE(PG8_SB(1, 1), cB + hstep + kstep, voffB);
        PG8_WAIT_V(6); PG8_BAR;
    } else {
        PG8_STAGE(PG8_SB(0, 0), cB, voffB); PG8_STAGE(PG8_SA(0, 0), cA, voffA); PG8_STAGE(PG8_SB(0, 1), cB + hstep, voffB); PG8_STAGE(PG8_SA(0, 1), cA + hstep, voffA);
        if (wr == 1) PG8_BAR;
        PG8_WAIT_V(4); PG8_BAR;
        PG8_STAGE(PG8_SB(1, 0), cB + kstep, voffB); PG8_STAGE(PG8_SA(1, 0), cA + kstep, voffA); PG8_STAGE(PG8_SB(1, 1), cB + hstep + kstep, voffB);
        PG8_WAIT_V(6); PG8_BAR;
    }
    for (;;) {
        const bool has_next = S.next(ui + 1, nxt);
        const char* nA = has_next ? (const char*)g.A + (size_t)nxt.pm * tstep : cA; const char* nB = has_next ? (const char*)g.Bt + (size_t)nxt.pn * tstep : cB;
        for (int t = 0; t < nt; t += 2) {
            const bool last = (t == nt - 2);
            const char* a1 = cA + (size_t)(t + 1) * kstep;
            const char* a2 = last ? nA : cA + (size_t)(t + 2) * kstep; const char* b2 = last ? nB : cB + (size_t)(t + 2) * kstep;
            const char* a3 = a2 + kstep; const char* b3 = b2 + kstep;
            if (last && has_next) S.a_ready(nxt);
            if constexpr (SP2) {
            PG8_LDB(B0, 0, 0); PG8_LDB(B1, 0, 1); PG8_SCHED; PG8_LDA(At, 0, 0); PG8_STAGE(PG8_SA(1, 1), a1 + hstep, voffA);
            PG8_WAIT_V(8); PG8_WAIT_L(0); PG8_BAR; PG8_MMA(0, 0, At, B0); PG8_MMA(0, 1, At, B1); PG8_BAR; PG8_SCHED;
            PG8_LDA(At, 0, 1); PG8_STAGE(PG8_SB(0, 0), b2, voffB); PG8_STAGE(PG8_SB(0, 1), b2 + hstep, voffB); PG8_STAGE(PG8_SA(0, 0), a2, voffA);
            PG8_WAIT_V(8); PG8_WAIT_L(0); PG8_BAR; PG8_MMA(1, 0, At, B0); PG8_MMA(1, 1, At, B1); PG8_BAR; PG8_SCHED;
            PG8_LDB(B0, 1, 0); PG8_LDB(B1, 1, 1); PG8_SCHED; PG8_LDA(At, 1, 0); PG8_STAGE(PG8_SA(0, 1), a2 + hstep, voffA);
            PG8_WAIT_V(8); PG8_WAIT_L(0); PG8_BAR; PG8_MMA(0, 0, At, B0); PG8_MMA(0, 1, At, B1); PG8_BAR; PG8_SCHED;
            PG8_LDA(At, 1, 1); PG8_STAGE(PG8_SB(1, 0), b3, voffB); PG8_STAGE(PG8_SB(1, 1), b3 + hstep, voffB); PG8_STAGE(PG8_SA(1, 0), a3, voffA);
            PG8_WAIT_V(8); PG8_WAIT_L(0); PG8_BAR; PG8_MMA(1, 0, At, B0); PG8_MMA(1, 1, At, B1); PG8_BAR; PG8_SCHED;
            } else {
            PG8_LDB(B0, 0, 0); PG8_SCHED; PG8_LDA(At, 0, 0); PG8_STAGE(PG8_SA(1, 1), a1 + hstep, voffA);
            PG8_WAIT_L(8); PG8_BAR; PG8_WAIT_L(0); PG8_MMA(0, 0, At, B0); PG8_BAR; PG8_SCHED;
            PG8_LDB(B1, 0, 1); PG8_STAGE(PG8_SB(0, 0), b2, voffB);
            PG8_BAR; PG8_WAIT_L(0); PG8_MMA(0, 1, At, B1); PG8_BAR;
            PG8_LDA(At, 0, 1); PG8_STAGE(PG8_SA(0, 0), a2, voffA);
            PG8_BAR; PG8_WAIT_L(0); PG8_MMA(1, 0, At, B0); PG8_BAR; PG8_SCHED;
            PG8_STAGE(PG8_SB(0, 1), b2 + hstep, voffB);
            PG8_WAIT_V(6); PG8_BAR; PG8_MMA(1, 1, At, B1); PG8_BAR;
            PG8_LDB(B0, 1, 0); PG8_SCHED; PG8_LDA(At, 1, 0); PG8_STAGE(PG8_SA(0, 1), a2 + hstep, voffA);
            PG8_WAIT_L(8); PG8_BAR; PG8_WAIT_L(0); PG8_MMA(0, 0, At, B0); PG8_BAR; PG8_SCHED;
            PG8_LDB(B1, 1, 1); PG8_STAGE(PG8_SB(1, 0), b3, voffB);
            PG8_BAR; PG8_WAIT_L(0); PG8_MMA(0, 1, At, B1); PG8_BAR;
            PG8_LDA(At, 1, 1); PG8_STAGE(PG8_SA(1, 0), a3, voffA);
            PG8_BAR; PG8_WAIT_L(0); PG8_MMA(1, 0, At, B0); PG8_BAR; PG8_SCHED;
            PG8_STAGE(PG8_SB(1, 1), b3 + hstep, voffB);
            PG8_WAIT_V(6); PG8_BAR; PG8_MMA(1, 1, At, B1); PG8_BAR;
            }
        }
        if constexpr (ALIGN_EPI) { if (wr == 0) PG8_BAR; }
        if constexpr (!Epi::AFTER_DRAIN) { E(acc, cur, wr, wc, fr, fq); S.done(cur); }
        if (!has_next) break;
#pragma unroll
        for (int a = 0; a < 2; ++a)
#pragma unroll
            for (int b = 0; b < 2; ++b)
#pragma unroll
                for (int m = 0; m < 4; ++m)
#pragma unroll
                    for (int n = 0; n < 2; ++n) acc[a][b][m][n] = (f32x4){0.f, 0.f, 0.f, 0.f};
        cur = nxt; cA = nA; cB = nB; ++ui;
        if constexpr (ALIGN_EPI) { if (wr == 1) PG8_BAR; }
    }
    PG8_WAIT_V(0);
    if constexpr (!ALIGN_EPI) { if (wr == 0) PG8_BAR; }
    PG8_BAR;
    if constexpr (Epi::AFTER_DRAIN) { E.fused(acc, cur, wr, wc, fr, fq, lds, wid, lane); S.done(cur); }
#undef PG8_SA
#undef PG8_SB
#undef PG8_STAGE
#undef PG8_LDA
#undef PG8_LDB
#undef PG8_MMA
#undef PG8_WAIT_V
#undef PG8_WAIT_L
#undef PG8_BAR
#undef PG8_SCHED
}
}
namespace pg8 {
__device__ __forceinline__ f32x4 shflx4(const f32x4 v, int m) { f32x4 r; r[0] = __shfl_xor(v[0], m); r[1] = __shfl_xor(v[1], m); r[2] = __shfl_xor(v[2], m); r[3] = __shfl_xor(v[3], m); return r; }
__device__ __forceinline__ u32x4 pack8(const f32x4 a, const f32x4 b) { u32x4 w; w.x = cvt_pk_bf16(a[0], a[1]); w.y = cvt_pk_bf16(a[2], a[3]); w.z = cvt_pk_bf16(b[0], b[1]); w.w = cvt_pk_bf16(b[2], b[3]); return w; }
struct EpiProj {
    static constexpr bool PERM = true, AFTER_DRAIN = false;
    bf16_t *Qb, *Kb, *Vb, *AGb, *HQb, *HIb, *HGb; float* LF;
    float *oKp, *oKs, *oVp, *oVs;
    const float *qg, *kg, *lbl, *rope;
    __device__ __forceinline__ void operator()(const f32x4 (&acc)[2][2][4][2], const Unit& u, int wr, int wc, int fr, int fq) const {
        const int seg = u.pn >> 1, half = u.pn & 1;
        const int row0 = u.pm * BM + wr * 64 + fr;
        const bool samp = (u.pm * BM) >= ::MP;
        if (seg < 2) {
            const float* g = seg ? kg : qg;
            f32x4 gv[2][2];
#pragma unroll
            for (int bj = 0; bj < 2; ++bj)
#pragma unroll
                for (int n = 0; n < 2; ++n) gv[bj][n] = *(const f32x4*)(g + 32 * bj + 8 * fq + 4 * n);
            const int gcol = (half * 4 + wc) * 64 + 8 * fq;
            const float sgn = (fq == 0) ? -1.f : 1.f;
#pragma unroll
            for (int ai = 0; ai < 2; ++ai) {
                f32x4 rc[4][4];
                if (fq < 2) {
#pragma unroll
                    for (int m = 0; m < 4; ++m) { const int row = row0 + ai * HALF + m * 16; const int pos = samp ? 2048 + ((row - ::MP) & 7) : (row & 8191); const float* rp = rope + (size_t)pos * 16;
#pragma unroll
                        for (int k4 = 0; k4 < 4; ++k4) rc[m][k4] = *(const f32x4*)(rp + 4 * k4); }
                }
                asm volatile("" ::: "memory");
#pragma unroll
                for (int m = 0; m < 4; ++m) {
                    const int row = row0 + ai * HALF + m * 16;
                    f32x4 x[2][2]; float ss = 0.f;
#pragma unroll
                    for (int bj = 0; bj < 2; ++bj)
#pragma unroll
                        for (int n = 0; n < 2; ++n) { x[bj][n] = acc[ai][bj][m][n]; const f32x4 t = x[bj][n] * x[bj][n]; ss += (t[0] + t[1]) + (t[2] + t[3]); }
                    ss += __shfl_xor(ss, 16); ss += __shfl_xor(ss, 32);
                    const float rs = __builtin_amdgcn_rsqf(ss * (1.f / 64.f) + 1e-6f);
#pragma unroll
                    for (int bj = 0; bj < 2; ++bj)
#pragma unroll
                        for (int n = 0; n < 2; ++n) x[bj][n] = x[bj][n] * rs * gv[bj][n];
                    const f32x4 o0 = shflx4(x[0][0], 16), o1 = shflx4(x[0][1], 16);
                    if (fq < 2) { x[0][0] = x[0][0] * rc[m][0] + (o0 * rc[m][2]) * sgn; x[0][1] = x[0][1] * rc[m][1] + (o1 * rc[m][3]) * sgn; }
                    if (seg == 0) {
#pragma unroll
                        for (int bj = 0; bj < 2; ++bj) *(u32x4*)(Qb + (size_t)row * 512 + gcol + 32 * bj) = pack8(x[bj][0] * ::C2, x[bj][1] * ::C2);
                    } else {
                        float* ok = samp ? oKs + (size_t)(row - ::MP) * 512 : oKp + (size_t)row * 512;
#pragma unroll
                        for (int bj = 0; bj < 2; ++bj) { *(u32x4*)(Kb + (size_t)row * 512 + gcol + 32 * bj) = pack8(x[bj][0], x[bj][1]);
                            *(f32x4*)(ok + gcol + 32 * bj) = x[bj][0]; *(f32x4*)(ok + gcol + 32 * bj + 4) = x[bj][1]; }
                    }
                }
            }
            return;
        }
        const int col0 = half * 256 + wc * 32 + 8 * fq;
        f32x4 lbv[2][2];
        if (seg == 5) {
#pragma unroll
            for (int bj = 0; bj < 2; ++bj)
#pragma unroll
                for (int n = 0; n < 2; ++n) { const f32x4 l0 = *(const f32x4*)(lbl + col0 + bj * HALF + 4 * n), l1 = *(const f32x4*)(lbl + 512 + col0 + bj * HALF + 4 * n);
#pragma unroll
                    for (int e = 0; e < 4; ++e) lbv[bj][n][e] = ::fast_sigmoid(l0[e] - l1[e]); }
        }
        bf16_t* dst = seg == 2 ? Vb : seg == 3 ? AGb : seg == 4 ? HQb : seg == 6 ? HIb : HGb;
#pragma unroll
        for (int ai = 0; ai < 2; ++ai)
#pragma unroll
            for (int m = 0; m < 4; ++m) {
                const int row = row0 + ai * HALF + m * 16;
#pragma unroll
                for (int bj = 0; bj < 2; ++bj) {
                    f32x4 v0 = acc[ai][bj][m][0], v1 = acc[ai][bj][m][1];
                    const int c = col0 + bj * HALF;
                    if (seg == 5) {
#pragma unroll
                        for (int e = 0; e < 4; ++e) { const float la = lbv[bj][0][e], lb2 = lbv[bj][1][e];
                            v0[e] = __builtin_amdgcn_logf(la + (1.f - la) * ::fast_sigmoid(v0[e])) * ::LN2; v1[e] = __builtin_amdgcn_logf(lb2 + (1.f - lb2) * ::fast_sigmoid(v1[e])) * ::LN2; }
                        *(f32x4*)(LF + (size_t)row * 512 + c) = v0; *(f32x4*)(LF + (size_t)row * 512 + c + 4) = v1;
                    } else {
                        if (seg == 3 || seg == 4 || seg == 7) {
#pragma unroll
                            for (int e = 0; e < 4; ++e) { v0[e] = ::fast_silu(v0[e]); v1[e] = ::fast_silu(v1[e]); }
                        }
                        *(u32x4*)(dst + (size_t)row * 512 + c) = pack8(v0, v1);
                        if (seg == 2) { float* ov = samp ? oVs + (size_t)(row - ::MP) * 512 : oVp + (size_t)row * 512; *(f32x4*)(ov + c) = v0; *(f32x4*)(ov + c + 4) = v1; }
                    }
                }
            }
    }
};
struct EpiOut {
    static constexpr bool PERM = false, AFTER_DRAIN = false;
    const float *xp, *xs; float* out;
    __device__ __forceinline__ void operator()(const f32x4 (&acc)[2][2][4][2], const Unit& u, int wr, int wc, int fr, int fq) const {
        const int row0 = u.pm * BM + wr * 64 + fr, col0 = u.pn * BM + wc * 32 + 4 * fq;
        const bool samp = (u.pm * BM) >= ::MP;
        const float* xbase = samp ? xs + (size_t)(row0 - ::MP) * 1024 : xp + (size_t)row0 * 1024; float* obase = out + (size_t)row0 * 1024;
#pragma unroll
        for (int ai = 0; ai < 2; ++ai) {
            f32x4 xv[4][2][2];
#pragma unroll
            for (int m = 0; m < 4; ++m)
#pragma unroll
                for (int bj = 0; bj < 2; ++bj)
#pragma unroll
                    for (int n = 0; n < 2; ++n) xv[m][bj][n] = *(const f32x4*)(xbase + (size_t)(ai * HALF + m * 16) * 1024 + col0 + bj * HALF + n * 16);
            asm volatile("" ::: "memory");
#pragma unroll
            for (int m = 0; m < 4; ++m)
#pragma unroll
                for (int bj = 0; bj < 2; ++bj)
#pragma unroll
                    for (int n = 0; n < 2; ++n) *(f32x4*)(obase + (size_t)(ai * HALF + m * 16) * 1024 + col0 + bj * HALF + n * 16) = xv[m][bj][n] + acc[ai][bj][m][n];
            asm volatile("" ::: "memory");
        }
    }
};
struct OneUnit {
    int pm, pn;
    __device__ __forceinline__ bool next(int i, Unit& u) const { if (i != 0) return false; u.pm = pm; u.pn = pn; return true; }
    __device__ __forceinline__ void a_ready(const Unit&) const {}
    __device__ __forceinline__ void done(const Unit&) const {}
};
struct P1Order {
    int G, c, i0, n;
    __device__ __forceinline__ bool next(int i, Unit& u) const {
        if (i >= n) return false;
        const int L = (i0 + i) * G + c; if (L >= 1088) return false;
        int wgid = (L & 7) * 136 + (L >> 3);
        if (G == 256) { if (wgid >= 1024 && wgid < 1032) wgid += 56; else if (wgid >= 1080) wgid -= 56; }
        const int gid = wgid >> 7, rem = wgid & 127;
        if (gid < 8) { u.pm = gid * 8 + (rem & 7); u.pn = rem >> 3; } else { u.pm = 64 + (rem & 3); u.pn = rem >> 2; }
        return true;
    }
    __device__ __forceinline__ void a_ready(const Unit&) const {}
    __device__ __forceinline__ void done(const Unit&) const {}
};
}
#include <hip/hip_bf16.h>
#include <cmath>
namespace attn128 {
using bf16=__hip_bfloat16;
using bf16x8=__attribute__((ext_vector_type(8)))short;
using s16x4=__attribute__((ext_vector_type(4)))short;
using f32x16=__attribute__((ext_vector_type(16)))float;
using u32x4=__attribute__((ext_vector_type(4)))unsigned;
constexpr int BATCH=2,NHEAD=8,SEQ=8192,D=64,DM=1024;
constexpr int NW=8,QBLK=32,QB=QBLK*NW,KVBLK=64,NQB=SEQ/QB;
constexpr int ATTN_PITCH=DM, ATTN_UNIT_ROWS=QB, QKP=512;
__device__ __forceinline__ int crow(int r,int hi){return (r&3)+8*(r>>2)+4*hi;}
#define SBAR() __builtin_amdgcn_sched_barrier(0)
__device__ __forceinline__ void cmask(f32x16&p0,f32x16&p1,int jb,int qrel,int hi){
  const float NEG=-INFINITY; int kb=64*jb+4*hi;
  #pragma unroll
  for(int r=0;r<16;++r){int kv=kb+(r&3)+8*(r>>2); if(kv>qrel)p0[r]=NEG; if(kv+32>qrel)p1[r]=NEG;}
}

constexpr int NSLOT=3, SLOTB=8192;
constexpr int LDS_K=0, LDS_V=NSLOT*SLOTB, LDS_WS=3*NSLOT*SLOTB, LDS_OST=LDS_WS+NW*64*4, LDS_BYTES=LDS_OST+NW*4096;
constexpr float C2=0.125f*1.4426950408889634f;
__device__ __forceinline__ void glds16(const void*gsrc,unsigned lds_dst){unsigned keep;
  asm volatile("s_mov_b32 %0, m0\n\ts_mov_b32 m0, %2\n\ts_nop 0\n\tglobal_load_lds_dwordx4 %1, off\n\ts_mov_b32 m0, %0":"=&s"(keep):"v"(gsrc),"s"(lds_dst):"memory");}
__device__ __forceinline__ float max3f(float a,float b,float c){float r;asm("v_max3_f32 %0, %1, %2, %3":"=v"(r):"v"(a),"v"(b),"v"(c));return r;}
__device__ __forceinline__ float max2f(float a,float b){float r;asm("v_max_f32_e32 %0, %1, %2":"=v"(r):"v"(a),"v"(b));return r;}
__device__ __forceinline__ float fadd_s(float a,float b){float r;asm("v_add_f32_e32 %0, %1, %2":"=v"(r):"v"(a),"v"(b));return r;}
__device__ __forceinline__ float fsub_s(float a,float b){float r;asm("v_sub_f32_e32 %0, %1, %2":"=v"(r):"v"(a),"v"(b));return r;}
typedef float f32x2_t __attribute__((ext_vector_type(2))); typedef __bf16 bf16x2_t __attribute__((ext_vector_type(2)));
__device__ __forceinline__ unsigned cvtpk_s(float lo,float hi){f32x2_t v={lo,hi};bf16x2_t b=__builtin_convertvector(v,bf16x2_t);return __builtin_bit_cast(unsigned,b);}
#define WAIT_BAR(N) asm volatile("s_waitcnt vmcnt(" #N ") lgkmcnt(0)\n\ts_barrier":::"memory")

__device__ __forceinline__ void qkt(f32x16&p0,f32x16&p1,const char*Kslot,const bf16x8*qr,const f32x16&negm,int r32,int hi){
  const char*kb=Kslot+hi*1024+r32*16;
  #pragma unroll
  for(int d0=0;d0<4;++d0){
    const bf16x8 b0=*reinterpret_cast<const bf16x8*>(kb+d0*2048);
    const bf16x8 b1=*reinterpret_cast<const bf16x8*>(kb+d0*2048+512);
    if(d0==0){p0=__builtin_amdgcn_mfma_f32_32x32x16_bf16(b0,qr[0],negm,0,0,0);p1=__builtin_amdgcn_mfma_f32_32x32x16_bf16(b1,qr[0],negm,0,0,0);}
    else{p0=__builtin_amdgcn_mfma_f32_32x32x16_bf16(b0,qr[d0],p0,0,0,0);p1=__builtin_amdgcn_mfma_f32_32x32x16_bf16(b1,qr[d0],p1,0,0,0);}}
}
typedef __attribute__((address_space(3))) const char* lds_cptr;
typedef short v4i16_t __attribute__((ext_vector_type(4)));
__device__ __forceinline__ void kload8(bf16x8*kf,lds_cptr kp){
  kf[0]=*(const __attribute__((address_space(3))) bf16x8*)(kp);      kf[1]=*(const __attribute__((address_space(3))) bf16x8*)(kp+512);
  kf[2]=*(const __attribute__((address_space(3))) bf16x8*)(kp+2048); kf[3]=*(const __attribute__((address_space(3))) bf16x8*)(kp+2560);
  kf[4]=*(const __attribute__((address_space(3))) bf16x8*)(kp+4096); kf[5]=*(const __attribute__((address_space(3))) bf16x8*)(kp+4608);
  kf[6]=*(const __attribute__((address_space(3))) bf16x8*)(kp+6144); kf[7]=*(const __attribute__((address_space(3))) bf16x8*)(kp+6656);
}
__device__ __forceinline__ void kload2(bf16x8*kf,lds_cptr kp,int j){ kf[2*j]=*(const __attribute__((address_space(3))) bf16x8*)(kp+j*2048); kf[2*j+1]=*(const __attribute__((address_space(3))) bf16x8*)(kp+j*2048+512); }
__device__ __forceinline__ s16x4 vtr(lds_cptr p){ return __builtin_bit_cast(s16x4,__builtin_amdgcn_ds_read_tr16_b64_v4i16((__attribute__((address_space(3))) v4i16_t*)p)); }
__device__ __forceinline__ float rowmax(const f32x16&p0,const f32x16&p1){
  float a=max3f(p0[0],p0[1],p1[0]),b=max3f(p0[2],p0[3],p1[1]);a=max3f(a,p1[2],p1[3]);
  #pragma unroll
  for(int r=4;r<16;r+=4){a=max3f(a,p0[r],p0[r+1]);b=max3f(b,p0[r+2],p0[r+3]);a=max3f(a,p1[r],p1[r+1]);b=max3f(b,p1[r+2],p1[r+3]);}
  const float m=max2f(a,b);
  auto rr=__builtin_amdgcn_permlane32_swap(__float_as_uint(m),__float_as_uint(m),false,false);
  return max2f(__uint_as_float(rr[0]),__uint_as_float(rr[1]));
}
__device__ __forceinline__ void pv(f32x16*o,int vb,bf16x8 pa0,bf16x8 pa1,bf16x8 pa2,bf16x8 pa3){
  #pragma unroll
  for(int d0=0;d0<2;++d0){s16x4 lo[4],hi[4];
    #pragma unroll
    for(int ks=0;ks<4;++ks){
      asm volatile("ds_read_b64_tr_b16 %0,%1 offset:%c2":"=&v"(lo[ks]):"v"(vb),"i"(d0*4096+ks*1024):"memory");
      asm volatile("ds_read_b64_tr_b16 %0,%1 offset:%c2":"=&v"(hi[ks]):"v"(vb),"i"(d0*4096+ks*1024+512):"memory");}
    asm volatile("s_waitcnt lgkmcnt(0)":::"memory");SBAR();
    #define PK(k) (bf16x8){lo[k][0],lo[k][1],lo[k][2],lo[k][3],hi[k][0],hi[k][1],hi[k][2],hi[k][3]}
    o[d0]=__builtin_amdgcn_mfma_f32_32x32x16_bf16(pa0,PK(0),o[d0],0,0,0);
    o[d0]=__builtin_amdgcn_mfma_f32_32x32x16_bf16(pa1,PK(1),o[d0],0,0,0);
    o[d0]=__builtin_amdgcn_mfma_f32_32x32x16_bf16(pa2,PK(2),o[d0],0,0,0);
    o[d0]=__builtin_amdgcn_mfma_f32_32x32x16_bf16(pa3,PK(3),o[d0],0,0,0);
    #undef PK
  }
}

#ifndef ATTN_STORE16
#define ATTN_STORE16(p,v) (*(u32x4*)(p)=(v))
#endif
template<int THRL> __device__ __forceinline__ void attn_unit(int b,int h,int qb,const bf16*Q,const bf16*__restrict__ K,const bf16*__restrict__ V,bf16*O,char*shm){
  int tid_=threadIdx.x; asm volatile("":"+v"(tid_));
  const int tid=tid_,lane=tid&63,r32=lane&31,hi=lane>>5; const int wid=__builtin_amdgcn_readfirstlane(tid>>6);
  const long rowbase=(long)b*SEQ; const int q0=qb*QB;
  const int hq_=h;
  const bf16*Qw=Q+(rowbase+q0+wid*QBLK)*QKP+hq_*D;
  const bf16*Kh=K+rowbase*QKP+hq_*D,*Vh=V+rowbase*QKP+(h>>1)*128;
  const unsigned lds0=(unsigned)(uintptr_t)shm;
  float*wsf=(float*)(shm+LDS_WS)+wid*64;
  const bf16*ksrc=Kh+(long)lane*QKP+wid*8;
  const bf16*vsrc=Vh+(long)(16*(wid&3)+(lane>>2))*QKP+(wid>>2)*32+(lane&3)*8;
  const unsigned kdst=lds0+LDS_K+wid*1024, vdst=lds0+LDS_V+wid*1024;
  #define DMA_K(t,slot) glds16(ksrc+(long)(t)*KVBLK*QKP,(unsigned)__builtin_amdgcn_readfirstlane(kdst+(slot)))
  #define DMA_V(t,slot) do{ glds16(vsrc+(long)(t)*KVBLK*QKP,(unsigned)__builtin_amdgcn_readfirstlane(vdst+2*(slot))); glds16(vsrc+(long)(t)*KVBLK*QKP+64,(unsigned)__builtin_amdgcn_readfirstlane(vdst+2*(slot)+SLOTB)); }while(0)
  const int vb0=(int)(lds0+LDS_V)+((lane>>4)&1)*32+(lane&3)*8+(4*hi+((lane&15)>>2))*64;
  const char*Kbase=shm+LDS_K; bf16x8 kf[8];
  const lds_cptr shm3=(lds_cptr)shm; const lds_cptr kp0=shm3+LDS_K+hi*1024+r32*16; const lds_cptr vp0=shm3+LDS_V+((lane>>4)&1)*32+(lane&3)*8+(4*hi+((lane&15)>>2))*64;
  const int NT=(q0+QB)/KVBLK;
  DMA_K(0,0);DMA_V(0,0);DMA_K(1,SLOTB);
  bf16x8 qr[4];
  #pragma unroll
  for(int d0=0;d0<4;++d0)qr[d0]=*reinterpret_cast<const bf16x8*>(&Qw[(long)r32*QKP+d0*16+hi*8]);
  float mhat=0.f,l_reg=0.f;f32x16 o[4];{float z_=0.f;asm volatile("":"+v"(z_));
  _Pragma("unroll") for(int d_=0;d_<4;++d_) _Pragma("unroll") for(int r=0;r<16;++r)o[d_][r]=z_;}
  f32x16 negm; {float z_=0.f;asm volatile("":"+v"(z_)); _Pragma("unroll") for(int r=0;r<16;++r)negm[r]=z_;}
  const int qrel=wid*QBLK+r32;
  #define CMASK(P0,P1,t) do{int jb_=(t)-(NT-4); if(jb_>=0)cmask(P0,P1,jb_,qrel,hi);}while(0)
  bool resc=false;
  #define START(P0,P1) do{ const float rm=rowmax(P0,P1); resc=false; \
    { const float dl=rm; mhat=fadd_s(mhat,dl); \
      _Pragma("unroll") for(int r=0;r<16;++r){P0[r]=fsub_s(P0[r],dl);P1[r]=fsub_s(P1[r],dl);} \
      _Pragma("unroll") for(int r=0;r<16;++r)negm[r]=-mhat; asm volatile("":"+v"(negm)); } \
    _Pragma("unroll") for(int r=0;r<16;++r)P0[r]=__builtin_amdgcn_exp2f(P0[r]); }while(0)
  #define RESC() do{ if(resc){ asm volatile("s_waitcnt lgkmcnt(0)":::"memory"); \
      _Pragma("unroll") for(int d_=0;d_<4;++d_) _Pragma("unroll") for(int r=0;r<16;++r)o[d_][r]*=wsf[crow(r,hi)]; } }while(0)
  f32x16 pA0,pA1,pB0,pB1;
  int sl_prev=0,sl_cur=0,sl_next=SLOTB;
  #define ROT() do{sl_prev=sl_cur;sl_cur=sl_next;sl_next=(sl_next==(NSLOT-1)*SLOTB)?0:sl_next+SLOTB;}while(0)
  DMA_K(2,2*SLOTB);
  WAIT_BAR(3);
  qkt(pA0,pA1,Kbase,qr,negm,r32,hi);asm volatile("s_nop 15\n\ts_nop 7":"+v"(pA0),"+v"(pA1));CMASK(pA0,pA1,0);
  START(pA0,pA1);
  _Pragma("unroll") for(int r=0;r<16;++r)pA1[r]=__builtin_amdgcn_exp2f(pA1[r]);
  WAIT_BAR(0);
  DMA_K(3,0);DMA_V(1,SLOTB);
  ROT();
  kload8(kf,kp0+sl_cur);
  WAIT_BAR(3);
  s16x4 vlo[8],vhi[8]; u32x4 pw0,pw1,pw2,pw3;
  #define PKW(P,B) cvtpk_s(P[B],P[B+1])
  #define PAF(k) __builtin_bit_cast(bf16x8,pw##k)
  #define VFR(i) (bf16x8){vlo[i][0],vlo[i][1],vlo[i][2],vlo[i][3],vhi[i][0],vhi[i][1],vhi[i][2],vhi[i][3]}
  #define PIN(x) asm volatile("":"+v"(x))
  #define MX3(a,b,c) __builtin_fmaxf(__builtin_fmaxf((a),(b)),(c))
  #define GAPA(MF,A0,A1,A2,A3,W0,W1,PW) do{ MF; sacc+=A0; sacc+=A1; sacc+=A2; sacc+=A3; PIN(sacc); W0; W1; PIN(PW); SBAR(); }while(0)
  #define EX(v) __builtin_amdgcn_exp2f(v)
  #define GAPB(MF,X,B) do{ MF; X[B]=EX(X[B]); X[B+1]=EX(X[B+1]); X[B+2]=EX(X[B+2]); X[B+3]=EX(X[B+3]); PIN(X); SBAR(); }while(0)
  #define VRD(i) do{ vlo[i]=vtr(vp_+(((i)>>2)*4096+((i)&3)*1024)); vhi[i]=vtr(vp_+(((i)>>2)*4096+((i)&3)*1024+512)); }while(0)
  #define KRD(G,j) do{ if(G){ kload2(kf,kp0+sl_next,j); SBAR(); } }while(0)
  #define STEP(C0,C1,P0,P1,t,GK,GV,GL) do{ SBAR(); \
    const lds_cptr vp_=vp0+2*sl_prev; \
    VRD(0); SBAR(); float sacc=(P0[0]+P0[1]); \
    GAPA(C0=__builtin_amdgcn_mfma_f32_32x32x16_bf16(kf[0],qr[0],negm,0,0,0), P0[2],P0[3],P0[4],P0[5],     pw0[0]=PKW(P0,0), pw0[1]=PKW(P0,2), pw0); \
    VRD(4); SBAR(); GAPA(C1=__builtin_amdgcn_mfma_f32_32x32x16_bf16(kf[1],qr[0],negm,0,0,0), P0[6],P0[7],P0[8],P0[9],     pw0[2]=PKW(P0,4), pw0[3]=PKW(P0,6), pw0); \
    VRD(1); SBAR(); GAPA(C0=__builtin_amdgcn_mfma_f32_32x32x16_bf16(kf[2],qr[1],C0,0,0,0),   P0[10],P0[11],P0[12],P0[13], pw1[0]=PKW(P0,8), pw1[1]=PKW(P0,10), pw1); \
    VRD(5); SBAR(); GAPA(C1=__builtin_amdgcn_mfma_f32_32x32x16_bf16(kf[3],qr[1],C1,0,0,0),   P0[14],P0[15],P1[0],P1[1],   pw1[2]=PKW(P0,12),pw1[3]=PKW(P0,14), pw1); \
    VRD(2); SBAR(); GAPA(C0=__builtin_amdgcn_mfma_f32_32x32x16_bf16(kf[4],qr[2],C0,0,0,0),   P1[2],P1[3],P1[4],P1[5],     pw2[0]=PKW(P1,0), pw2[1]=PKW(P1,2), pw2); \
    VRD(6); SBAR(); GAPA(C1=__builtin_amdgcn_mfma_f32_32x32x16_bf16(kf[5],qr[2],C1,0,0,0),   P1[6],P1[7],P1[8],P1[9],     pw2[2]=PKW(P1,4), pw2[3]=PKW(P1,6), pw2); \
    VRD(3); SBAR(); GAPA(C0=__builtin_amdgcn_mfma_f32_32x32x16_bf16(kf[6],qr[3],C0,0,0,0),   P1[10],P1[11],P1[12],P1[13], pw3[0]=PKW(P1,8), pw3[1]=PKW(P1,10), pw3); \
    VRD(7); SBAR(); GAPA(C1=__builtin_amdgcn_mfma_f32_32x32x16_bf16(kf[7],qr[3],C1,0,0,0),   P1[14],P1[15],0.f,0.f,       pw3[2]=PKW(P1,12),pw3[3]=PKW(P1,14), pw3); \
    l_reg+=sacc; \
    if(GK){DMA_K((t)+3,sl_cur);} if(GV){DMA_V((t)+1,sl_next);} \
    CMASK(C0,C1,t); \
    { float a=MX3(C0[0],C0[1],C1[0]),b=MX3(C0[2],C0[3],C1[1]); a=MX3(a,C1[2],C1[3]); \
      _Pragma("unroll") for(int r=4;r<16;r+=4){a=MX3(a,C0[r],C0[r+1]);b=MX3(b,C0[r+2],C0[r+3]);a=MX3(a,C1[r],C1[r+1]);b=MX3(b,C1[r+2],C1[r+3]);} \
      float rm=__builtin_fmaxf(a,b); { auto rr=__builtin_amdgcn_permlane32_swap(__float_as_uint(rm),__float_as_uint(rm),false,false); rm=__builtin_fmaxf(__uint_as_float(rr[0]),__uint_as_float(rr[1])); } \
      resc=false; \
      if(__builtin_expect(__any(rm>(float)THRL),0)){ const float dl=__builtin_fmaxf(rm,0.f); mhat+=dl; \
        _Pragma("unroll") for(int r=0;r<16;++r){C0[r]-=dl;C1[r]-=dl;} \
        _Pragma("unroll") for(int r=0;r<16;++r)negm[r]=-mhat; asm volatile("":"+v"(negm)); \
        const float f=__builtin_amdgcn_exp2f(-dl); l_reg*=f; if(hi==0)wsf[r32]=f; resc=true; } } \
    SBAR(); \
    GAPB(o[0]=__builtin_amdgcn_mfma_f32_32x32x16_bf16(PAF(0),VFR(0),o[0],0,0,0), C0,0); \
    GAPB(o[1]=__builtin_amdgcn_mfma_f32_32x32x16_bf16(PAF(0),VFR(4),o[1],0,0,0), C0,4); \
    KRD(GL,0); GAPB(o[0]=__builtin_amdgcn_mfma_f32_32x32x16_bf16(PAF(1),VFR(1),o[0],0,0,0), C0,8); \
    KRD(GL,1); GAPB(o[1]=__builtin_amdgcn_mfma_f32_32x32x16_bf16(PAF(1),VFR(5),o[1],0,0,0), C0,12); \
    KRD(GL,2); GAPB(o[0]=__builtin_amdgcn_mfma_f32_32x32x16_bf16(PAF(2),VFR(2),o[0],0,0,0), C1,0); \
    KRD(GL,3); GAPB(o[1]=__builtin_amdgcn_mfma_f32_32x32x16_bf16(PAF(2),VFR(6),o[1],0,0,0), C1,4); \
    GAPB(o[0]=__builtin_amdgcn_mfma_f32_32x32x16_bf16(PAF(3),VFR(3),o[0],0,0,0), C1,8); \
    GAPB(o[1]=__builtin_amdgcn_mfma_f32_32x32x16_bf16(PAF(3),VFR(7),o[1],0,0,0), C1,12); \
    pv(o+2,vb0+2*sl_prev+SLOTB,PAF(0),PAF(1),PAF(2),PAF(3));     \
    }while(0)
  int t=1;
  #undef CMASK
  #define CMASK(P0,P1,t) do{}while(0)
  for(;t+5<NT;t+=2){
    STEP(pB0,pB1,pA0,pA1,t,true,true,true);     WAIT_BAR(3); RESC(); ROT();
    STEP(pA0,pA1,pB0,pB1,t+1,true,true,true);   WAIT_BAR(3); RESC(); ROT();
  }
  #undef CMASK
  #define CMASK(P0,P1,t) do{int jb_=(t)-(NT-4); if(jb_>=0)cmask(P0,P1,jb_,qrel,hi);}while(0)
  #define ENDW(tt) do{ if((tt)+3<NT){WAIT_BAR(3);} else if((tt)+2<NT){WAIT_BAR(2);} else {WAIT_BAR(0);} }while(0)
  for(;t+1<NT;t+=2){
    STEP(pB0,pB1,pA0,pA1,t,(t+3<NT),(t+1<NT),(t+1<NT));       ENDW(t);   RESC(); ROT();
    STEP(pA0,pA1,pB0,pB1,t+1,(t+4<NT),(t+2<NT),(t+2<NT));     ENDW(t+1); RESC(); ROT();
  }
  STEP(pB0,pB1,pA0,pA1,NT-1,false,false,false); RESC();
  { float sacc=pB0[0]+pB0[1]; _Pragma("unroll") for(int r=2;r<16;++r)sacc+=pB0[r]; _Pragma("unroll") for(int r=0;r<16;++r)sacc+=pB1[r]; l_reg+=sacc;
    pw0=(u32x4){PKW(pB0,0),PKW(pB0,2),PKW(pB0,4),PKW(pB0,6)};pw1=(u32x4){PKW(pB0,8),PKW(pB0,10),PKW(pB0,12),PKW(pB0,14)};pw2=(u32x4){PKW(pB1,0),PKW(pB1,2),PKW(pB1,4),PKW(pB1,6)};pw3=(u32x4){PKW(pB1,8),PKW(pB1,10),PKW(pB1,12),PKW(pB1,14)};
    SBAR(); pv(o,vb0+2*sl_cur,PAF(0),PAF(1),PAF(2),PAF(3)); pv(o+2,vb0+2*sl_cur+SLOTB,PAF(0),PAF(1),PAF(2),PAF(3)); }
  #undef PKW
  #undef PAF
  #undef VFR
  #undef PIN
  #undef MX3
  #undef GAPA
  #undef GAPB
  #undef EX
  #undef VRD
  #undef KRD
  #undef STEP
  #undef ENDW
  {auto rr=__builtin_amdgcn_permlane32_swap(__float_as_uint(l_reg),__float_as_uint(l_reg),false,false);l_reg=__uint_as_float(rr[0])+__uint_as_float(rr[1]);}
  if(hi==0)wsf[32+r32]=l_reg;asm volatile("s_waitcnt lgkmcnt(0)":::"memory");
  float rli[16];
  #pragma unroll
  for(int r=0;r<16;++r)rli[r]=__builtin_amdgcn_rcpf(wsf[32+crow(r,hi)]);
  bf16*Ow=O+(rowbase+q0+wid*QBLK)*DM+h*128;
  { bf16*stg=(bf16*)(shm+LDS_OST)+wid*2048;
    #pragma unroll
    for(int hh=0;hh<2;++hh){
    #pragma unroll
    for(int r=0;r<16;++r){const int orow=crow(r,hi);
      #pragma unroll
      for(int d0=0;d0<2;++d0)stg[orow*64+d0*32+r32]=__float2bfloat16(o[2*hh+d0][r]*rli[r]);}
    asm volatile("s_waitcnt lgkmcnt(0)":::"memory");
    #pragma unroll
    for(int i=0;i<4;++i){const int row=i*8+(lane>>3),ch=lane&7; const u32x4 v=*(const u32x4*)(stg+row*64+ch*8); ATTN_STORE16(Ow+(long)row*DM+hh*64+ch*8,v);}
    asm volatile("s_waitcnt lgkmcnt(0)":::"memory"); } }
  asm volatile("s_waitcnt lgkmcnt(0)\n\ts_barrier":::"memory");
  #undef DMA_K
  #undef DMA_V
  #undef CMASK
  #undef START
  #undef RESC
  #undef ROT
}
constexpr int ATTN_LDS_BYTES=LDS_BYTES;
struct AttnTensors { const bf16* Q; const bf16* K; const bf16* V; bf16* O; };
struct AttnUnit { int bh; int qb; };
struct StaticOrder {
  int vcu;
  __device__ __forceinline__ explicit StaticOrder(int grid,int block):vcu((block%8)*(grid/8)+block/8){}
  __device__ __forceinline__ bool next(int i,AttnUnit&u)const{ if(i>=2)return false; const int s=vcu&15; u.bh=vcu>>4; u.qb=(i==0)?s:31-s; return true; }
  __device__ __forceinline__ void a_ready(const AttnUnit&)const{}
  __device__ __forceinline__ void done(const AttnUnit&)const{}
};
template<class Sched,int THRL=8> __device__ __forceinline__ void attn_phase(char*lds,const AttnTensors&T,const Sched&S){
  AttnUnit u;
  for(int i=0;S.next(i,u);++i){ S.a_ready(u); attn_unit<THRL>(u.bh/NHEAD,u.bh%NHEAD,u.qb,T.Q,T.K,T.V,T.O,lds); S.done(u); }
}
#undef SBAR
#undef WAIT_BAR
}
#define GAS __attribute__((address_space(1)))
#define LAS __attribute__((address_space(3)))
typedef unsigned short bf16;
typedef unsigned v4u __attribute__((ext_vector_type(4)));
typedef float f32x4 __attribute__((ext_vector_type(4)));
typedef short bf16x8 __attribute__((ext_vector_type(8)));
typedef GAS unsigned gu32;
typedef GAS unsigned long long gu64;
#define RLX_AGENT __ATOMIC_RELAXED, __HIP_MEMORY_SCOPE_AGENT
#define LDS_WAIT() asm volatile("s_waitcnt lgkmcnt(0)" ::: "memory")
#define VM_WAIT() asm volatile("s_waitcnt vmcnt(0)" ::: "memory")
__device__ __forceinline__ unsigned long long rt() { return __builtin_amdgcn_s_memrealtime(); }
__device__ __forceinline__ unsigned f2bf(float f) { unsigned u = __builtin_bit_cast(unsigned, f); return (u + 0x7fffu + ((u >> 16) & 1u)) >> 16; }
__device__ __forceinline__ unsigned pk2(float lo, float hi) { return f2bf(lo) | (f2bf(hi) << 16); }

#define XB_TMO      128
#define XB_XCNT(j)  (256  + 64 * (j))
#define XB_XSUB(j)  (1280 + 64 * (j))
#define XB_XGEN(j)  (2304 + 64 * (j))
#define XB_TOP      3328
#define XB_TOPGEN   3392
#define XCD_BAR_WORDS 3456
#define XB_SPIN_CAP (1u << 18)

__device__ __forceinline__ unsigned xb_ld(unsigned* p)              { return __hip_atomic_load(p, __ATOMIC_RELAXED, __HIP_MEMORY_SCOPE_AGENT); }
__device__ __forceinline__ unsigned xb_add(unsigned* p, unsigned v) { return __hip_atomic_fetch_add(p, v, __ATOMIC_RELAXED, __HIP_MEMORY_SCOPE_AGENT); }
__device__ __forceinline__ unsigned xb_xcc_id() { return (unsigned)__builtin_amdgcn_s_getreg((3 << 11) | 20) & 0xFu; }
#define XB_SPIN(cond, bar) do { unsigned _sp = 0; while (cond) { __builtin_amdgcn_s_sleep(1); \
    if ((++_sp & 255u) == 0u) { if (xb_ld(&(bar)[XB_TMO])) break; if (_sp > XB_SPIN_CAP) { atomicAdd(&(bar)[XB_TMO], 1u); break; } } } } while (0)

struct XcdBarrier {
    unsigned* bar; unsigned x;
    volatile LAS unsigned* st;
};

__device__ __forceinline__ XcdBarrier xcd_barrier_post(unsigned* bar, volatile LAS unsigned* st) {
    XcdBarrier b; b.bar = bar; b.x = xb_xcc_id(); b.st = st;
    if (threadIdx.x == 0) (void)xb_add(&bar[XB_XCNT(b.x)], 1u);
    return b;
}
__device__ __forceinline__ void xcd_barrier_complete(unsigned* bar, unsigned x, unsigned& nloc, unsigned& nx) {
    const unsigned G = gridDim.x * gridDim.y * gridDim.z;
    unsigned sum, cnt, mine, sp = 0u;
    for (;;) {
        sum = 0u; cnt = 0u; mine = 0u;
#pragma unroll
        for (unsigned j = 0; j < 16; ++j) { const unsigned c = xb_ld(&bar[XB_XCNT(j)]); sum += c; cnt += (c > 0u) ? 1u : 0u; mine = (j == x) ? c : mine; }
        if (sum == G) break;
        __builtin_amdgcn_s_sleep(1);
        if ((++sp & 255u) == 0u) { if (xb_ld(&bar[XB_TMO])) break; if (sp > XB_SPIN_CAP) { atomicAdd(&bar[XB_TMO], 1u); break; } }
    }
    nloc = mine > 0u ? mine : 1u; nx = cnt > 0u ? cnt : 1u;
}

__device__ __forceinline__ void xcd_barrier(const XcdBarrier& b) {
    asm volatile("s_waitcnt vmcnt(0)" ::: "memory");
    __syncthreads();
    if (threadIdx.x == 0) {
        unsigned* bar = b.bar;
        __builtin_amdgcn_s_waitcnt(0);
        unsigned nloc = b.st[0], nx = b.st[1];
        if (nloc == 0u) { xcd_barrier_complete(bar, b.x, nloc, nx); b.st[0] = nloc; b.st[1] = nx; }
        const unsigned old = xb_add(&bar[XB_XSUB(b.x)], 1u);
        const unsigned gen = old / nloc;
        if (old + 1u == (gen + 1u) * nloc) {
            __builtin_amdgcn_fence(__ATOMIC_RELEASE, "agent");
            asm volatile("s_waitcnt vmcnt(0)" ::: "memory");
            const unsigned og = xb_add(&bar[XB_TOP], 1u);
            const unsigned tg = og / nx;
            if (og + 1u == (tg + 1u) * nx) xb_add(&bar[XB_TOPGEN], 1u);
            else XB_SPIN(xb_ld(&bar[XB_TOPGEN]) == tg, bar);
            __builtin_amdgcn_fence(__ATOMIC_ACQUIRE, "agent");
            xb_add(&bar[XB_XGEN(b.x)], 1u);
            asm volatile("s_waitcnt vmcnt(0)" ::: "memory");
        } else {
            XB_SPIN(xb_ld(&bar[XB_XGEN(b.x)]) == gen, bar);
            __builtin_amdgcn_fence(__ATOMIC_ACQUIRE, "agent");
            asm volatile("s_waitcnt vmcnt(0)" ::: "memory");
        }
    }
    __syncthreads();
}
template <bool PERMQK>
__device__ __forceinline__ void p0_transpose_item(const float* W, int K, int N, bf16* WT, LAS float* scr, int item, int lane) {
    const int nblk = N / 32, kb = item / nblk, nb = item % nblk, k0 = 64 * kb, n0 = 32 * nb;
    float wv[32];
#pragma unroll
    for (int i = 0; i < 32; ++i) { const int kk = 2 * i + (lane >> 5); wv[i] = W[(size_t)(k0 + kk) * N + n0 + (lane & 31)]; }
#pragma unroll
    for (int i = 0; i < 32; ++i) { const int kk = 2 * i + (lane >> 5); scr[kk * 33 + (lane & 31)] = wv[i]; }
    LDS_WAIT(); asm volatile("" ::: "memory");
    const int c = lane & 7;
    const int r0 = PERMQK ? win_row_of_col(n0) : n0;
#pragma unroll
    for (int j = 0; j < 4; ++j) { const int n = (lane >> 3) + 8 * j; const LAS float* s = scr + (8 * c) * 33 + n;
        v4u o; o.x = pkbf(s[0 * 33], s[1 * 33]); o.y = pkbf(s[2 * 33], s[3 * 33]); o.z = pkbf(s[4 * 33], s[5 * 33]); o.w = pkbf(s[6 * 33], s[7 * 33]);
        *(GAS v4u*)(WT + (size_t)(r0 + n) * K + k0 + 8 * c) = o; }
    LDS_WAIT(); asm volatile("" ::: "memory");
}
__device__ __forceinline__ void rms_rows4_to_bf16(const float* xp, const float* xs, const float* g, bf16* XN, int m0, int mstride, int lane) {
    f32x4 v[4][4]; bool ok[4];
#pragma unroll
    for (int r = 0; r < 4; ++r) { const int m = m0 + r * mstride; ok[r] = m < MT; const int mm = ok[r] ? m : m0;
        const GAS f32x4* xr = (const GAS f32x4*)(mm < MP ? xp + (size_t)mm * 1024 : xs + (size_t)(mm - MP) * 1024) + lane;
#pragma unroll
        for (int j = 0; j < 4; ++j) v[r][j] = xr[64 * j]; }
    f32x4 gg[4];
#pragma unroll
    for (int j = 0; j < 4; ++j) gg[j] = ((const GAS f32x4*)g + lane)[64 * j];
#pragma unroll
    for (int r = 0; r < 4; ++r) { float s = 0.f;
#pragma unroll
        for (int j = 0; j < 4; ++j) s += (v[r][j].x * v[r][j].x + v[r][j].y * v[r][j].y) + (v[r][j].z * v[r][j].z + v[r][j].w * v[r][j].w);
        const float rstd = __builtin_amdgcn_rsqf(wave_sum(s) * (1.f / 1024.f) + 1e-6f);
        if (ok[r]) { GAS unsigned long long* o8 = (GAS unsigned long long*)(XN + (size_t)(m0 + r * mstride) * 1024) + lane;
#pragma unroll
            for (int j = 0; j < 4; ++j) o8[64 * j] = (unsigned long long)pkbf(v[r][j].x * rstd * gg[j].x, v[r][j].y * rstd * gg[j].y) | ((unsigned long long)pkbf(v[r][j].z * rstd * gg[j].z, v[r][j].w * rstd * gg[j].w) << 32); } }
}
__device__ __forceinline__ void rope_entry(int pos, int i, float* tab) {
    const double rev[8] = {0.15915494309189535, 0.03086376340470123, 0.005985185712713705, 0.001160663641240061, 0.00022507907903927653, 4.364795279280289e-05, 8.464330808241401e-06, 1.6414262627950345e-06};
    double r = rev[0];
#pragma unroll
    for (int k = 1; k < 8; ++k) r = (i == k) ? rev[k] : r;
    double x = (double)pos * r; x -= __builtin_rint(x);
    const float xf = (float)x;
    tab[pos * 16 + i] = __builtin_amdgcn_cosf(xf); tab[pos * 16 + 8 + i] = __builtin_amdgcn_sinf(xf);
}
typedef short s16x4h __attribute__((ext_vector_type(4)));
typedef float f32x16h __attribute__((ext_vector_type(16)));
typedef __attribute__((address_space(3))) const unsigned char* lcptr;
constexpr int HRS = 272;
constexpr int H_VT = 0, H_QT = 17408, H_KT = 2 * 17408, H_QP = 3 * 17408, H_SS = 4 * 17408, H_HQ = H_SS + 1024, H_LF = H_HQ + 17408, LFRS = 528, H_END = H_LF + 64 * LFRS;
static_assert(H_END <= 131072, "hgrn LDS map");
__device__ __forceinline__ s16x4h h_vtr(lcptr p) { return __builtin_bit_cast(s16x4h, __builtin_amdgcn_ds_read_tr16_b64_v4i16((__attribute__((address_space(3))) s16x4h*)p)); }
__device__ __forceinline__ int h_crow(int r, int hi) { return (r & 3) + 8 * (r >> 2) + 4 * hi; }
__device__ __forceinline__ bf16x8 h_cat(s16x4h a, s16x4h b) { return (bf16x8){a[0], a[1], a[2], a[3], b[0], b[1], b[2], b[3]}; }
__device__ __forceinline__ void h_stage_tile(LAS unsigned char* L, int off, const bf16* src, int tid) {
#pragma unroll
    for (int i = 0; i < 2; ++i) { const int e = tid + 512 * i, r = e >> 4, ch = e & 15;
        const v4u v = *(const GAS v4u*)(src + (size_t)r * 512 + ch * 8); *(LAS v4u*)(L + off + r * HRS + ch * 16) = v; }
}
__device__ __forceinline__ void h_stage_lf(LAS unsigned char* L, const float* src, int tid) {
    f32x4 v[4];
#pragma unroll
    for (int i = 0; i < 4; ++i) { const int e = tid + 512 * i, r = e >> 5, ch = e & 31; v[i] = *(const GAS f32x4*)(src + (size_t)r * 512 + ch * 4); }
#pragma unroll
    for (int i = 0; i < 4; ++i) { const int e = tid + 512 * i, r = e >> 5, ch = e & 31; *(LAS f32x4*)(L + H_LF + r * LFRS + ch * 16) = v[i]; }
}
__device__ __forceinline__ void h_cumsum(const LAS unsigned char* L, int d, int kg, float (&lf)[32], float (&b)[32], float& bC, float& bMid) {
#pragma unroll
    for (int s = 0; s < 32; ++s) lf[s] = *(const LAS float*)(L + H_LF + (32 * kg + s) * LFRS + d * 4);
    float c = 0.f;
#pragma unroll
    for (int s = 0; s < 32; ++s) { c += lf[s]; b[s] = c; }
    const float Tp = __shfl_xor(c, 32);
    const float P = kg ? Tp : 0.f;
#pragma unroll
    for (int s = 0; s < 32; ++s) b[s] += P;
    bC = c + Tp; bMid = kg ? Tp : c;
}
__device__ __forceinline__ float ex(float x) { return __builtin_amdgcn_exp2f(x * LOG2E); }

__device__ __forceinline__ void hgrn_a_item(LAS unsigned char* L, int bh, int c, const float* LF, const bf16* HIb, bf16* UT, float* GC, int tid, int lane, int wave) {
    const int b = bh >> 2, h = bh & 3; const size_t t0 = (size_t)b * SEQ + (size_t)c * 64;
    h_stage_tile(L, H_VT, HIb + t0 * 512 + h * 128, tid);
    h_stage_lf(L, LF + t0 * 512 + h * 128, tid);
    __syncthreads();
    const int dblk = wave & 3, vhalf = wave >> 2, i = lane & 31, kg = lane >> 5, d = 32 * dblk + i;
    float lf[32], bb[32], bC, bMid;
    h_cumsum(L, d, kg, lf, bb, bC, bMid);
    bf16x8 kf[4];
#pragma unroll
    for (int ks = 0; ks < 4; ++ks) { unsigned w[4];
#pragma unroll
        for (int j = 0; j < 4; ++j) { const int s0 = 8 * ks + 2 * j; w[j] = pkbf((1.f - ex(lf[s0])) * ex(bC - bb[s0]), (1.f - ex(lf[s0 + 1])) * ex(bC - bb[s0 + 1])); }
        kf[ks] = __builtin_bit_cast(bf16x8, (v4u){w[0], w[1], w[2], w[3]}); }
    if (vhalf == 0 && kg == 0) GC[((size_t)bh * 128 + c) * 128 + d] = ex(bC);
    const int q = (lane & 15) >> 2, p = lane & 3, g1 = (lane >> 4) & 1;
    f32x16h acc[2];
#pragma unroll
    for (int vt = 0; vt < 2; ++vt) { acc[vt] = f32x16h{};
        const lcptr vp = (lcptr)(L + H_VT) + (32 * kg + q) * HRS + (32 * (2 * vhalf + vt) + 16 * g1 + 4 * p) * 2;
#pragma unroll
        for (int ks = 0; ks < 4; ++ks) { const s16x4h lo = h_vtr(vp + (8 * ks) * HRS), hi4 = h_vtr(vp + (8 * ks + 4) * HRS);
            acc[vt] = __builtin_amdgcn_mfma_f32_32x32x16_bf16(h_cat(lo, hi4), kf[ks], acc[vt], 0, 0, 0); } }
    bf16* U = UT + ((size_t)bh * 128 + c) * 16384;
#pragma unroll
    for (int vt = 0; vt < 2; ++vt)
#pragma unroll
        for (int r = 0; r < 16; ++r) U[(size_t)(32 * (2 * vhalf + vt) + h_crow(r, kg)) * 128 + d] = (bf16)(pkbf(acc[vt][r], 0.f) & 0xffffu);
    __syncthreads();
}

#define H_BAR() asm volatile("s_waitcnt lgkmcnt(0)\n\ts_barrier" ::: "memory")
struct HTileRegs { v4u v[2]; v4u q[2]; f32x4 lf[4]; };
template <bool WITHQ> __device__ __forceinline__ void h_tiles_load(HTileRegs& R, const bf16* HIb, const bf16* HQb, const float* LF, size_t t0, int h, int tid) {
#pragma unroll
    for (int i = 0; i < 2; ++i) { const int e = tid + 512 * i, r = e >> 4, ch = e & 15; R.v[i] = *(const GAS v4u*)(HIb + (t0 + r) * 512 + h * 128 + ch * 8);
        if (WITHQ) R.q[i] = *(const GAS v4u*)(HQb + (t0 + r) * 512 + h * 128 + ch * 8); }
#pragma unroll
    for (int i = 0; i < 4; ++i) { const int e = tid + 512 * i, r = e >> 5, ch = e & 31; R.lf[i] = *(const GAS f32x4*)(LF + (t0 + r) * 512 + h * 128 + ch * 4); }
}
template <bool WITHQ> __device__ __forceinline__ void h_tiles_store(LAS unsigned char* L, const HTileRegs& R, int tid) {
#pragma unroll
    for (int i = 0; i < 2; ++i) { const int e = tid + 512 * i, r = e >> 4, ch = e & 15; *(LAS v4u*)(L + H_VT + r * HRS + ch * 16) = R.v[i];
        if (WITHQ) *(LAS v4u*)(L + H_HQ + r * HRS + ch * 16) = R.q[i]; }
#pragma unroll
    for (int i = 0; i < 4; ++i) { const int e = tid + 512 * i, r = e >> 5, ch = e & 31; *(LAS f32x4*)(L + H_LF + r * LFRS + ch * 16) = R.lf[i]; }
}
__device__ __forceinline__ size_t h_t0(int it) { return (size_t)(it >> 9) * SEQ + (size_t)(it & 127) * 64; }
__device__ __forceinline__ void hgrn_a_phase(LAS unsigned char* L, int it0, int step, int end, const float* LF, const bf16* HIb, bf16* UT, float* GC, int tid, int lane, int wave) {
    HTileRegs R;
    if (it0 < end) h_tiles_load<false>(R, HIb, nullptr, LF, h_t0(it0), (it0 >> 7) & 3, tid);
    for (int it = it0; it < end; it += step) {
        const int bh = it >> 7, c = it & 127;
        h_tiles_store<false>(L, R, tid);
        H_BAR();
        __builtin_amdgcn_sched_barrier(0);
        if (it + step < end) h_tiles_load<false>(R, HIb, nullptr, LF, h_t0(it + step), ((it + step) >> 7) & 3, tid);
        __builtin_amdgcn_sched_barrier(0);
        const int dblk = wave & 3, vhalf = wave >> 2, i = lane & 31, kg = lane >> 5, d = 32 * dblk + i;
        float lf[32], bb[32], bC, bMid;
        h_cumsum(L, d, kg, lf, bb, bC, bMid);
        bf16x8 kf[4];
#pragma unroll
        for (int ks = 0; ks < 4; ++ks) { unsigned w[4];
#pragma unroll
            for (int j = 0; j < 4; ++j) { const int s0 = 8 * ks + 2 * j; w[j] = pkbf((1.f - ex(lf[s0])) * ex(bC - bb[s0]), (1.f - ex(lf[s0 + 1])) * ex(bC - bb[s0 + 1])); }
            kf[ks] = __builtin_bit_cast(bf16x8, (v4u){w[0], w[1], w[2], w[3]}); }
        if (vhalf == 0 && kg == 0) GC[((size_t)bh * 128 + c) * 128 + d] = ex(bC);
        const int q = (lane & 15) >> 2, p = lane & 3, g1 = (lane >> 4) & 1;
        f32x16h acc[2];
#pragma unroll
        for (int vt = 0; vt < 2; ++vt) { acc[vt] = f32x16h{};
            const lcptr vp = (lcptr)(L + H_VT) + (32 * kg + q) * HRS + (32 * (2 * vhalf + vt) + 16 * g1 + 4 * p) * 2;
#pragma unroll
            for (int ks = 0; ks < 4; ++ks) { const s16x4h lo = h_vtr(vp + (8 * ks) * HRS), hi4 = h_vtr(vp + (8 * ks + 4) * HRS);
                acc[vt] = __builtin_amdgcn_mfma_f32_32x32x16_bf16(h_cat(lo, hi4), kf[ks], acc[vt], 0, 0, 0); } }
        bf16* U = UT + ((size_t)bh * 128 + c) * 16384;
#pragma unroll
        for (int vt = 0; vt < 2; ++vt)
#pragma unroll
            for (int r = 0; r < 16; ++r) U[(size_t)(32 * (2 * vhalf + vt) + h_crow(r, kg)) * 128 + d] = (bf16)(pkbf(acc[vt][r], 0.f) & 0xffffu);
        H_BAR();
    }
    asm volatile("s_waitcnt vmcnt(0)" ::: "memory");
}
__device__ __forceinline__ void hgrn_scan(const bf16* UT, const float* GC, bf16* ST, float* outS, int e0, int estride) {
    for (int e = e0; e < 8 * 16384; e += estride) {
        const int bh = e >> 14, vd = e & 16383, d = e & 127, v = vd >> 7;
        const bf16* U = UT + (size_t)bh * 128 * 16384 + vd; const float* Gp = GC + (size_t)bh * 128 * 128 + d; bf16* Sp = ST + (size_t)bh * 128 * 16384 + vd;
        float S = 0.f;
        unsigned short ua[32], ub[32]; float ga[32], gb[32];
#define SC_LOAD(UU, GG, C0) do { _Pragma("unroll") for (int k = 0; k < 32; ++k) { UU[k] = U[(size_t)((C0) + k) * 16384]; GG[k] = Gp[((C0) + k) * 128]; } } while (0)
#define SC_RUN(UU, GG, C0) do { _Pragma("unroll") for (int k = 0; k < 32; ++k) { Sp[(size_t)((C0) + k) * 16384] = (bf16)(pkbf(S, 0.f) & 0xffffu); S = GG[k] * S + bf2f(UU[k]); } } while (0)
        SC_LOAD(ua, ga, 0); __builtin_amdgcn_sched_barrier(0);
        SC_LOAD(ub, gb, 32); __builtin_amdgcn_sched_barrier(0);
        SC_RUN(ua, ga, 0); __builtin_amdgcn_sched_barrier(0);
        SC_LOAD(ua, ga, 64); __builtin_amdgcn_sched_barrier(0);
        SC_RUN(ub, gb, 32); __builtin_amdgcn_sched_barrier(0);
        SC_LOAD(ub, gb, 96); __builtin_amdgcn_sched_barrier(0);
        SC_RUN(ua, ga, 64); __builtin_amdgcn_sched_barrier(0);
        SC_RUN(ub, gb, 96);
#undef SC_LOAD
#undef SC_RUN
        outS[((size_t)bh * 128 + d) * 128 + v] = S;
    }
}
__device__ __forceinline__ void hgrn_c_item(LAS unsigned char* L, int bh, int c, const float* LF, const bf16* HQb, const bf16* HIb, const bf16* HGb, const bf16* ST, const float* hgn_g, bf16* MIX, int tid, int lane, int wave) {
    const int b = bh >> 2, h = bh & 3; const size_t t0 = (size_t)b * SEQ + (size_t)c * 64;
    h_stage_tile(L, H_VT, HIb + t0 * 512 + h * 128, tid);
    h_stage_tile(L, H_HQ, HQb + t0 * 512 + h * 128, tid);
    h_stage_lf(L, LF + t0 * 512 + h * 128, tid);
    __syncthreads();
    {
        const int dblk = wave & 3, i = lane & 31, kg = lane >> 5, d = 32 * dblk + i;
        float lf[32], bb[32], bC, bMid;
        h_cumsum(L, d, kg, lf, bb, bC, bMid);
        if (wave < 4) {
#pragma unroll
            for (int s = 0; s < 32; ++s) { const int t = 32 * kg + s; const float qv = bf2f(*(const LAS bf16*)(L + H_HQ + t * HRS + d * 2));
                *(LAS bf16*)(L + H_QT + t * HRS + d * 2) = (bf16)(pkbf(qv * ex(bb[s] - bMid), 0.f) & 0xffffu);
                *(LAS bf16*)(L + H_QP + t * HRS + d * 2) = (bf16)(pkbf(qv * ex(bb[s]), 0.f) & 0xffffu); }
        } else {
#pragma unroll
            for (int s = 0; s < 32; ++s) { const int t = 32 * kg + s;
                *(LAS bf16*)(L + H_KT + t * HRS + d * 2) = (bf16)(pkbf((1.f - ex(lf[s])) * ex(bMid - bb[s]), 0.f) & 0xffffu); }
        }
    }
    __syncthreads();
    const int tb = wave & 1, vb = wave >> 1, n = lane & 31, hi = lane >> 5;
    const int q = (lane & 15) >> 2, p = lane & 3, g1 = (lane >> 4) & 1;
    f32x16h o = f32x16h{};
    for (int sb = 0; sb <= tb; ++sb) {
        f32x16h at = f32x16h{};
#pragma unroll
        for (int ks = 0; ks < 8; ++ks) {
            const bf16x8 ka = *(const LAS bf16x8*)(L + H_KT + (32 * sb + n) * HRS + (16 * ks + 8 * hi) * 2);
            const bf16x8 qb = *(const LAS bf16x8*)(L + H_QT + (32 * tb + n) * HRS + (16 * ks + 8 * hi) * 2);
            at = __builtin_amdgcn_mfma_f32_32x32x16_bf16(ka, qb, at, 0, 0, 0);
        }
        if (sb == tb) {
#pragma unroll
            for (int r = 0; r < 16; ++r) if (h_crow(r, hi) > n) at[r] = 0.f;
        }
#pragma unroll
        for (int kk = 0; kk < 2; ++kk) {
            const v4u pw = {pkbf(at[8 * kk + 0], at[8 * kk + 1]), pkbf(at[8 * kk + 2], at[8 * kk + 3]), pkbf(at[8 * kk + 4], at[8 * kk + 5]), pkbf(at[8 * kk + 6], at[8 * kk + 7])};
            const lcptr vp = (lcptr)(L + H_VT) + (32 * sb + 16 * kk + 4 * hi + q) * HRS + (32 * vb + 16 * g1 + 4 * p) * 2;
            const s16x4h lo = h_vtr(vp), hi4 = h_vtr(vp + 8 * HRS);
            o = __builtin_amdgcn_mfma_f32_32x32x16_bf16(h_cat(lo, hi4), __builtin_bit_cast(bf16x8, pw), o, 0, 0, 0);
        }
    }
    {
        const bf16* Sr = ST + ((size_t)bh * 128 + c) * 16384 + (size_t)(32 * vb + n) * 128 + 8 * hi;
#pragma unroll
        for (int ks = 0; ks < 8; ++ks) {
            const bf16x8 sa = *(const GAS bf16x8*)(Sr + 16 * ks);
            const bf16x8 qb = *(const LAS bf16x8*)(L + H_QP + (32 * tb + n) * HRS + (16 * ks + 8 * hi) * 2);
            o = __builtin_amdgcn_mfma_f32_32x32x16_bf16(sa, qb, o, 0, 0, 0);
        }
    }
    float ss = 0.f;
#pragma unroll
    for (int r = 0; r < 16; ++r) ss += o[r] * o[r];
    ss += __shfl_xor(ss, 32);
    LAS float* SS = (LAS float*)(L + H_SS);
    if (hi == 0) SS[(32 * tb + n) * 4 + vb] = ss;
    __syncthreads();
    const f32x4 s4 = *(const LAS f32x4*)(SS + (32 * tb + n) * 4);
    const float rs = __builtin_amdgcn_rsqf(((s4[0] + s4[1]) + (s4[2] + s4[3])) * (1.f / 128.f) + 1e-6f);
    const size_t row = t0 + 32 * tb + n;
#pragma unroll
    for (int rg = 0; rg < 4; ++rg) { const int v = 32 * vb + 8 * rg + 4 * hi;
        const unsigned long long gz = *(const GAS unsigned long long*)(HGb + row * 512 + h * 128 + v); const f32x4 gn = *(const GAS f32x4*)(hgn_g + v);
        const float g0 = bf2f((unsigned short)gz), g1f = bf2f((unsigned short)(gz >> 16)), g2 = bf2f((unsigned short)(gz >> 32)), g3 = bf2f((unsigned short)(gz >> 48));
        const unsigned w0 = pkbf(o[4 * rg + 0] * rs * gn[0] * g0, o[4 * rg + 1] * rs * gn[1] * g1f), w1 = pkbf(o[4 * rg + 2] * rs * gn[2] * g2, o[4 * rg + 3] * rs * gn[3] * g3);
        *(GAS unsigned long long*)(MIX + row * 1024 + 512 + h * 128 + v) = (unsigned long long)w0 | ((unsigned long long)w1 << 32); }
    __syncthreads();
}
__device__ __forceinline__ void hgrn_c_phase(LAS unsigned char* L, int it0, int step, const float* LF, const bf16* HQb, const bf16* HIb, const bf16* HGb, const bf16* ST, const float* hgn_g, bf16* MIX, int tid, int lane, int wave) {
    HTileRegs R;
    const int tb = wave & 1, vb = wave >> 1, n = lane & 31, hi = lane >> 5;
    bf16x8 sfr[8], sfn[8]; unsigned long long gzr[4], gzn[4];
#define HC_LOAD_SG(IT, SF, GZ) do { const int bh_ = (IT) >> 7, c_ = (IT) & 127; const size_t t0_ = (size_t)(bh_ >> 2) * SEQ + (size_t)c_ * 64; \
        const bf16* Sr_ = ST + ((size_t)bh_ * 128 + c_) * 16384 + (size_t)(32 * vb + n) * 128 + 8 * hi; \
        _Pragma("unroll") for (int ks = 0; ks < 8; ++ks) SF[ks] = *(const GAS bf16x8*)(Sr_ + 16 * ks); \
        _Pragma("unroll") for (int rg = 0; rg < 4; ++rg) GZ[rg] = *(const GAS unsigned long long*)(HGb + (t0_ + 32 * tb + n) * 512 + (bh_ & 3) * 128 + 32 * vb + 8 * rg + 4 * hi); } while (0)
    if (it0 < 1024) { h_tiles_load<true>(R, HIb, HQb, LF, h_t0(it0), (it0 >> 7) & 3, tid); HC_LOAD_SG(it0, sfr, gzr); }
    for (int it = it0; it < 1024; it += step) {
    const int bh = it >> 7, c = it & 127;
    const int b = bh >> 2, h = bh & 3; const size_t t0 = (size_t)b * SEQ + (size_t)c * 64;
    h_tiles_store<true>(L, R, tid);
    H_BAR();
    __builtin_amdgcn_sched_barrier(0);
    if (it + step < 1024) { h_tiles_load<true>(R, HIb, HQb, LF, h_t0(it + step), ((it + step) >> 7) & 3, tid); HC_LOAD_SG(it + step, sfn, gzn); }
    __builtin_amdgcn_sched_barrier(0);
    {
        const int dblk = wave & 3, i = lane & 31, kg = lane >> 5, d = 32 * dblk + i;
        float lf[32], bb[32], bC, bMid;
        h_cumsum(L, d, kg, lf, bb, bC, bMid);
        if (wave < 4) {
#pragma unroll
            for (int s = 0; s < 32; ++s) { const int t = 32 * kg + s; const float qv = bf2f(*(const LAS bf16*)(L + H_HQ + t * HRS + d * 2));
                *(LAS bf16*)(L + H_QT + t * HRS + d * 2) = (bf16)(pkbf(qv * ex(bb[s] - bMid), 0.f) & 0xffffu);
                *(LAS bf16*)(L + H_QP + t * HRS + d * 2) = (bf16)(pkbf(qv * ex(bb[s]), 0.f) & 0xffffu); }
        } else {
#pragma unroll
            for (int s = 0; s < 32; ++s) { const int t = 32 * kg + s;
                *(LAS bf16*)(L + H_KT + t * HRS + d * 2) = (bf16)(pkbf((1.f - ex(lf[s])) * ex(bMid - bb[s]), 0.f) & 0xffffu); }
        }
    }
    H_BAR();
    const int q = (lane & 15) >> 2, p = lane & 3, g1 = (lane >> 4) & 1;
    f32x16h o = f32x16h{};
    for (int sb = 0; sb <= tb; ++sb) {
        f32x16h at = f32x16h{};
#pragma unroll
        for (int ks = 0; ks < 8; ++ks) {
            const bf16x8 ka = *(const LAS bf16x8*)(L + H_KT + (32 * sb + n) * HRS + (16 * ks + 8 * hi) * 2);
            const bf16x8 qb = *(const LAS bf16x8*)(L + H_QT + (32 * tb + n) * HRS + (16 * ks + 8 * hi) * 2);
            at = __builtin_amdgcn_mfma_f32_32x32x16_bf16(ka, qb, at, 0, 0, 0);
        }
        if (sb == tb) {
#pragma unroll
            for (int r = 0; r < 16; ++r) if (h_crow(r, hi) > n) at[r] = 0.f;
        }
#pragma unroll
        for (int kk = 0; kk < 2; ++kk) {
            const v4u pw = {pkbf(at[8 * kk + 0], at[8 * kk + 1]), pkbf(at[8 * kk + 2], at[8 * kk + 3]), pkbf(at[8 * kk + 4], at[8 * kk + 5]), pkbf(at[8 * kk + 6], at[8 * kk + 7])};
            const lcptr vp = (lcptr)(L + H_VT) + (32 * sb + 16 * kk + 4 * hi + q) * HRS + (32 * vb + 16 * g1 + 4 * p) * 2;
            const s16x4h lo = h_vtr(vp), hi4 = h_vtr(vp + 8 * HRS);
            o = __builtin_amdgcn_mfma_f32_32x32x16_bf16(h_cat(lo, hi4), __builtin_bit_cast(bf16x8, pw), o, 0, 0, 0);
        }
    }
    {
#pragma unroll
        for (int ks = 0; ks < 8; ++ks) {
            const bf16x8 sa = sfr[ks];
            const bf16x8 qb = *(const LAS bf16x8*)(L + H_QP + (32 * tb + n) * HRS + (16 * ks + 8 * hi) * 2);
            o = __builtin_amdgcn_mfma_f32_32x32x16_bf16(sa, qb, o, 0, 0, 0);
        }
    }
    float ss = 0.f;
#pragma unroll
    for (int r = 0; r < 16; ++r) ss += o[r] * o[r];
    ss += __shfl_xor(ss, 32);
    LAS float* SS = (LAS float*)(L + H_SS);
    if (hi == 0) SS[(32 * tb + n) * 4 + vb] = ss;
    H_BAR();
    const f32x4 s4 = *(const LAS f32x4*)(SS + (32 * tb + n) * 4);
    const float rs = __builtin_amdgcn_rsqf(((s4[0] + s4[1]) + (s4[2] + s4[3])) * (1.f / 128.f) + 1e-6f);
    const size_t row = t0 + 32 * tb + n;
#pragma unroll
    for (int rg = 0; rg < 4; ++rg) { const int v = 32 * vb + 8 * rg + 4 * hi;
        const unsigned long long gz = gzr[rg]; const f32x4 gn = *(const GAS f32x4*)(hgn_g + v);
        const float g0 = bf2f((unsigned short)gz), g1f = bf2f((unsigned short)(gz >> 16)), g2 = bf2f((unsigned short)(gz >> 32)), g3 = bf2f((unsigned short)(gz >> 48));
        const unsigned w0 = pkbf(o[4 * rg + 0] * rs * gn[0] * g0, o[4 * rg + 1] * rs * gn[1] * g1f), w1 = pkbf(o[4 * rg + 2] * rs * gn[2] * g2, o[4 * rg + 3] * rs * gn[3] * g3);
        *(GAS unsigned long long*)(MIX + row * 1024 + 512 + h * 128 + v) = (unsigned long long)w0 | ((unsigned long long)w1 << 32); }
    H_BAR();
#pragma unroll
    for (int ks = 0; ks < 8; ++ks) sfr[ks] = sfn[ks];
#pragma unroll
    for (int rg = 0; rg < 4; ++rg) gzr[rg] = gzn[rg];
    }
    asm volatile("s_waitcnt vmcnt(0)" ::: "memory");
#undef HC_LOAD_SG
}
constexpr int SM_COEF = 0, SM_VV = 128 * 20 * 4, SM_A = SM_VV + 8 * 128 * 4, SM_EK = SM_A + 64 * 4, SM_RED = SM_EK + 8 * 129 * 4, SM_EQ = SM_RED + 4 * 8 * 128 * 4, SM_END = SM_EQ + 8 * 129 * 4;
__device__ __forceinline__ void hgrn_s_item(LAS unsigned char* L, int b, int h, const float* LF, const bf16* HQb, const bf16* HIb, const bf16* HGb, const float* S0, const float* hgn_g, float* outS, bf16* MIX, int tid, int lane, int wave) {
    LAS float* COEF = (LAS float*)(L + SM_COEF);
    LAS float* VV = (LAS float*)(L + SM_VV);
    LAS float* AM = (LAS float*)(L + SM_A);
    LAS float* EK = (LAS float*)(L + SM_EK);
    LAS float* EQ = (LAS float*)(L + SM_EQ);
    LAS float* RED = (LAS float*)(L + SM_RED);
    const size_t r0 = (size_t)MP + (size_t)b * 8;
    if (tid < 128) { const int d = tid; float bsum = 0.f; float bt[8], kk[8];
#pragma unroll
        for (int t = 0; t < 8; ++t) { const float lf = LF[(r0 + t) * 512 + h * 128 + d]; bsum += lf; bt[t] = bsum; kk[t] = 1.f - ex(lf);
            const float qe = bf2f(HQb[(r0 + t) * 512 + h * 128 + d]) * ex(bsum); COEF[d * 20 + t] = qe; EQ[t * 129 + d] = qe; EK[t * 129 + d] = kk[t] * ex(-bsum); }
#pragma unroll
        for (int t = 0; t < 8; ++t) COEF[d * 20 + 8 + t] = kk[t] * ex(bsum - bt[t]);
        COEF[d * 20 + 16] = ex(bsum);
    } else if (tid < 256) { const int v = tid - 128;
#pragma unroll
        for (int s = 0; s < 8; ++s) VV[s * 128 + v] = bf2f(HIb[(r0 + s) * 512 + h * 128 + v]); }
    __syncthreads();
    if (tid < 64) { const int t = tid >> 3, s = tid & 7; float a = 0.f;
        if (s <= t) { for (int d = 0; d < 128; ++d) a += EQ[t * 129 + d] * EK[s * 129 + d]; }
        AM[t * 8 + s] = a; }
    {
        const int v = tid & 127, dq = tid >> 7; float vv[8], acc[8];
#pragma unroll
        for (int s = 0; s < 8; ++s) { vv[s] = VV[s * 128 + v]; acc[s] = 0.f; }
        const float* Sin = S0 + ((size_t)(b * 4 + h) * 128) * 128 + v; float* So = outS + ((size_t)(b * 4 + h) * 128) * 128 + v;
        float s0v[32];
#pragma unroll
        for (int dd = 0; dd < 32; ++dd) s0v[dd] = Sin[(size_t)(32 * dq + dd) * 128];
#pragma unroll
        for (int dd = 0; dd < 32; ++dd) { const int d = 32 * dq + dd; const float s0 = s0v[dd];
            const f32x4 c0 = *(const LAS f32x4*)(COEF + d * 20), c1 = *(const LAS f32x4*)(COEF + d * 20 + 4), c2 = *(const LAS f32x4*)(COEF + d * 20 + 8), c3 = *(const LAS f32x4*)(COEF + d * 20 + 12); const float gd = COEF[d * 20 + 16];
            float sn = gd * s0;
            sn += c2[0] * vv[0]; sn += c2[1] * vv[1]; sn += c2[2] * vv[2]; sn += c2[3] * vv[3]; sn += c3[0] * vv[4]; sn += c3[1] * vv[5]; sn += c3[2] * vv[6]; sn += c3[3] * vv[7];
            So[(size_t)d * 128] = sn;
            acc[0] += c0[0] * s0; acc[1] += c0[1] * s0; acc[2] += c0[2] * s0; acc[3] += c0[3] * s0; acc[4] += c1[0] * s0; acc[5] += c1[1] * s0; acc[6] += c1[2] * s0; acc[7] += c1[3] * s0; }
#pragma unroll
        for (int t = 0; t < 8; ++t) RED[(dq * 8 + t) * 128 + v] = acc[t];
    }
    __syncthreads();
    {
        const int t = wave; float o[2];
#pragma unroll
        for (int k = 0; k < 2; ++k) { const int v = lane + 64 * k; float a = (RED[(0 * 8 + t) * 128 + v] + RED[(1 * 8 + t) * 128 + v]) + (RED[(2 * 8 + t) * 128 + v] + RED[(3 * 8 + t) * 128 + v]);
#pragma unroll
            for (int s = 0; s < 8; ++s) a += AM[t * 8 + s] * VV[s * 128 + v];
            o[k] = a; }
        const float rs = __builtin_amdgcn_rsqf(wave_sum(o[0] * o[0] + o[1] * o[1]) * (1.f / 128.f) + 1e-6f);
#pragma unroll
        for (int k = 0; k < 2; ++k) { const int v = lane + 64 * k;
            MIX[(r0 + t) * 1024 + 512 + h * 128 + v] = (bf16)(pkbf(o[k] * rs * hgn_g[v] * bf2f(HGb[(r0 + t) * 512 + h * 128 + v]), 0.f) & 0xffffu); }
    }
    __syncthreads();
}
__device__ __forceinline__ void hgrn_s_phase(LAS unsigned char* L, int j0, int step, const float* LF, const bf16* HQb, const bf16* HIb, const bf16* HGb, const float* S0, const float* hgn_g, float* outS, bf16* MIX, int tid, int lane, int wave) {
    LAS float* COEF = (LAS float*)(L + SM_COEF);
    LAS float* VV = (LAS float*)(L + SM_VV);
    LAS float* AM = (LAS float*)(L + SM_A);
    LAS float* EK = (LAS float*)(L + SM_EK);
    LAS float* EQ = (LAS float*)(L + SM_EQ);
    LAS float* RED = (LAS float*)(L + SM_RED);
    float s0v[32];
#define HS_LOAD(J) do { const float* Sin_ = S0 + ((size_t)(J) * 128) * 128 + (tid & 127) + (size_t)(32 * (tid >> 7)) * 128; _Pragma("unroll") for (int dd = 0; dd < 32; ++dd) s0v[dd] = Sin_[(size_t)dd * 128]; } while (0)
    if (j0 < 512) HS_LOAD(j0);
    for (int j = j0; j < 512; j += step) {
    const int b = j >> 2, h = j & 3;
    const size_t r0 = (size_t)MP + (size_t)b * 8;
    if (tid < 128) { const int d = tid; float bsum = 0.f; float bt[8], kk[8];
#pragma unroll
        for (int t = 0; t < 8; ++t) { const float lf = LF[(r0 + t) * 512 + h * 128 + d]; bsum += lf; bt[t] = bsum; kk[t] = 1.f - ex(lf);
            const float qe = bf2f(HQb[(r0 + t) * 512 + h * 128 + d]) * ex(bsum); COEF[d * 20 + t] = qe; EQ[t * 129 + d] = qe; EK[t * 129 + d] = kk[t] * ex(-bsum); }
#pragma unroll
        for (int t = 0; t < 8; ++t) COEF[d * 20 + 8 + t] = kk[t] * ex(bsum - bt[t]);
        COEF[d * 20 + 16] = ex(bsum);
    } else if (tid < 256) { const int v = tid - 128;
#pragma unroll
        for (int s = 0; s < 8; ++s) VV[s * 128 + v] = bf2f(HIb[(r0 + s) * 512 + h * 128 + v]); }
    __syncthreads();
    if (tid < 64) { const int t = tid >> 3, s = tid & 7; float a = 0.f;
        if (s <= t) {
#pragma unroll 16
            for (int d = 0; d < 128; ++d) a += EQ[t * 129 + d] * EK[s * 129 + d]; }
        AM[t * 8 + s] = a; }
    {
        const int v = tid & 127, dq = tid >> 7; float vv[8], acc[8];
#pragma unroll
        for (int s = 0; s < 8; ++s) { vv[s] = VV[s * 128 + v]; acc[s] = 0.f; }
        float* So = outS + ((size_t)(b * 4 + h) * 128) * 128 + v;
#pragma unroll
        for (int dd = 0; dd < 32; ++dd) { const int d = 32 * dq + dd; const float s0 = s0v[dd];
            const f32x4 c0 = *(const LAS f32x4*)(COEF + d * 20), c1 = *(const LAS f32x4*)(COEF + d * 20 + 4), c2 = *(const LAS f32x4*)(COEF + d * 20 + 8), c3 = *(const LAS f32x4*)(COEF + d * 20 + 12); const float gd = COEF[d * 20 + 16];
            float sn = gd * s0;
            sn += c2[0] * vv[0]; sn += c2[1] * vv[1]; sn += c2[2] * vv[2]; sn += c2[3] * vv[3]; sn += c3[0] * vv[4]; sn += c3[1] * vv[5]; sn += c3[2] * vv[6]; sn += c3[3] * vv[7];
            So[(size_t)d * 128] = sn;
            acc[0] += c0[0] * s0; acc[1] += c0[1] * s0; acc[2] += c0[2] * s0; acc[3] += c0[3] * s0; acc[4] += c1[0] * s0; acc[5] += c1[1] * s0; acc[6] += c1[2] * s0; acc[7] += c1[3] * s0; }
#pragma unroll
        for (int t = 0; t < 8; ++t) RED[(dq * 8 + t) * 128 + v] = acc[t];
        __builtin_amdgcn_sched_barrier(0);
        if (j + step < 512) HS_LOAD(j + step);
        __builtin_amdgcn_sched_barrier(0);
    }
    H_BAR();
    {
        const int t = wave; float o[2];
#pragma unroll
        for (int k = 0; k < 2; ++k) { const int v = lane + 64 * k; float a = (RED[(0 * 8 + t) * 128 + v] + RED[(1 * 8 + t) * 128 + v]) + (RED[(2 * 8 + t) * 128 + v] + RED[(3 * 8 + t) * 128 + v]);
#pragma unroll
            for (int s = 0; s < 8; ++s) a += AM[t * 8 + s] * VV[s * 128 + v];
            o[k] = a; }
        const float rs = __builtin_amdgcn_rsqf(wave_sum(o[0] * o[0] + o[1] * o[1]) * (1.f / 128.f) + 1e-6f);
#pragma unroll
        for (int k = 0; k < 2; ++k) { const int v = lane + 64 * k;
            MIX[(r0 + t) * 1024 + 512 + h * 128 + v] = (bf16)(pkbf(o[k] * rs * hgn_g[v] * bf2f(HGb[(r0 + t) * 512 + h * 128 + v]), 0.f) & 0xffffu); }
    }
    H_BAR();
    }
    asm volatile("s_waitcnt vmcnt(0)" ::: "memory");
#undef HS_LOAD
}

constexpr int SR_RED = 0;
struct HsRaw { float lf[8]; unsigned short hq[8]; unsigned short hi[8][2]; unsigned short hg[2]; float s0[16][2]; };
__device__ __forceinline__ void hs_load(HsRaw& R, int j, const float* LF, const bf16* HQb, const bf16* HIb, const bf16* HGb, const float* S0, int lane, int wave) {
    const int b = j >> 2, h = j & 3; const size_t r0 = (size_t)MP + (size_t)b * 8; const int d = 16 * wave + (lane & 15);
#pragma unroll
    for (int t = 0; t < 8; ++t) { R.lf[t] = LF[(r0 + t) * 512 + h * 128 + d]; R.hq[t] = HQb[(r0 + t) * 512 + h * 128 + d];
        R.hi[t][0] = HIb[(r0 + t) * 512 + h * 128 + lane]; R.hi[t][1] = HIb[(r0 + t) * 512 + h * 128 + lane + 64]; }
    R.hg[0] = HGb[(r0 + wave) * 512 + h * 128 + lane]; R.hg[1] = HGb[(r0 + wave) * 512 + h * 128 + lane + 64];
    const float* Sin_ = S0 + ((size_t)j * 128 + 16 * wave) * 128 + lane;
#pragma unroll
    for (int i = 0; i < 16; ++i) { R.s0[i][0] = Sin_[(size_t)i * 128]; R.s0[i][1] = Sin_[(size_t)i * 128 + 64]; }
}
__device__ __forceinline__ void hgrn_s_phase2(LAS unsigned char* L, int j0, int step, int end, const float* LF, const bf16* HQb, const bf16* HIb, const bf16* HGb, const float* S0, const float* hgn_g, float* outS, bf16* MIX, int tid, int lane, int wave) {
    LAS float* RED = (LAS float*)(L + SR_RED);
    HsRaw C, N;
    if (j0 < end) hs_load(C, j0, LF, HQb, HIb, HGb, S0, lane, wave);
    const float gn0 = hgn_g[lane], gn1 = hgn_g[lane + 64];
    for (int j = j0; j < end; j += step) {
        const int b = j >> 2, h = j & 3; const size_t r0 = (size_t)MP + (size_t)b * 8;
        __builtin_amdgcn_sched_barrier(0);
        if (j + step < end) hs_load(N, j + step, LF, HQb, HIb, HGb, S0, lane, wave);
        __builtin_amdgcn_sched_barrier(0);
        float ek[8], eq[8], gd; { float bsum = 0.f;
#pragma unroll
            for (int t = 0; t < 8; ++t) { const float lf = C.lf[t]; bsum += lf; ek[t] = (1.f - ex(lf)) * ex(-bsum); eq[t] = bf2f(C.hq[t]) * ex(bsum); }
            gd = ex(bsum); }
        float acc[8][2];
#pragma unroll
        for (int t = 0; t < 8; ++t) { acc[t][0] = 0.f; acc[t][1] = 0.f; }
        float* So = outS + ((size_t)j * 128 + 16 * wave) * 128 + lane;
#pragma unroll
        for (int i = 0; i < 16; ++i) {
            float w0 = C.s0[i][0], w1 = C.s0[i][1];
#pragma unroll
            for (int s = 0; s < 8; ++s) { const float ks = __uint_as_float(__builtin_amdgcn_readlane(__float_as_uint(ek[s]), i)), qs = __uint_as_float(__builtin_amdgcn_readlane(__float_as_uint(eq[s]), i));
                w0 += ks * bf2f(C.hi[s][0]); w1 += ks * bf2f(C.hi[s][1]); acc[s][0] += qs * w0; acc[s][1] += qs * w1; }
            const float gi = __uint_as_float(__builtin_amdgcn_readlane(__float_as_uint(gd), i));
            So[(size_t)i * 128] = gi * w0; So[(size_t)i * 128 + 64] = gi * w1;
        }
#pragma unroll
        for (int t = 0; t < 8; ++t) { RED[(wave * 8 + t) * 128 + lane] = acc[t][0]; RED[(wave * 8 + t) * 128 + lane + 64] = acc[t][1]; }
        H_BAR();
        {
            const int t = wave; float o[2];
#pragma unroll
            for (int k = 0; k < 2; ++k) { const int v = lane + 64 * k; float a = 0.f;
#pragma unroll
                for (int w = 0; w < 8; ++w) a += RED[(w * 8 + t) * 128 + v];
                o[k] = a; }
            const float rs = __builtin_amdgcn_rsqf(wave_sum(o[0] * o[0] + o[1] * o[1]) * (1.f / 128.f) + 1e-6f);
            MIX[(r0 + t) * 1024 + 512 + h * 128 + lane] = (bf16)(pkbf(o[0] * rs * gn0 * bf2f(C.hg[0]), 0.f) & 0xffffu);
            MIX[(r0 + t) * 1024 + 512 + h * 128 + lane + 64] = (bf16)(pkbf(o[1] * rs * gn1 * bf2f(C.hg[1]), 0.f) & 0xffffu);
        }
        H_BAR();
        C = N;
    }
    asm volatile("s_waitcnt vmcnt(0)" ::: "memory");
}
typedef float f32x4d __attribute__((ext_vector_type(4)));
constexpr int DVRS = 272, DVR = 32 * DVRS;
constexpr int DC_PO = 0, DC_PM = 8 * DVR, DC_PL = DC_PM + 8 * 16 * 4, DC_SN = DC_PL + 8 * 16 * 4, DC_SQ = DC_SN + 2 * 8 * 16 * 4, DC_END = DC_SQ + 2 * 8 * 2 * 4;
static_assert(DVR >= 128 * 16 * 4 && DC_END <= 131072, "decode LDS map");
__device__ __forceinline__ bf16x8 cvt8(const f32x4d a, const f32x4d b) { v4u w = {pkbf(a[0], a[1]), pkbf(a[2], a[3]), pkbf(b[0], b[1]), pkbf(b[2], b[3])}; return __builtin_bit_cast(bf16x8, w); }
__device__ __forceinline__ float lam_value(const float* lq1, const float* lk1, const float* lq2, const float* lk2, int lane) {
    const float a = wave_sum(lq1[lane] * lk1[lane]), b = wave_sum(lq2[lane] * lk2[lane]);
    return ex(a) - ex(b) + 0.2f;
}
__device__ __forceinline__ void dec_item(LAS unsigned char* L, int b, int hp, const float* ck, const float* cv, const int* ptab, const bf16* Qb, const bf16* Kb, const bf16* Vb, const bf16* AGb,
                                         const float* subln_g, const float* lq1, const float* lk1, const float* lq2, const float* lk2, bf16* MIX, int tid_, int lane_, int wave) {
    int tid = tid_, lane = lane_;
    const int n = lane & 15, kg = lane >> 4;
    const int h = 2 * hp + (wave & 1), tq = wave >> 1;
    const size_t r0 = (size_t)MP + (size_t)b * 8;
    bf16x8 qx[4];
#pragma unroll
    for (int kk = 0; kk < 4; ++kk) { const bool on = (n < 8) == (kk < 2);
        v4u z = {0u, 0u, 0u, 0u};
        if (on) { const bf16* qp_ = Qb + (r0 + (n & 7)) * 512 + h * 128 + 32 * kk + 4 * kg; const unsigned long long lo_ = *(const GAS unsigned long long*)qp_, hi_ = *(const GAS unsigned long long*)(qp_ + 16);
            z = (v4u){(unsigned)lo_, (unsigned)(lo_ >> 32), (unsigned)hi_, (unsigned)(hi_ >> 32)}; }
        qx[kk] = __builtin_bit_cast(bf16x8, z); }
    f32x4d O[8];
#pragma unroll
    for (int mt = 0; mt < 8; ++mt) O[mt] = (f32x4d){0.f, 0.f, 0.f, 0.f};
    float m_run = -INFINITY, l_run = 0.f;
    LAS unsigned char* vst = L + DC_PO + wave * DVR;
    const lcptr vtr0 = (lcptr)vst + (4 * kg + ((lane & 15) >> 2)) * DVRS + (lane & 3) * 8;
    f32x4d kr[2][8], vr[16];
    const int pgv = ptab[b * 16 + (lane & 15)];
#define DEC_SB() __builtin_amdgcn_sched_barrier(0)
#define DEC_LOADK(IT) do { const int pg_ = __builtin_amdgcn_readlane(pgv, (IT)); const float* kb_ = ck + (((size_t)pg_ * 128 + tq * 32) * 4 + h) * 128 + (size_t)n * 512 + 4 * kg; \
        _Pragma("unroll") for (int tl = 0; tl < 2; ++tl) _Pragma("unroll") for (int kk = 0; kk < 4; ++kk) { const float* p = kb_ + (size_t)(16 * tl) * 512 + 32 * kk; kr[tl][2 * kk] = __builtin_nontemporal_load((const GAS f32x4d*)p); kr[tl][2 * kk + 1] = __builtin_nontemporal_load((const GAS f32x4d*)(p + 16)); } } while (0)
#define DEC_LOADV(IT) do { const int pg_ = __builtin_amdgcn_readlane(pgv, (IT)); const float* vb_ = cv + (((size_t)pg_ * 128 + tq * 32) * 4 + h) * 128 + (size_t)(lane >> 5) * 512 + (lane & 31) * 4; \
        _Pragma("unroll") for (int t = 0; t < 16; ++t) vr[t] = __builtin_nontemporal_load((const GAS f32x4d*)(vb_ + (size_t)(2 * t) * 512)); } while (0)
    DEC_LOADK(0); DEC_SB(); DEC_LOADV(0); DEC_SB();
    for (int it = 0; it < 16; ++it) {
        asm volatile("s_waitcnt vmcnt(16)" ::: "memory"); DEC_SB();
        f32x4d sa = (f32x4d){0.f, 0.f, 0.f, 0.f}, sb = (f32x4d){0.f, 0.f, 0.f, 0.f};
#pragma unroll
        for (int kk = 0; kk < 4; ++kk) { sa = __builtin_amdgcn_mfma_f32_16x16x32_bf16(cvt8(kr[0][2 * kk], kr[0][2 * kk + 1]), qx[kk], sa, 0, 0, 0);
                                         sb = __builtin_amdgcn_mfma_f32_16x16x32_bf16(cvt8(kr[1][2 * kk], kr[1][2 * kk + 1]), qx[kk], sb, 0, 0, 0); }
        DEC_SB();
        if (it < 15) { DEC_LOADK(it + 1); }
        DEC_SB();
        float mx = fmaxf(fmaxf(fmaxf(sa[0], sa[1]), fmaxf(sa[2], sa[3])), fmaxf(fmaxf(sb[0], sb[1]), fmaxf(sb[2], sb[3])));
        mx = fmaxf(mx, __shfl_xor(mx, 16)); mx = fmaxf(mx, __shfl_xor(mx, 32));
        const float m_new = fmaxf(m_run, mx); const float alpha = __builtin_amdgcn_exp2f(m_run - m_new); m_run = m_new;
        f32x4d pa, pb; float ps = 0.f;
#pragma unroll
        for (int r = 0; r < 4; ++r) { pa[r] = __builtin_amdgcn_exp2f(sa[r] - m_new); pb[r] = __builtin_amdgcn_exp2f(sb[r] - m_new); ps += pa[r] + pb[r]; }
        l_run = l_run * alpha + ps;
#pragma unroll
        for (int mt = 0; mt < 8; ++mt) O[mt] = O[mt] * alpha;
        const bf16x8 pB = cvt8(pa, pb);
        DEC_SB();
        if (it < 15) asm volatile("s_waitcnt vmcnt(16)" ::: "memory"); else asm volatile("s_waitcnt vmcnt(0)" ::: "memory");
        DEC_SB();
#pragma unroll
        for (int t = 0; t < 16; ++t) { const unsigned long long w = (unsigned long long)pkbf(vr[t][0], vr[t][1]) | ((unsigned long long)pkbf(vr[t][2], vr[t][3]) << 32);
            *(LAS unsigned long long*)(vst + (2 * t + (lane >> 5)) * DVRS + (lane & 31) * 8) = w; }
        DEC_SB();
        if (it < 15) { DEC_LOADV(it + 1); }
        DEC_SB();
#pragma unroll
        for (int mt = 0; mt < 8; ++mt) { const lcptr vp = vtr0 + mt * 32; const s16x4h lo = h_vtr(vp), hi4 = h_vtr(vp + 16 * DVRS);
            O[mt] = __builtin_amdgcn_mfma_f32_16x16x32_bf16(h_cat(lo, hi4), pB, O[mt], 0, 0, 0); }
    }
    asm volatile("s_waitcnt vmcnt(0)" ::: "memory");
#undef DEC_LOADV
#undef DEC_SB
#undef DEC_LOADK
    asm volatile("" : "+v"(tid), "+v"(lane));
    l_run += __shfl_xor(l_run, 16); l_run += __shfl_xor(l_run, 32);
    LAS float* PO = (LAS float*)(L + DC_PO); LAS float* PM = (LAS float*)(L + DC_PM); LAS float* PL = (LAS float*)(L + DC_PL); LAS float* SN = (LAS float*)(L + DC_SN); LAS float* SQ = (LAS float*)(L + DC_SQ);
#pragma unroll
    for (int mt = 0; mt < 8; ++mt)
#pragma unroll
        for (int r = 0; r < 4; ++r) PO[wave * (DVR / 4) + (16 * mt + 4 * kg + r) * 16 + n] = O[mt][r];
    if (kg == 0) { PM[wave * 16 + n] = m_run; PL[wave * 16 + n] = l_run; }
    const float lam = lam_value(lq1, lk1, lq2, lk2, lane);
    if (tid < 256) {
        const int hh = tid >> 7, j = (tid >> 4) & 7, col = tid & 15, q = col & 7, mp = col >> 3, h2 = 2 * hp + hh; float s = -INFINITY;
        if (j <= q) { s = 0.f; const GAS v4u* qp = (const GAS v4u*)(Qb + (r0 + q) * 512 + h2 * 128 + mp * 64); const GAS v4u* kp = (const GAS v4u*)(Kb + (r0 + j) * 512 + h2 * 128 + mp * 64);
            v4u qv[8], kv[8];
#pragma unroll
            for (int c8 = 0; c8 < 8; ++c8) { qv[c8] = qp[c8]; kv[c8] = kp[c8]; }
#pragma unroll
            for (int c8 = 0; c8 < 8; ++c8)
#pragma unroll
                for (int e = 0; e < 4; ++e) { s += __uint_as_float(qv[c8][e] << 16) * __uint_as_float(kv[c8][e] << 16); s += __uint_as_float(qv[c8][e] & 0xffff0000u) * __uint_as_float(kv[c8][e] & 0xffff0000u); } }
        SN[(hh * 8 + j) * 16 + col] = s;
    }
    __syncthreads();
    {
        const int dv = tid & 127, qg = tid >> 7; float o2[2][2];
#pragma unroll
        for (int hh = 0; hh < 2; ++hh) { const int h2 = 2 * hp + hh;
#pragma unroll
            for (int qq = 0; qq < 2; ++qq) { const int q = 2 * qg + qq; float res[2];
#pragma unroll
                for (int mp = 0; mp < 2; ++mp) { const int col = 8 * mp + q; float M = -INFINITY;
#pragma unroll
                    for (int w4 = 0; w4 < 4; ++w4) M = fmaxf(M, PM[(2 * w4 + hh) * 16 + col]);
#pragma unroll
                    for (int j = 0; j < 8; ++j) M = fmaxf(M, SN[(hh * 8 + j) * 16 + col]);
                    float Lsum = 0.f, Osum = 0.f;
#pragma unroll
                    for (int w4 = 0; w4 < 4; ++w4) { const int w = 2 * w4 + hh; const float wg = __builtin_amdgcn_exp2f(PM[w * 16 + col] - M); Lsum += wg * PL[w * 16 + col]; Osum += wg * PO[w * (DVR / 4) + dv * 16 + col]; }
#pragma unroll
                    for (int j = 0; j < 8; ++j) { const float wg = __builtin_amdgcn_exp2f(SN[(hh * 8 + j) * 16 + col] - M); Lsum += wg; Osum += wg * bf2f(Vb[(r0 + j) * 512 + h2 * 128 + dv]); }
                    res[mp] = Osum / Lsum; }
                o2[hh][qq] = res[0] - lam * res[1]; }
            const float s0 = wave_sum(o2[hh][0] * o2[hh][0]), s1 = wave_sum(o2[hh][1] * o2[hh][1]);
            if (lane == 0) { SQ[(hh * 8 + wave) * 2] = s0; SQ[(hh * 8 + wave) * 2 + 1] = s1; } }
        __syncthreads();
        const int wp = wave ^ 1;
#pragma unroll
        for (int hh = 0; hh < 2; ++hh) { const int h2 = 2 * hp + hh;
#pragma unroll
            for (int qq = 0; qq < 2; ++qq) { const int q = 2 * qg + qq; const float rs = __builtin_amdgcn_rsqf((SQ[(hh * 8 + wave) * 2 + qq] + SQ[(hh * 8 + wp) * 2 + qq]) * (1.f / 128.f) + 1e-6f);
                MIX[(r0 + q) * 1024 + h2 * 128 + dv] = (bf16)(pkbf(o2[hh][qq] * rs * subln_g[dv] * 0.8f * bf2f(AGb[(r0 + q) * 512 + h2 * 128 + dv]), 0.f) & 0xffffu); } }
    }
    __syncthreads();
}


template <int NR> __device__ __forceinline__ void attn_merge_rowsN(const bf16* OA, const bf16* AGb, const float* subln_g, float lam, bf16* MIX, int m0, int mstride, int lane) {
    const int half = lane >> 5, c = (2 * lane) & 63;
    unsigned a[NR][4], bq[NR][4], gz[NR][4];
#pragma unroll
    for (int r = 0; r < NR; ++r) { const int m = m0 + r * mstride; const size_t row = (size_t)(m < MP ? m : m0);
#pragma unroll
        for (int h = 0; h < 4; ++h) { a[r][h] = *(const GAS unsigned*)(OA + row * 1024 + (h * 4 + half) * 64 + c); bq[r][h] = *(const GAS unsigned*)(OA + row * 1024 + (h * 4 + 2 + half) * 64 + c);
            gz[r][h] = *(const GAS unsigned*)(AGb + row * 512 + h * 128 + 2 * lane); } }
    const float sg0 = subln_g[2 * lane] * 0.8f, sg1 = subln_g[2 * lane + 1] * 0.8f;
#pragma unroll
    for (int r = 0; r < NR; ++r) { const int m = m0 + r * mstride;
#pragma unroll
        for (int h = 0; h < 4; ++h) {
            const float o0 = bf2f((unsigned short)a[r][h]) - lam * bf2f((unsigned short)bq[r][h]), o1 = bf2f((unsigned short)(a[r][h] >> 16)) - lam * bf2f((unsigned short)(bq[r][h] >> 16));
            const float rs = __builtin_amdgcn_rsqf(wave_sum(o0 * o0 + o1 * o1) * (1.f / 128.f) + 1e-6f);
            const float g0 = sg0 * bf2f((unsigned short)gz[r][h]), g1 = sg1 * bf2f((unsigned short)(gz[r][h] >> 16));
            if (m < MP) *(GAS unsigned*)(MIX + (size_t)m * 1024 + h * 128 + 2 * lane) = pkbf(o0 * rs * g0, o1 * rs * g1); } }
}
struct Args { const void* in[18]; float* out; unsigned char* ws; int ph_lo, ph_hi, li, pad; };
__global__ void __launch_bounds__(NWAVES * 64, 2) mk_fwd(Args args) {
    extern __shared__ __attribute__((aligned(16))) unsigned char lds[];
    LAS unsigned char* L = (LAS unsigned char*)lds;
    volatile LAS unsigned* MISC = (volatile LAS unsigned*)(L + MISC_OFF);
    const int tid = threadIdx.x, lane = tid & 63, wave = __builtin_amdgcn_readfirstlane(tid >> 6);
    const int G = gridDim.x; const int bx = blockIdx.x; const int vcu = (G % 8 == 0) ? (bx % 8) * (G / 8) + bx / 8 : bx;
    unsigned char* ws = args.ws;
    gu32* ctl = (gu32*)(ws + WS_CTL);
    const float* xp = (const float*)args.in[0]; const float* xs = (const float*)args.in[1];
    const float* cache_k = (const float*)args.in[2]; const float* cache_v = (const float*)args.in[3]; const float* state0 = (const float*)args.in[4];
    const int* ptab = (const int*)args.in[5]; const float* norm_g = (const float*)args.in[6]; const float* w_in = (const float*)args.in[7];
    const float* qn_g = (const float*)args.in[8]; const float* kn_g = (const float*)args.in[9];
    const float* lq1 = (const float*)args.in[10]; const float* lk1 = (const float*)args.in[11]; const float* lq2 = (const float*)args.in[12]; const float* lk2 = (const float*)args.in[13];
    const float* subln_g = (const float*)args.in[14]; const float* lbl = (const float*)args.in[15]; const float* hgn_g = (const float*)args.in[16]; const float* w_out = (const float*)args.in[17];
    float* out = args.out;
    float* ROPE = (float*)(ws + WS_ROPE);
    bf16 *WinT = (bf16*)(ws + WS_WIN), *WoutT = (bf16*)(ws + WS_WOUT), *XN = (bf16*)(ws + WS_XN), *Qb = (bf16*)(ws + WS_Q), *Kb = (bf16*)(ws + WS_K), *Vb = (bf16*)(ws + WS_V),
         *AGb = (bf16*)(ws + WS_AG), *HQb = (bf16*)(ws + WS_HQ), *HIb = (bf16*)(ws + WS_HI), *HGb = (bf16*)(ws + WS_HG), *OA = (bf16*)(ws + WS_OA), *MIX = (bf16*)(ws + WS_MIX), *ST = (bf16*)(ws + WS_ST);
    float *LF = (float*)(ws + WS_LF), *GC = (float*)(ws + WS_GC); bf16* UT = (bf16*)(ws + WS_UT);


    for (int u = tid; u < (LDS_BYTES - LDSCTL_OFF) / 4; u += NWAVES * 64) ((LAS unsigned*)(L + LDSCTL_OFF))[u] = 0u;
    __syncthreads();
    XcdBarrier bar = xcd_barrier_post((unsigned*)(ctl + CW_BAR) + args.li * XCD_BAR_WORDS, MISC + 8);
    const int lo = args.ph_lo, hi = args.ph_hi;
#define IN(k) (lo <= (k) && (k) < hi)
#define BOTH(k) (IN(k) && IN((k) + 1))
#define GRID_BAR() xcd_barrier(bar)

    if (IN(0)) {
        LAS float* scr = (LAS float*)(L + RING_OFF + wave * 16384);
        const int gw = vcu * NWAVES + wave, NGW = G * NWAVES;
        constexpr int I_IN = (1024 / 64) * (DIN / 32), I_OUT = (1024 / 64) * (1024 / 32);
        for (int it = gw; it < I_IN + I_OUT; it += NGW) {
            if (it < I_IN) p0_transpose_item<true>(w_in, 1024, DIN, WinT, scr, it, lane);
            else p0_transpose_item<false>(w_out, 1024, 1024, WoutT, scr, it - I_IN, lane);
        }
        for (int m = gw; m < MT; m += 4 * NGW) rms_rows4_to_bf16(xp, xs, norm_g, XN, m, NGW, lane);
        for (int e = bx * (NWAVES * 64) + tid; e < 8192 * 8; e += G * NWAVES * 64) rope_entry(e >> 3, e & 7, ROPE);
        if (BOTH(0)) GRID_BAR();
    }
    if (IN(1)) {
        pg8::Gemm g{XN, WinT, MT, DIN, 1024};
        pg8::EpiProj E{Qb, Kb, Vb, AGb, HQb, HIb, HGb, LF, out + O_KP, out + O_KS, out + O_VP, out + O_VS, qn_g, kn_g, lbl, ROPE};
        const bool split = (G == 256) && BOTH(1);
        { const pg8::P1Order S{G, bx, 0, split ? 4 : (1 << 20)};
          pg8::gemm_phase<pg8::EpiProj, pg8::P1Order, true, true>(L + RING_OFF, g, S, E); }
        if (BOTH(1)) GRID_BAR();
        if (split && bx < 64) { const pg8::P1Order S{G, bx, 4, 1};
          pg8::gemm_phase<pg8::EpiProj, pg8::P1Order, true, true>(L + RING_OFF, g, S, E); }
    }
    if (IN(2)) {
        int a0 = vcu, as = G, ae = 1024, s0 = vcu, ss = G, se = 512;
        if (G == 256) {
            if (bx < 64) { a0 = 1024; s0 = 448 + bx; ss = 64; }
            else if (bx < 192) { a0 = bx - 64; as = 128; ae = 768; s0 = bx - 64; ss = 128; se = 256; }
            else { a0 = 768 + (bx - 192); as = 64; s0 = 256 + (bx - 192); ss = 64; se = 448; }
        }
        hgrn_a_phase(L + RING_OFF, a0, as, ae, LF, HIb, UT, GC, tid, lane, wave);
        hgrn_s_phase2(L + RING_OFF, s0, ss, se, LF, HQb, HIb, HGb, state0, hgn_g, out + O_SS, MIX, tid, lane, wave);

        if (BOTH(2)) GRID_BAR();
    }
    if (IN(3)) {
        hgrn_scan(UT, GC, ST, out + O_SP, bx * (NWAVES * 64) + tid, G * NWAVES * 64);
        __syncthreads();
        if (G == 256) {
            const int dgrp = (vcu >> 2) & 3;
            const int nbefore = dgrp == 0 ? 0 : dgrp == 3 ? 2 : 1;
            const attn128::StaticOrder S(G, bx); attn128::AttnUnit u;
#define ATTN_UNIT_(i) do { S.next((dgrp == 2) ? 1 - (i) : (i), u); attn128::attn_unit<8>(u.bh / attn128::NHEAD, u.bh % attn128::NHEAD, u.qb, (const attn128::bf16*)Qb, (const attn128::bf16*)Kb, (const attn128::bf16*)Vb, (attn128::bf16*)OA, (char*)lds + RING_OFF); } while (0)
            for (int i = 0; i < nbefore; ++i) ATTN_UNIT_(i);
            { int jv = vcu; asm volatile("" : "+s"(jv));
              for (int j = jv; j < 256; j += G) dec_item(L + RING_OFF, j >> 1, j & 1, cache_k, cache_v, ptab, Qb, Kb, Vb, AGb, subln_g, lq1, lk1, lq2, lk2, MIX, tid, lane, wave); }
            int i2 = nbefore; asm volatile("" : "+s"(i2));
            for (int i = i2; i < 2; ++i) ATTN_UNIT_(i);
#undef ATTN_UNIT_
        }
        if (BOTH(3)) GRID_BAR();
    }
    if (IN(4)) {
        if (G == 256 && vcu < 16) {
            pg8::Gemm g{MIX, WoutT, MT, 1024, 1024}; const pg8::OneUnit S1{64 + (vcu >> 2), vcu & 3};
            pg8::EpiOut E{xp, xs, out + O_YP};
            pg8::gemm_phase<pg8::EpiOut, pg8::OneUnit, true, true>(L + RING_OFF, g, S1, E);
            __syncthreads();
        } else if (G == 256) hgrn_c_phase(L + RING_OFF, vcu - 16, G - 16, LF, HQb, HIb, HGb, ST, hgn_g, MIX, tid, lane, wave);
        else hgrn_c_phase(L + RING_OFF, vcu, G, LF, HQb, HIb, HGb, ST, hgn_g, MIX, tid, lane, wave);
        { const float lam = lam_value(lq1, lk1, lq2, lk2, lane);
          for (int m = vcu * NWAVES + wave; m < MP; m += 8 * G * NWAVES) attn_merge_rowsN<8>(OA, AGb, subln_g, lam, MIX, m, G * NWAVES, lane); }
        if (BOTH(4)) GRID_BAR();
    }
    if (IN(5)) {
        const int mrows = (G == 256) ? MP : MT;
        pg8::Gemm g{MIX, WoutT, mrows, 1024, 1024}; pg8::StaticOrder S; S.init(mrows, 1024, G, bx);
        pg8::EpiOut E{xp, xs, out + O_YP};
        pg8::gemm_phase<pg8::EpiOut, pg8::StaticOrder, true, true>(L + RING_OFF, g, S, E);
    }
#undef IN
#undef BOTH
#undef GRID_BAR
}

static int mk_grid() {
    static int grid = 0;
    if (grid == 0) {
        int dev = 0, cus = 0, per_cu = 0;
        if (hipGetDevice(&dev) != hipSuccess || hipDeviceGetAttribute(&cus, hipDeviceAttributeMultiprocessorCount, dev) != hipSuccess) { grid = -1; return grid; }
        if (hipFuncSetAttribute((const void*)mk_fwd, hipFuncAttributeMaxDynamicSharedMemorySize, LDS_BYTES) != hipSuccess) { grid = -1; return grid; }
        if (hipOccupancyMaxActiveBlocksPerMultiprocessor(&per_cu, (const void*)mk_fwd, NWAVES * 64, LDS_BYTES) != hipSuccess || per_cu < 1) { (void)hipGetLastError(); fprintf(stderr, "mk: occupancy query says %d\n", per_cu); }
        grid = cus;
        if (grid != 256) fprintf(stderr, "mk: %d CUs; this kernel's unit orders are built for 256\n", grid);
    }
    return grid;
}
static void mk_launch(void* const* d_in, float* out, void* d_ws, hipStream_t stream, int lo, int hi, int li) {
    const int grid = mk_grid(); if (grid <= 0) return;
    Args a{}; for (int i = 0; i < 18; ++i) a.in[i] = d_in[i];
    a.out = out; a.ws = (unsigned char*)d_ws; a.ph_lo = lo; a.ph_hi = hi; a.li = li; a.pad = 0;
    hipLaunchKernelGGL(mk_fwd, dim3(grid), dim3(NWAVES * 64), LDS_BYTES, stream, a);
}
extern "C" void kernel_launch(void* const* d_in, const int* in_sizes, int n_in, void* d_out, int out_size, void* d_ws, size_t ws_size, hipStream_t stream) {
    if (hipMemsetAsync((char*)d_ws + WS_CTL, 0, CTL_ZERO_BYTES, stream) != hipSuccess) return;
    mk_launch(d_in, (float*)d_out, d_ws, stream, 0, 6, 0);
}
```

```cpp
#include <hip/hip_runtime.h>
#include <cstdio>
#include <cstdint>
#include <cmath>
constexpr int NWAVES = 8;
constexpr int MP = 16384, MS = 1024, MT = 17408, DMODEL = 1024, DIN = 4096, SEQ = 8192;
constexpr float C2 = 0.125f * 1.4426950408889634f;
constexpr float LOG2E = 1.4426950408889634f, LN2 = 0.6931471805599453f;
constexpr size_t MiB = 1u << 20;
constexpr size_t WS_CTL = 0, CTL_ZERO_BYTES = 1 * MiB;
constexpr size_t WS_ROPE = 1 * MiB, WS_WIN = 2 * MiB, WS_WOUT = 10 * MiB, WS_XN = 16 * MiB, WS_Q = 52 * MiB, WS_K = 70 * MiB, WS_V = 88 * MiB,
                 WS_AG = 106 * MiB, WS_HQ = 124 * MiB, WS_HI = 142 * MiB, WS_HG = 160 * MiB, WS_LF = 178 * MiB, WS_OA = 212 * MiB, WS_MIX = 244 * MiB,
                 WS_UT = 280 * MiB, WS_GC = 344 * MiB, WS_ST = 346 * MiB, WS_FAST_END = 380 * MiB;
constexpr size_t WS_ORACLE = 1536 * MiB;
constexpr int CW_TMO = 0, CW_CODE = 1, CW_BAR = 4096, CW_DIAG = 65536;
constexpr size_t WS_FOUT = 1024 * MiB;
constexpr size_t O_YP = 0, O_YS = O_YP + (size_t)MP * 1024, O_KP = O_YS + (size_t)MS * 1024, O_VP = O_KP + (size_t)MP * 512,
                 O_SP = O_VP + (size_t)MP * 512, O_KS = O_SP + (size_t)2 * 4 * 128 * 128, O_VS = O_KS + (size_t)MS * 512,
                 O_SS = O_VS + (size_t)MS * 512;
constexpr int RING_OFF = 0, RING_BYTES = 131072, LDSCTL_OFF = RING_BYTES, MISC_OFF = LDSCTL_OFF + 320, LDS_BYTES = 147456;

__device__ __forceinline__ float wave_sum(float v) {
#pragma unroll
    for (int o = 1; o < 64; o <<= 1) v += __shfl_xor(v, o);
    return v;
}
__device__ __forceinline__ float fast_silu(float x) { return x * __builtin_amdgcn_rcpf(1.f + __builtin_amdgcn_exp2f(-x * LOG2E)); }
__device__ __forceinline__ float fast_sigmoid(float x) { return __builtin_amdgcn_rcpf(1.f + __builtin_amdgcn_exp2f(-x * LOG2E)); }
__device__ __forceinline__ unsigned pkbf(float lo, float hi) { typedef float f2 __attribute__((ext_vector_type(2))); typedef __bf16 b2 __attribute__((ext_vector_type(2)));
    f2 v = {lo, hi}; b2 b = __builtin_convertvector(v, b2); return __builtin_bit_cast(unsigned, b); }
__device__ __forceinline__ float bf2f(unsigned short b) { return __uint_as_float((unsigned)b << 16); }
typedef _Float16 f16x2_t __attribute__((ext_vector_type(2)));
__device__ __forceinline__ unsigned pkh(float lo, float hi) { f16x2_t v = {(_Float16)lo, (_Float16)hi}; return __builtin_bit_cast(unsigned, v); }
__device__ __forceinline__ float h2f(unsigned short b) { return (float)__builtin_bit_cast(_Float16, b); }
__host__ __device__ __forceinline__ int win_row_of_col(int n) {
    if (n >= 1024) return n;
    const int pn = n >> 8, ca = n & 255, wc = ca >> 6, bj = (ca >> 5) & 1, r = ca & 31;
    return pn * 256 + 128 * bj + 32 * wc + r;
}
namespace pg8 {
#define PG8_LAS __attribute__((address_space(3)))
typedef unsigned short bf16_t;
typedef short bf16x8 __attribute__((ext_vector_type(8)));
typedef float f32x4 __attribute__((ext_vector_type(4)));
typedef unsigned u32x4 __attribute__((ext_vector_type(4)));
constexpr int BM = 256, BK = 64, HALF = 128, HTB = HALF * BK * 2  , STAGE_BYTES = 8 * HTB, NXCD = 8, WGM = 8;

__host__ __device__ __forceinline__ int lds_byte(int r, int c) { const int st = (r >> 4) * 2 + (c >> 5), rr = r & 15, cc = c & 31, ob = rr * 64 + cc * 2; return st * 1024 + (ob ^ (((ob >> 9) & 1) << 5)); }
__host__ __device__ __forceinline__ void stage_rc(int b, int& R, int& C) { const int st = b / 1024, sb = b % 1024, swz = sb ^ (((sb >> 9) & 1) << 5); R = (st >> 1) * 16 + swz / 64; C = (st & 1) * 32 + (swz % 64) / 2; }
__host__ __device__ __forceinline__ int perm32(int rho) { const int n = rho >> 4, i = rho & 15; return 8 * (i >> 2) + 4 * n + (i & 3); }

struct Unit { int pm, pn; };
struct Gemm { const bf16_t* A; const bf16_t* Bt; int M, N, K; };

struct StaticOrder {
    int nM, nN, nwg, G, c;
    __host__ __device__ void init(int M, int N, int G_, int c_) { nM = M / BM; nN = N / BM; nwg = nM * nN; G = G_; c = c_; }
    __host__ __device__ bool next(int i, Unit& u) const {
        const long L = (long)i * G + c; if (L >= nwg) return false;
        int wgid = (int)L; { const int q = nwg / NXCD, r = nwg % NXCD, xcd = wgid % NXCD, off = wgid / NXCD; wgid = (xcd < r ? xcd * (q + 1) : r * (q + 1) + (xcd - r) * q) + off; }
        const int nig = WGM * nN, gid = wgid / nig, fm = gid * WGM, gsz = (nM - fm) < WGM ? (nM - fm) : WGM;
        u.pm = fm + ((wgid % nig) % gsz); u.pn = (wgid % nig) / gsz; return true;
    }
    __device__ __forceinline__ void a_ready(const Unit&) const {}
    __device__ __forceinline__ void done(const Unit&) const {}
};

__device__ __forceinline__ unsigned cvt_pk_bf16(float lo, float hi) { unsigned r; asm volatile("v_cvt_pk_bf16_f32 %0, %1, %2" : "=v"(r) : "v"(lo), "v"(hi)); return r; }
typedef float f32x2 __attribute__((ext_vector_type(2)));
__device__ __forceinline__ f32x2 gelu_pk(f32x2 v) {
    const f32x2 av = __builtin_elementwise_abs(v), d = av * 0.2316418882f + 1.0f;
    f32x2 t; t.x = __builtin_amdgcn_rcpf(d.x); t.y = __builtin_amdgcn_rcpf(d.y);
    f32x2 q = t * 0.5307027145f + (-0.7265760135f); q = q * t + 0.7107068705f; q = q * t + (-0.142248368f); q = q * t + 0.127414796f; q = q * t;
    const f32x2 s = (v * v) * (-0.72134752044f);
    f32x2 e; e.x = __builtin_amdgcn_exp2f(s.x); e.y = __builtin_amdgcn_exp2f(s.y);
    const f32x2 m = v * (q * e), r = v - m;
    f32x2 o; o.x = v.x < 0.f ? m.x : r.x; o.y = v.y < 0.f ? m.y : r.y; return o;
}

template <int ACT  > struct EpiBf16 {
    static constexpr bool PERM = true, AFTER_DRAIN = false; static_assert(ACT == 0 || ACT == 1, "EpiBf16: ACT is 0 (none) or 1 (gelu_pk)");
    bf16_t* O; int ldc; const float* bias; int split_cols; size_t split_stride; float scale0;
    __device__ __forceinline__ void operator()(const f32x4 (&acc)[2][2][4][2], const Unit& u, int wr, int wc, int fr, int fq) const {
        const int row0 = u.pm * BM + wr * 64 + fr; int colt = u.pn * BM; bf16_t* base = O;
        float sc = 1.f; if (split_cols) { const int t = colt / split_cols; base += (size_t)t * split_stride; colt -= t * split_cols; if (t == 0) sc = scale0; }
        const int col0 = colt + wc * 32 + 8 * fq, bcol0 = u.pn * BM + wc * 32 + 8 * fq;
        f32x4 bv[2][2];
#pragma unroll
        for (int bj = 0; bj < 2; ++bj)
#pragma unroll
            for (int n = 0; n < 2; ++n) bv[bj][n] = bias ? *(const f32x4*)(bias + bcol0 + bj * HALF + 4 * n) : (f32x4){0.f, 0.f, 0.f, 0.f};
#pragma unroll
        for (int ai = 0; ai < 2; ++ai)
#pragma unroll
            for (int m = 0; m < 4; ++m) { bf16_t* rowp = base + (size_t)(row0 + ai * HALF + m * 16) * ldc + col0;
#pragma unroll
                for (int bj = 0; bj < 2; ++bj) { f32x4 v0 = acc[ai][bj][m][0] + bv[bj][0], v1 = acc[ai][bj][m][1] + bv[bj][1];
                    if (ACT == 1) { f32x2 a = gelu_pk((f32x2){v0[0], v0[1]}), b = gelu_pk((f32x2){v0[2], v0[3]}), c = gelu_pk((f32x2){v1[0], v1[1]}), d = gelu_pk((f32x2){v1[2], v1[3]});
                        v0 = (f32x4){a.x, a.y, b.x, b.y}; v1 = (f32x4){c.x, c.y, d.x, d.y}; }
                    v0 = v0 * sc; v1 = v1 * sc; u32x4 w; w.x = cvt_pk_bf16(v0[0], v0[1]); w.y = cvt_pk_bf16(v0[2], v0[3]); w.z = cvt_pk_bf16(v1[0], v1[1]); w.w = cvt_pk_bf16(v1[2], v1[3]);
                    *(u32x4*)(rowp + bj * HALF) = w; } }
    }
};

struct PanelStats {
    unsigned* xbuf;
    unsigned* cnt;
    unsigned* tmo;
    int ntn; float eps;
    unsigned code;
    __device__ __forceinline__ bool run(const f32x4 (&v)[2][2][4][2], const Unit& u, int wr, int wc, int fr, int fq, PG8_LAS unsigned char* lds, int wid, int lane) const {
        typedef float f32x2v __attribute__((ext_vector_type(2)));
        PG8_LAS f32x2v* P = (PG8_LAS f32x2v*)lds;
        PG8_LAS f32x2v* S = (PG8_LAS f32x2v*)(lds + 8192);
        PG8_LAS unsigned* flag = (PG8_LAS unsigned*)(lds + 8192 + 2048);
#pragma unroll
        for (int ai = 0; ai < 2; ++ai)
#pragma unroll
            for (int m = 0; m < 4; ++m) {
                float s = 0.f;
#pragma unroll
                for (int bj = 0; bj < 2; ++bj)
#pragma unroll
                    for (int n = 0; n < 2; ++n) { const f32x4 x = v[ai][bj][m][n]; s += (x[0] + x[1]) + (x[2] + x[3]); }
                s += __shfl_xor(s, 16); s += __shfl_xor(s, 32);
                const float mw = s * (1.0f / 64.0f); float q = 0.f;
#pragma unroll
                for (int bj = 0; bj < 2; ++bj)
#pragma unroll
                    for (int n = 0; n < 2; ++n) { const f32x4 d = v[ai][bj][m][n] - mw; q += (d[0] * d[0] + d[1] * d[1]) + (d[2] * d[2] + d[3] * d[3]); }
                q += __shfl_xor(q, 16); q += __shfl_xor(q, 32);
                if (fq == 0) P[(ai * HALF + wr * 64 + m * 16 + fr) * 4 + wc] = (f32x2v){mw, q};
            }
        asm volatile("s_waitcnt lgkmcnt(0)" ::: "memory"); __builtin_amdgcn_s_barrier(); asm volatile("" ::: "memory");
#if defined(BROKEN_EXCHANGE_NO_WAIT)
#warning BROKEN CONTROL BUILD: the row-statistics exchange does not wait; results are wrong by design
        if (blockIdx.x >= 64) { const long long t0_ = clock64(); while (clock64() - t0_ < 60000) __builtin_amdgcn_s_sleep(8); }
#endif
        const int row = wid * 32 + (lane & 31);
        if (lane < 32) {
            const f32x2v a = P[row * 4 + 0], b = P[row * 4 + 1], c = P[row * 4 + 2], d = P[row * 4 + 3];
            const float mt = (a.x + b.x + c.x + d.x) * 0.25f;
            const float da = a.x - mt, db = b.x - mt, dc = c.x - mt, dd = d.x - mt;
            const float m2 = (a.y + b.y) + (c.y + d.y) + 64.0f * ((da * da + db * db) + (dc * dc + dd * dd));
            unsigned long long* slot = (unsigned long long*)xbuf + ((size_t)(u.pm * BM + row) * 4 + u.pn);
            __hip_atomic_store(slot, ((unsigned long long)__float_as_uint(m2) << 32) | __float_as_uint(mt), __ATOMIC_RELAXED, __HIP_MEMORY_SCOPE_AGENT);
        }
        asm volatile("s_waitcnt vmcnt(0)" ::: "memory");
        if (lane == 0) __hip_atomic_fetch_add(cnt + 64 * u.pm, 1u, __ATOMIC_RELAXED, __HIP_MEMORY_SCOPE_AGENT);
        if (wid == 0) {
            bool dead = false; const unsigned long long t0 = __builtin_amdgcn_s_memrealtime(); const unsigned want = 8u * (unsigned)ntn;
            for (;;) {
#if defined(BROKEN_EXCHANGE_NO_WAIT)
                break;
#endif
                if ((unsigned)__builtin_amdgcn_readfirstlane(__hip_atomic_load(cnt + 64 * u.pm, __ATOMIC_RELAXED, __HIP_MEMORY_SCOPE_AGENT)) >= want) break;
                if (__builtin_amdgcn_s_memrealtime() - t0 > 2000000ull) {
                    if (lane == 0) { unsigned expect = 0u; __hip_atomic_compare_exchange_strong(tmo + 1, &expect, code | (unsigned)(u.pm & 0xff), __ATOMIC_RELAXED, __ATOMIC_RELAXED, __HIP_MEMORY_SCOPE_AGENT);
                                     __hip_atomic_store(tmo, 1u, __ATOMIC_RELAXED, __HIP_MEMORY_SCOPE_AGENT); }
                    dead = true; break; }
                __builtin_amdgcn_s_sleep(2);
            }
            __builtin_amdgcn_fence(__ATOMIC_ACQUIRE, "agent");
            if (lane == 0) flag[0] = dead ? 1u : 0u;
        }
        asm volatile("s_waitcnt vmcnt(0) lgkmcnt(0)" ::: "memory"); __builtin_amdgcn_s_barrier(); asm volatile("" ::: "memory");
        const bool bad = flag[0] != 0u;
        if (lane < 32) {
            const unsigned long long* slot = (const unsigned long long*)xbuf + (size_t)(u.pm * BM + row) * 4; float mt[4], m2[4]; float ms = 0.f;
#pragma unroll
            for (int t = 0; t < 4; ++t) { if (t < ntn) { const unsigned long long w = __hip_atomic_load(slot + t, __ATOMIC_RELAXED, __HIP_MEMORY_SCOPE_AGENT); mt[t] = __uint_as_float((unsigned)w); m2[t] = __uint_as_float((unsigned)(w >> 32)); } else { mt[t] = 0.f; m2[t] = 0.f; } ms += mt[t]; }
            const float mean = ms / (float)ntn; float q = 0.f;
#pragma unroll
            for (int t = 0; t < 4; ++t) if (t < ntn) { const float dm = mt[t] - mean; q += m2[t] + 256.0f * dm * dm; }
            S[row] = (f32x2v){mean, 1.0f / sqrtf(q / (256.0f * (float)ntn) + eps)};
        }
        asm volatile("s_waitcnt lgkmcnt(0)" ::: "memory"); __builtin_amdgcn_s_barrier(); asm volatile("" ::: "memory");
        return bad;
    }
};
struct EpiLnRes {
    static constexpr bool PERM = false, AFTER_DRAIN = true;
    const float* base; float* out; int ldc; const float* bias; PanelStats st; unsigned poison;
    __device__ __forceinline__ void fused(f32x4 (&acc)[2][2][4][2], const Unit& u, int wr, int wc, int fr, int fq, PG8_LAS unsigned char* lds, int wid, int lane) const {
        typedef float f32x2v __attribute__((ext_vector_type(2)));
        const PG8_LAS f32x2v* S = (const PG8_LAS f32x2v*)(lds + 8192);
        const int col0 = u.pn * BM + wc * 32 + 4 * fq;
#pragma unroll
        for (int bj = 0; bj < 2; ++bj)
#pragma unroll
            for (int n = 0; n < 2; ++n) { const f32x4 bv = bias ? *(const f32x4*)(bias + col0 + bj * HALF + n * 16) : (f32x4){0.f, 0.f, 0.f, 0.f};
#pragma unroll
                for (int ai = 0; ai < 2; ++ai)
#pragma unroll
                    for (int m = 0; m < 4; ++m) acc[ai][bj][m][n] += bv; }
        f32x4 pre[4][2][2];
#pragma unroll
        for (int m = 0; m < 4; ++m) { const size_t off = (size_t)(u.pm * BM + wr * 64 + m * 16 + fr) * ldc + col0;
#pragma unroll
            for (int bj = 0; bj < 2; ++bj)
#pragma unroll
                for (int n = 0; n < 2; ++n) pre[m][bj][n] = *(const f32x4*)(base + off + bj * HALF + n * 16); }
        const bool bad = st.run(acc, u, wr, wc, fr, fq, lds, wid, lane) || poison != 0u;
        const float qnan = __builtin_nanf("");
#pragma unroll
        for (int ai = 0; ai < 2; ++ai)
#pragma unroll
            for (int m = 0; m < 4; ++m) { const int r = ai * HALF + wr * 64 + m * 16 + fr; const f32x2v sr = S[r]; const size_t off = (size_t)(u.pm * BM + r) * ldc + col0;
#pragma unroll
                for (int bj = 0; bj < 2; ++bj)
#pragma unroll
                    for (int n = 0; n < 2; ++n) { const f32x4 bs = ai == 0 ? pre[m][bj][n] : *(const f32x4*)(base + off + bj * HALF + n * 16); f32x4 o = bs + (acc[ai][bj][m][n] - sr.x) * sr.y;
                        if (bad) o = (f32x4){qnan, qnan, qnan, qnan}; *(f32x4*)(out + off + bj * HALF + n * 16) = o; }
                if (m & 1) asm volatile("" ::: "memory"); }
    }
};
struct EpiLnResLn {
    static constexpr bool PERM = false, AFTER_DRAIN = true;
    const float* base; float* out; bf16_t* xn; int ldc; const float* bias; PanelStats st1, st2; unsigned poison;
    __device__ __forceinline__ void fused(f32x4 (&acc)[2][2][4][2], const Unit& u, int wr, int wc, int fr, int fq, PG8_LAS unsigned char* lds, int wid, int lane) const {
        typedef float f32x2v __attribute__((ext_vector_type(2))); typedef unsigned u32x2v __attribute__((ext_vector_type(2)));
        const PG8_LAS f32x2v* S = (const PG8_LAS f32x2v*)(lds + 8192);
        const int col0 = u.pn * BM + wc * 32 + 4 * fq;
#pragma unroll
        for (int bj = 0; bj < 2; ++bj)
#pragma unroll
            for (int n = 0; n < 2; ++n) { const f32x4 bv = bias ? *(const f32x4*)(bias + col0 + bj * HALF + n * 16) : (f32x4){0.f, 0.f, 0.f, 0.f};
#pragma unroll
                for (int ai = 0; ai < 2; ++ai)
#pragma unroll
                    for (int m = 0; m < 4; ++m) acc[ai][bj][m][n] += bv; }
        bool bad = st1.run(acc, u, wr, wc, fr, fq, lds, wid, lane) || poison != 0u;
        const float qnan = __builtin_nanf("");
#pragma unroll
        for (int ai = 0; ai < 2; ++ai)
#pragma unroll
            for (int m = 0; m < 4; ++m) { const int r = ai * HALF + wr * 64 + m * 16 + fr; const f32x2v sr = S[r]; const size_t off = (size_t)(u.pm * BM + r) * ldc + col0;
#pragma unroll
                for (int bj = 0; bj < 2; ++bj)
#pragma unroll
                    for (int n = 0; n < 2; ++n) { const f32x4 bs = *(const f32x4*)(base + off + bj * HALF + n * 16); acc[ai][bj][m][n] = bs + (acc[ai][bj][m][n] - sr.x) * sr.y; }
                asm volatile("" : "+v"(acc[ai][0][m][0]), "+v"(acc[ai][0][m][1]), "+v"(acc[ai][1][m][0]), "+v"(acc[ai][1][m][1]));
                if (m & 1) asm volatile("" ::: "memory"); }
        const bool bad1 = bad;
        bad = st2.run(acc, u, wr, wc, fr, fq, lds, wid, lane) || bad;
#pragma unroll
        for (int ai = 0; ai < 2; ++ai)
#pragma unroll
            for (int m = 0; m < 4; ++m) { const int r = ai * HALF + wr * 64 + m * 16 + fr; const f32x2v sr = S[r]; const size_t off = (size_t)(u.pm * BM + r) * ldc + col0;
#pragma unroll
                for (int bj = 0; bj < 2; ++bj)
#pragma unroll
                    for (int n = 0; n < 2; ++n) { const f32x4 x1 = acc[ai][bj][m][n]; *(f32x4*)(out + off + bj * HALF + n * 16) = bad1 ? (f32x4){qnan, qnan, qnan, qnan} : x1;
                        const f32x4 o = (x1 - sr.x) * sr.y; u32x2v w; w.x = cvt_pk_bf16(o[0], o[1]); w.y = cvt_pk_bf16(o[2], o[3]);
                        if (bad) { w.x = 0x7fc07fc0u; w.y = 0x7fc07fc0u; } *(u32x2v*)(xn + off + bj * HALF + n * 16) = w; }
                asm volatile("" ::: "memory"); }
    }
};

template <class Epi, class Sched, bool ALIGN_EPI = false, bool SP2 = false>
__device__ __forceinline__ void gemm_phase(PG8_LAS unsigned char* lds, const Gemm g, const Sched& S, const Epi& E) {
    int tid_ = threadIdx.x; asm volatile("" : "+v"(tid_));
    const int tid = tid_, wid = __builtin_amdgcn_readfirstlane(tid >> 6), lane = tid & 63, wr = wid >> 2, wc = wid & 3, fr = lane & 15, fq = lane >> 4;
    const int K = g.K, nt = K / BK;
    unsigned voffA[2], voffB[2];
#pragma unroll
    for (int i = 0; i < 2; ++i) { int R, C; stage_rc(tid * 16 + i * 8192, R, C); const int Rb = Epi::PERM ? ((R & ~31) + perm32(R & 31)) : R;
        voffA[i] = (unsigned)(R * K + C) * 2u; voffB[i] = (unsigned)(Rb * K + C) * 2u; }
    const size_t kstep = (size_t)(BK * 2);
    const size_t hstep = (size_t)HALF * K * 2;
    const size_t tstep = 2 * hstep;
    const unsigned ldsw = (unsigned)wid * 1024u;
    const int aoff = lds_byte(wr * 64 + fr, fq * 8), boff = lds_byte(wc * 32 + fr, fq * 8);
#define PG8_SA(b, h) (((b) * 2 + (h)) * HTB)
#define PG8_SB(b, h) ((4 + (b) * 2 + (h)) * HTB)
#define PG8_STAGE(bufoff, gbase, voff) do { _Pragma("unroll") for (int _i = 0; _i < 2; ++_i) \
        __builtin_amdgcn_global_load_lds((const unsigned*)((const char*)(gbase) + (voff)[_i]), (PG8_LAS unsigned*)(lds + (bufoff) + ldsw + _i * 8192), 16, 0, 0); } while (0)
#define PG8_LDA(dst, b, h) do { _Pragma("unroll") for (int m = 0; m < 4; ++m) _Pragma("unroll") for (int k = 0; k < 2; ++k) dst[m][k] = *(const PG8_LAS bf16x8*)(lds + PG8_SA(b, h) + aoff + m * 2048 + k * 1024); } while (0)
#define PG8_LDB(dst, b, h) do { _Pragma("unroll") for (int n = 0; n < 2; ++n) _Pragma("unroll") for (int k = 0; k < 2; ++k) dst[n][k] = *(const PG8_LAS bf16x8*)(lds + PG8_SB(b, h) + boff + n * 2048 + k * 1024); } while (0)
#define PG8_MMA(ai, bj, At, Bt) do { __builtin_amdgcn_s_setprio(1); _Pragma("unroll") for (int m = 0; m < 4; ++m) _Pragma("unroll") for (int n = 0; n < 2; ++n) _Pragma("unroll") for (int k = 0; k < 2; ++k) \
        acc[ai][bj][m][n] = __builtin_amdgcn_mfma_f32_16x16x32_bf16(Bt[n][k], At[m][k], acc[ai][bj][m][n], 0, 0, 0); __builtin_amdgcn_s_setprio(0); } while (0)
#define PG8_WAIT_V(n) asm volatile("s_waitcnt vmcnt(" #n ")" ::: "memory")
#define PG8_WAIT_L(n) asm volatile("s_waitcnt lgkmcnt(" #n ")" ::: "memory")
#define PG8_BAR __builtin_amdgcn_s_barrier()
#define PG8_SCHED __builtin_amdgcn_sched_barrier(0)
    Unit cur, nxt; int ui = 0;
    if (!S.next(0, cur)) return;
    f32x4 acc[2][2][4][2];
#pragma unroll
    for (int a = 0; a < 2; ++a)
#pragma unroll
        for (int b = 0; b < 2; ++b)
#pragma unroll
            for (int m = 0; m < 4; ++m)
#pragma unroll
                for (int n = 0; n < 2; ++n) acc[a][b][m][n] = (f32x4){0.f, 0.f, 0.f, 0.f};
    bf16x8 At[4][2], B0[2][2], B1[2][2];
    const char* cA = (const char*)g.A + (size_t)cur.pm * tstep; const char* cB = (const char*)g.Bt + (size_t)cur.pn * tstep;
    S.a_ready(cur);
    if constexpr (SP2) {
        PG8_STAGE(PG8_SB(0, 0), cB, voffB); PG8_STAGE(PG8_SB(0, 1), cB + hstep, voffB); PG8_STAGE(PG8_SA(0, 0), cA, voffA); PG8_STAGE(PG8_SA(0, 1), cA + hstep, voffA);
        if (wr == 1) PG8_BAR;
        PG8_WAIT_V(2); PG8_BAR;
        PG8_STAGE(PG8_SB(1, 0), cB + kstep, voffB); PG8_STAGE(PG8_SA(1, 0), cA + kstep, voffA); PG8_STAGE(PG8_SB(1, 1), cB + hstep + kstep, voffB);
        PG8_WAIT_V(6); PG8_BAR;
    } else {
        PG8_STAGE(PG8_SB(0, 0), cB, voffB); PG8_STAGE(PG8_SA(0, 0), cA, voffA); PG8_STAGE(PG8_SB(0, 1), cB + hstep, voffB); PG8_STAGE(PG8_SA(0, 1), cA + hstep, voffA);
        if (wr == 1) PG8_BAR;
        PG8_WAIT_V(4); PG8_BAR;
        PG8_STAGE(PG8_SB(1, 0), cB + kstep, voffB); PG8_STAGE(PG8_SA(1, 0), cA + kstep, voffA); PG8_STAGE(PG8_SB(1, 1), cB + hstep + kstep, voffB);
        PG8_WAIT_V(6); PG8_BAR;
    }
    for (;;) {
        const bool has_next = S.next(ui + 1, nxt);
        const char* nA = has_next ? (const char*)g.A + (size_t)nxt.pm * tstep : cA; const char* nB = has_next ? (const char*)g.Bt + (size_t)nxt.pn * tstep : cB;
        for (int t = 0; t < nt; t += 2) {
            const bool last = (t == nt - 2);
            const char* a1 = cA + (size_t)(t + 1) * kstep;
            const char* a2 = last ? nA : cA + (size_t)(t + 2) * kstep; const char* b2 = last ? nB : cB + (size_t)(t + 2) * kstep;
            const char* a3 = a2 + kstep; const char* b3 = b2 + kstep;
            if (last && has_next) S.a_ready(nxt);
            if constexpr (SP2) {
            PG8_LDB(B0, 0, 0); PG8_LDB(B1, 0, 1); PG8_SCHED; PG8_LDA(At, 0, 0); PG8_STAGE(PG8_SA(1, 1), a1 + hstep, voffA);
            PG8_WAIT_V(8); PG8_WAIT_L(0); PG8_BAR; PG8_MMA(0, 0, At, B0); PG8_MMA(0, 1, At, B1); PG8_BAR; PG8_SCHED;
            PG8_LDA(At, 0, 1); PG8_STAGE(PG8_SB(0, 0), b2, voffB); PG8_STAGE(PG8_SB(0, 1), b2 + hstep, voffB); PG8_STAGE(PG8_SA(0, 0), a2, voffA);
            PG8_WAIT_V(8); PG8_WAIT_L(0); PG8_BAR; PG8_MMA(1, 0, At, B0); PG8_MMA(1, 1, At, B1); PG8_BAR; PG8_SCHED;
            PG8_LDB(B0, 1, 0); PG8_LDB(B1, 1, 1); PG8_SCHED; PG8_LDA(At, 1, 0); PG8_STAGE(PG8_SA(0, 1), a2 + hstep, voffA);
            PG8_WAIT_V(8); PG8_WAIT_L(0); PG8_BAR; PG8_MMA(0, 0, At, B0); PG8_MMA(0, 1, At, B1); PG8_BAR; PG8_SCHED;
            PG8_LDA(At, 1, 1); PG8_STAGE(PG8_SB(1, 0), b3, voffB); PG8_STAGE(PG8_SB(1, 1), b3 + hstep, voffB); PG8_STAGE(PG8_SA(1, 0), a3, voffA);
            PG8_WAIT_V(8); PG8_WAIT_L(0); PG8_BAR; PG8_MMA(1, 0, At, B0); PG8_MMA(1, 1, At, B1); PG8_BAR; PG8_SCHED;
            } else {
            PG8_LDB(B0, 0, 0); PG8_SCHED; PG8_LDA(At, 0, 0); PG8_STAGE(PG8_SA(1, 1), a1 + hstep, voffA);
            PG8_WAIT_L(8); PG8_BAR; PG8_WAIT_L(0); PG8_MMA(0, 0, At, B0); PG8_BAR; PG8_SCHED;
            PG8_LDB(B1, 0, 1); PG8_STAGE(PG8_SB(0, 0), b2, voffB);
            PG8_BAR; PG8_WAIT_L(0); PG8_MMA(0, 1, At, B1); PG8_BAR;
            PG8_LDA(At, 0, 1); PG8_STAGE(PG8_SA(0, 0), a2, voffA);
            PG8_BAR; PG8_WAIT_L(0); PG8_MMA(1, 0, At, B0); PG8_BAR; PG8_SCHED;
            PG8_STAGE(PG8_SB(0, 1), b2 + hstep, voffB);
            PG8_WAIT_V(6); PG8_BAR; PG8_MMA(1, 1, At, B1); PG8_BAR;
            PG8_LDB(B0, 1, 0); PG8_SCHED; PG8_LDA(At, 1, 0); PG8_STAGE(PG8_SA(0, 1), a2 + hstep, voffA);
            PG8_WAIT_L(8); PG8_BAR; PG8_WAIT_L(0); PG8_MMA(0, 0, At, B0); PG8_BAR; PG8_SCHED;
            PG8_LDB(B1, 1, 1); PG8_STAGE(PG8_SB(1, 0), b3, voffB);
            PG8_BAR; PG8_WAIT_L(0); PG8_MMA(0, 1, At, B1); PG8_BAR;
            PG8_LDA(At, 1, 1); PG8_STAGE(PG8_SA(1, 0), a3, voffA);
            PG8_BAR; PG8_WAIT_L(0); PG8_MMA(1, 0, At, B0); PG8_BAR; PG8_SCHED;
            PG8_STAGE(PG8_SB(1, 1), b3 + hstep, voffB);
            PG8_WAIT_V(6); PG8_BAR; PG8_MMA(1, 1, At, B1); PG8_BAR;
            }
        }
        if constexpr (ALIGN_EPI) { if (wr == 0) PG8_BAR; }
        if constexpr (!Epi::AFTER_DRAIN) { E(acc, cur, wr, wc, fr, fq); S.done(cur); }
        if (!has_next) break;
#pragma unroll
        for (int a = 0; a < 2; ++a)
#pragma unroll
            for (int b = 0; b < 2; ++b)
#pragma unroll
                for (int m = 0; m < 4; ++m)
#pragma unroll
                    for (int n = 0; n < 2; ++n) acc[a][b][m][n] = (f32x4){0.f, 0.f, 0.f, 0.f};
        cur = nxt; cA = nA; cB = nB; ++ui;
        if constexpr (ALIGN_EPI) { if (wr == 1) PG8_BAR; }
    }
    PG8_WAIT_V(0);
    if constexpr (!ALIGN_EPI) { if (wr == 0) PG8_BAR; }
    PG8_BAR;
    if constexpr (Epi::AFTER_DRAIN) { E.fused(acc, cur, wr, wc, fr, fq, lds, wid, lane); S.done(cur); }
#undef PG8_SA
#undef PG8_SB
#undef PG8_STAGE
#undef PG8_LDA
#undef PG8_LDB
#undef PG8_MMA
#undef PG8_WAIT_V
#undef PG8_WAIT_L
#undef PG8_BAR
#undef PG8_SCHED
}
}
namespace pg8 {
__device__ __forceinline__ f32x4 shflx4(const f32x4 v, int m) { f32x4 r; r[0] = __shfl_xor(v[0], m); r[1] = __shfl_xor(v[1], m); r[2] = __shfl_xor(v[2], m); r[3] = __shfl_xor(v[3], m); return r; }
__device__ __forceinline__ u32x4 pack8(const f32x4 a, const f32x4 b) { u32x4 w; w.x = cvt_pk_bf16(a[0], a[1]); w.y = cvt_pk_bf16(a[2], a[3]); w.z = cvt_pk_bf16(b[0], b[1]); w.w = cvt_pk_bf16(b[2], b[3]); return w; }
struct EpiProj {
    static constexpr bool PERM = true, AFTER_DRAIN = false;
    bf16_t *Qb, *Kb, *Vb, *AGb, *HQb, *HIb, *HGb; float* LF;
    float *oKp, *oKs, *oVp, *oVs;
    const float *qg, *kg, *lbl, *rope;
    __device__ __forceinline__ void operator()(const f32x4 (&acc)[2][2][4][2], const Unit& u, int wr, int wc, int fr, int fq) const {
        const int seg = u.pn >> 1, half = u.pn & 1;
        const int row0 = u.pm * BM + wr * 64 + fr;
        const bool samp = (u.pm * BM) >= ::MP;
        if (seg < 2) {
            const float* g = seg ? kg : qg;
            f32x4 gv[2][2];
#pragma unroll
            for (int bj = 0; bj < 2; ++bj)
#pragma unroll
                for (int n = 0; n < 2; ++n) gv[bj][n] = *(const f32x4*)(g + 32 * bj + 8 * fq + 4 * n);
            const int gcol = (half * 4 + wc) * 64 + 8 * fq;
            const float sgn = (fq == 0) ? -1.f : 1.f;
#pragma unroll
            for (int ai = 0; ai < 2; ++ai) {
                f32x4 rc[4][4];
                if (fq < 2) {
#pragma unroll
                    for (int m = 0; m < 4; ++m) { const int row = row0 + ai * HALF + m * 16; const int pos = samp ? 2048 + ((row - ::MP) & 7) : (row & 8191); const float* rp = rope + (size_t)pos * 16;
#pragma unroll
                        for (int k4 = 0; k4 < 4; ++k4) rc[m][k4] = *(const f32x4*)(rp + 4 * k4); }
                }
                asm volatile("" ::: "memory");
#pragma unroll
                for (int m = 0; m < 4; ++m) {
                    const int row = row0 + ai * HALF + m * 16;
                    f32x4 x[2][2]; float ss = 0.f;
#pragma unroll
                    for (int bj = 0; bj < 2; ++bj)
#pragma unroll
                        for (int n = 0; n < 2; ++n) { x[bj][n] = acc[ai][bj][m][n]; const f32x4 t = x[bj][n] * x[bj][n]; ss += (t[0] + t[1]) + (t[2] + t[3]); }
                    ss += __shfl_xor(ss, 16); ss += __shfl_xor(ss, 32);
                    const float rs = __builtin_amdgcn_rsqf(ss * (1.f / 64.f) + 1e-6f);
#pragma unroll
                    for (int bj = 0; bj < 2; ++bj)
#pragma unroll
                        for (int n = 0; n < 2; ++n) x[bj][n] = x[bj][n] * rs * gv[bj][n];
                    const f32x4 o0 = shflx4(x[0][0], 16), o1 = shflx4(x[0][1], 16);
                    if (fq < 2) { x[0][0] = x[0][0] * rc[m][0] + (o0 * rc[m][2]) * sgn; x[0][1] = x[0][1] * rc[m][1] + (o1 * rc[m][3]) * sgn; }
                    if (seg == 0) {
#pragma unroll
                        for (int bj = 0; bj < 2; ++bj) *(u32x4*)(Qb + (size_t)row * 512 + gcol + 32 * bj) = pack8(x[bj][0] * ::C2, x[bj][1] * ::C2);
                    } else {
                        float* ok = samp ? oKs + (size_t)(row - ::MP) * 512 : oKp + (size_t)row * 512;
#pragma unroll
                        for (int bj = 0; bj < 2; ++bj) { *(u32x4*)(Kb + (size_t)row * 512 + gcol + 32 * bj) = pack8(x[bj][0], x[bj][1]);
                            *(f32x4*)(ok + gcol + 32 * bj) = x[bj][0]; *(f32x4*)(ok + gcol + 32 * bj + 4) = x[bj][1]; }
                    }
                }
            }
            return;
        }
        const int col0 = half * 256 + wc * 32 + 8 * fq;
        f32x4 lbv[2][2];
        if (seg == 5) {
#pragma unroll
            for (int bj = 0; bj < 2; ++bj)
#pragma unroll
                for (int n = 0; n < 2; ++n) { const f32x4 l0 = *(const f32x4*)(lbl + col0 + bj * HALF + 4 * n), l1 = *(const f32x4*)(lbl + 512 + col0 + bj * HALF + 4 * n);
#pragma unroll
                    for (int e = 0; e < 4; ++e) lbv[bj][n][e] = ::fast_sigmoid(l0[e] - l1[e]); }
        }
        bf16_t* dst = seg == 2 ? Vb : seg == 3 ? AGb : seg == 4 ? HQb : seg == 6 ? HIb : HGb;
#pragma unroll
        for (int ai = 0; ai < 2; ++ai)
#pragma unroll
            for (int m = 0; m < 4; ++m) {
                const int row = row0 + ai * HALF + m * 16;
#pragma unroll
                for (int bj = 0; bj < 2; ++bj) {
                    f32x4 v0 = acc[ai][bj][m][0], v1 = acc[ai][bj][m][1];
                    const int c = col0 + bj * HALF;
                    if (seg == 5) {
#pragma unroll
                        for (int e = 0; e < 4; ++e) { const float la = lbv[bj][0][e], lb2 = lbv[bj][1][e];
                            v0[e] = __builtin_amdgcn_logf(la + (1.f - la) * ::fast_sigmoid(v0[e])) * ::LN2; v1[e] = __builtin_amdgcn_logf(lb2 + (1.f - lb2) * ::fast_sigmoid(v1[e])) * ::LN2; }
                        { u32x4 w; w.x = ::pkh(v0[0], v0[1]); w.y = ::pkh(v0[2], v0[3]); w.z = ::pkh(v1[0], v1[1]); w.w = ::pkh(v1[2], v1[3]); *(u32x4*)((unsigned short*)LF + (size_t)row * 512 + c) = w; }
                    } else {
                        if (seg == 3 || seg == 4 || seg == 7) {
#pragma unroll
                            for (int e = 0; e < 4; ++e) { v0[e] = ::fast_silu(v0[e]); v1[e] = ::fast_silu(v1[e]); }
                        }
                        *(u32x4*)(dst + (size_t)row * 512 + c) = pack8(v0, v1);
                        if (seg == 2) { float* ov = samp ? oVs + (size_t)(row - ::MP) * 512 : oVp + (size_t)row * 512; *(f32x4*)(ov + c) = v0; *(f32x4*)(ov + c + 4) = v1; }
                    }
                }
            }
    }
};
struct EpiOut {
    static constexpr bool PERM = false, AFTER_DRAIN = false;
    const float *xp, *xs; float* out;
    __device__ __forceinline__ void operator()(const f32x4 (&acc)[2][2][4][2], const Unit& u, int wr, int wc, int fr, int fq) const {
        const int row0 = u.pm * BM + wr * 64 + fr, col0 = u.pn * BM + wc * 32 + 4 * fq;
        const bool samp = (u.pm * BM) >= ::MP;
        const float* xbase = samp ? xs + (size_t)(row0 - ::MP) * 1024 : xp + (size_t)row0 * 1024; float* obase = out + (size_t)row0 * 1024;
#pragma unroll
        for (int ai = 0; ai < 2; ++ai) {
            f32x4 xv[4][2][2];
#pragma unroll
            for (int m = 0; m < 4; ++m)
#pragma unroll
                for (int bj = 0; bj < 2; ++bj)
#pragma unroll
                    for (int n = 0; n < 2; ++n) xv[m][bj][n] = *(const f32x4*)(xbase + (size_t)(ai * HALF + m * 16) * 1024 + col0 + bj * HALF + n * 16);
            asm volatile("" ::: "memory");
#pragma unroll
            for (int m = 0; m < 4; ++m)
#pragma unroll
                for (int bj = 0; bj < 2; ++bj)
#pragma unroll
                    for (int n = 0; n < 2; ++n) *(f32x4*)(obase + (size_t)(ai * HALF + m * 16) * 1024 + col0 + bj * HALF + n * 16) = xv[m][bj][n] + acc[ai][bj][m][n];
            asm volatile("" ::: "memory");
        }
    }
};
struct OneUnit {
    int pm, pn;
    __device__ __forceinline__ bool next(int i, Unit& u) const { if (i != 0) return false; u.pm = pm; u.pn = pn; return true; }
    __device__ __forceinline__ void a_ready(const Unit&) const {}
    __device__ __forceinline__ void done(const Unit&) const {}
};
struct P1Order {
    int G, c, i0, n;
    __device__ __forceinline__ bool next(int i, Unit& u) const {
        if (i >= n) return false;
        const int L = (i0 + i) * G + c; if (L >= 1088) return false;
        int wgid = (L & 7) * 136 + (L >> 3);
        if (G == 256) { if (wgid >= 1024 && wgid < 1032) wgid += 56; else if (wgid >= 1080) wgid -= 56; }
        const int gid = wgid >> 7, rem = wgid & 127;
        if (gid < 8) { u.pm = gid * 8 + (rem & 7); u.pn = rem >> 3; } else { u.pm = 64 + (rem & 3); u.pn = rem >> 2; }
        return true;
    }
    __device__ __forceinline__ void a_ready(const Unit&) const {}
    __device__ __forceinline__ void done(const Unit&) const {}
};
}
#include <hip/hip_bf16.h>
#include <cmath>
namespace attn128 {
using bf16=__hip_bfloat16;
using bf16x8=__attribute__((ext_vector_type(8)))short;
using s16x4=__attribute__((ext_vector_type(4)))short;
using f32x16=__attribute__((ext_vector_type(16)))float;
using u32x4=__attribute__((ext_vector_type(4)))unsigned;
constexpr int BATCH=2,NHEAD=8,SEQ=8192,D=64,DM=1024;
constexpr int NW=8,QBLK=32,QB=QBLK*NW,KVBLK=64,NQB=SEQ/QB;
constexpr int ATTN_PITCH=DM, ATTN_UNIT_ROWS=QB, QKP=512;
__device__ __forceinline__ int crow(int r,int hi){return (r&3)+8*(r>>2)+4*hi;}
#define SBAR() __builtin_amdgcn_sched_barrier(0)
__device__ __forceinline__ void cmask(f32x16&p0,f32x16&p1,int jb,int qrel,int hi){
  const float NEG=-INFINITY; int kb=64*jb+4*hi;
  #pragma unroll
  for(int r=0;r<16;++r){int kv=kb+(r&3)+8*(r>>2); if(kv>qrel)p0[r]=NEG; if(kv+32>qrel)p1[r]=NEG;}
}

constexpr int NSLOT=3, SLOTB=8192;
constexpr int LDS_K=0, LDS_V=NSLOT*SLOTB, LDS_WS=3*NSLOT*SLOTB, LDS_OST=LDS_WS+NW*64*4, LDS_BYTES=LDS_OST+NW*4096;
constexpr float C2=0.125f*1.4426950408889634f;
__device__ __forceinline__ void glds16(const void*gsrc,unsigned lds_dst){unsigned keep;
  asm volatile("s_mov_b32 %0, m0\n\ts_mov_b32 m0, %2\n\ts_nop 0\n\tglobal_load_lds_dwordx4 %1, off\n\ts_mov_b32 m0, %0":"=&s"(keep):"v"(gsrc),"s"(lds_dst):"memory");}
__device__ __forceinline__ float max3f(float a,float b,float c){float r;asm("v_max3_f32 %0, %1, %2, %3":"=v"(r):"v"(a),"v"(b),"v"(c));return r;}
__device__ __forceinline__ float max2f(float a,float b){float r;asm("v_max_f32_e32 %0, %1, %2":"=v"(r):"v"(a),"v"(b));return r;}
__device__ __forceinline__ float fadd_s(float a,float b){float r;asm("v_add_f32_e32 %0, %1, %2":"=v"(r):"v"(a),"v"(b));return r;}
__device__ __forceinline__ float fsub_s(float a,float b){float r;asm("v_sub_f32_e32 %0, %1, %2":"=v"(r):"v"(a),"v"(b));return r;}
typedef float f32x2_t __attribute__((ext_vector_type(2))); typedef __bf16 bf16x2_t __attribute__((ext_vector_type(2)));
__device__ __forceinline__ unsigned cvtpk_s(float lo,float hi){f32x2_t v={lo,hi};bf16x2_t b=__builtin_convertvector(v,bf16x2_t);return __builtin_bit_cast(unsigned,b);}
#define WAIT_BAR(N) asm volatile("s_waitcnt vmcnt(" #N ") lgkmcnt(0)\n\ts_barrier":::"memory")

__device__ __forceinline__ void qkt(f32x16&p0,f32x16&p1,const char*Kslot,const bf16x8*qr,const f32x16&negm,int r32,int hi){
  const char*kb=Kslot+hi*1024+r32*16;
  #pragma unroll
  for(int d0=0;d0<4;++d0){
    const bf16x8 b0=*reinterpret_cast<const bf16x8*>(kb+d0*2048);
    const bf16x8 b1=*reinterpret_cast<const bf16x8*>(kb+d0*2048+512);
    if(d0==0){p0=__builtin_amdgcn_mfma_f32_32x32x16_bf16(b0,qr[0],negm,0,0,0);p1=__builtin_amdgcn_mfma_f32_32x32x16_bf16(b1,qr[0],negm,0,0,0);}
    else{p0=__builtin_amdgcn_mfma_f32_32x32x16_bf16(b0,qr[d0],p0,0,0,0);p1=__builtin_amdgcn_mfma_f32_32x32x16_bf16(b1,qr[d0],p1,0,0,0);}}
}
typedef __attribute__((address_space(3))) const char* lds_cptr;
typedef short v4i16_t __attribute__((ext_vector_type(4)));
__device__ __forceinline__ void kload8(bf16x8*kf,lds_cptr kp){
  kf[0]=*(const __attribute__((address_space(3))) bf16x8*)(kp);      kf[1]=*(const __attribute__((address_space(3))) bf16x8*)(kp+512);
  kf[2]=*(const __attribute__((address_space(3))) bf16x8*)(kp+2048); kf[3]=*(const __attribute__((address_space(3))) bf16x8*)(kp+2560);
  kf[4]=*(const __attribute__((address_space(3))) bf16x8*)(kp+4096); kf[5]=*(const __attribute__((address_space(3))) bf16x8*)(kp+4608);
  kf[6]=*(const __attribute__((address_space(3))) bf16x8*)(kp+6144); kf[7]=*(const __attribute__((address_space(3))) bf16x8*)(kp+6656);
}
__device__ __forceinline__ void kload2(bf16x8*kf,lds_cptr kp,int j){ kf[2*j]=*(const __attribute__((address_space(3))) bf16x8*)(kp+j*2048); kf[2*j+1]=*(const __attribute__((address_space(3))) bf16x8*)(kp+j*2048+512); }
__device__ __forceinline__ s16x4 vtr(lds_cptr p){ return __builtin_bit_cast(s16x4,__builtin_amdgcn_ds_read_tr16_b64_v4i16((__attribute__((address_space(3))) v4i16_t*)p)); }
__device__ __forceinline__ float rowmax(const f32x16&p0,const f32x16&p1){
  float a=max3f(p0[0],p0[1],p1[0]),b=max3f(p0[2],p0[3],p1[1]);a=max3f(a,p1[2],p1[3]);
  #pragma unroll
  for(int r=4;r<16;r+=4){a=max3f(a,p0[r],p0[r+1]);b=max3f(b,p0[r+2],p0[r+3]);a=max3f(a,p1[r],p1[r+1]);b=max3f(b,p1[r+2],p1[r+3]);}
  const float m=max2f(a,b);
  auto rr=__builtin_amdgcn_permlane32_swap(__float_as_uint(m),__float_as_uint(m),false,false);
  return max2f(__uint_as_float(rr[0]),__uint_as_float(rr[1]));
}
__device__ __forceinline__ void pv(f32x16*o,int vb,bf16x8 pa0,bf16x8 pa1,bf16x8 pa2,bf16x8 pa3){
  #pragma unroll
  for(int d0=0;d0<2;++d0){s16x4 lo[4],hi[4];
    #pragma unroll
    for(int ks=0;ks<4;++ks){
      asm volatile("ds_read_b64_tr_b16 %0,%1 offset:%c2":"=&v"(lo[ks]):"v"(vb),"i"(d0*4096+ks*1024):"memory");
      asm volatile("ds_read_b64_tr_b16 %0,%1 offset:%c2":"=&v"(hi[ks]):"v"(vb),"i"(d0*4096+ks*1024+512):"memory");}
    asm volatile("s_waitcnt lgkmcnt(0)":::"memory");SBAR();
    #define PK(k) (bf16x8){lo[k][0],lo[k][1],lo[k][2],lo[k][3],hi[k][0],hi[k][1],hi[k][2],hi[k][3]}
    o[d0]=__builtin_amdgcn_mfma_f32_32x32x16_bf16(pa0,PK(0),o[d0],0,0,0);
    o[d0]=__builtin_amdgcn_mfma_f32_32x32x16_bf16(pa1,PK(1),o[d0],0,0,0);
    o[d0]=__builtin_amdgcn_mfma_f32_32x32x16_bf16(pa2,PK(2),o[d0],0,0,0);
    o[d0]=__builtin_amdgcn_mfma_f32_32x32x16_bf16(pa3,PK(3),o[d0],0,0,0);
    #undef PK
  }
}

#ifndef ATTN_STORE16
#define ATTN_STORE16(p,v) (*(u32x4*)(p)=(v))
#endif
template<int THRL> __device__ __forceinline__ void attn_unit(int b,int h,int qb,const bf16*Q,const bf16*__restrict__ K,const bf16*__restrict__ V,bf16*O,char*shm){
  int tid_=threadIdx.x; asm volatile("":"+v"(tid_));
  const int tid=tid_,lane=tid&63,r32=lane&31,hi=lane>>5; const int wid=__builtin_amdgcn_readfirstlane(tid>>6);
  const long rowbase=(long)b*SEQ; const int q0=qb*QB;
  const int hq_=h;
  const bf16*Qw=Q+(rowbase+q0+wid*QBLK)*QKP+hq_*D;
  const bf16*Kh=K+rowbase*QKP+hq_*D,*Vh=V+rowbase*QKP+(h>>1)*128;
  const unsigned lds0=(unsigned)(uintptr_t)shm;
  float*wsf=(float*)(shm+LDS_WS)+wid*64;
  const bf16*ksrc=Kh+(long)lane*QKP+wid*8;
  const bf16*vsrc=Vh+(long)(16*(wid&3)+(lane>>2))*QKP+(wid>>2)*32+(lane&3)*8;
  const unsigned kdst=lds0+LDS_K+wid*1024, vdst=lds0+LDS_V+wid*1024;
  #define DMA_K(t,slot) glds16(ksrc+(long)(t)*KVBLK*QKP,(unsigned)__builtin_amdgcn_readfirstlane(kdst+(slot)))
  #define DMA_V(t,slot) do{ glds16(vsrc+(long)(t)*KVBLK*QKP,(unsigned)__builtin_amdgcn_readfirstlane(vdst+2*(slot))); glds16(vsrc+(long)(t)*KVBLK*QKP+64,(unsigned)__builtin_amdgcn_readfirstlane(vdst+2*(slot)+SLOTB)); }while(0)
  const int vb0=(int)(lds0+LDS_V)+((lane>>4)&1)*32+(lane&3)*8+(4*hi+((lane&15)>>2))*64;
  const char*Kbase=shm+LDS_K; bf16x8 kf[8];
  const lds_cptr shm3=(lds_cptr)shm; const lds_cptr kp0=shm3+LDS_K+hi*1024+r32*16; const lds_cptr vp0=shm3+LDS_V+((lane>>4)&1)*32+(lane&3)*8+(4*hi+((lane&15)>>2))*64;
  const int NT=(q0+QB)/KVBLK;
  DMA_K(0,0);DMA_V(0,0);DMA_K(1,SLOTB);
  bf16x8 qr[4];
  #pragma unroll
  for(int d0=0;d0<4;++d0)qr[d0]=*reinterpret_cast<const bf16x8*>(&Qw[(long)r32*QKP+d0*16+hi*8]);
  float mhat=0.f,l_reg=0.f;f32x16 o[4];{float z_=0.f;asm volatile("":"+v"(z_));
  _Pragma("unroll") for(int d_=0;d_<4;++d_) _Pragma("unroll") for(int r=0;r<16;++r)o[d_][r]=z_;}
  f32x16 negm; {float z_=0.f;asm volatile("":"+v"(z_)); _Pragma("unroll") for(int r=0;r<16;++r)negm[r]=z_;}
  const int qrel=wid*QBLK+r32;
  #define CMASK(P0,P1,t) do{int jb_=(t)-(NT-4); if(jb_>=0)cmask(P0,P1,jb_,qrel,hi);}while(0)
  bool resc=false;
  #define START(P0,P1) do{ const float rm=rowmax(P0,P1); resc=false; \
    { const float dl=rm; mhat=fadd_s(mhat,dl); \
      _Pragma("unroll") for(int r=0;r<16;++r){P0[r]=fsub_s(P0[r],dl);P1[r]=fsub_s(P1[r],dl);} \
      _Pragma("unroll") for(int r=0;r<16;++r)negm[r]=-mhat; asm volatile("":"+v"(negm)); } \
    _Pragma("unroll") for(int r=0;r<16;++r)P0[r]=__builtin_amdgcn_exp2f(P0[r]); }while(0)
  #define RESC() do{ if(resc){ asm volatile("s_waitcnt lgkmcnt(0)":::"memory"); \
      _Pragma("unroll") for(int d_=0;d_<4;++d_) _Pragma("unroll") for(int r=0;r<16;++r)o[d_][r]*=wsf[crow(r,hi)]; } }while(0)
  f32x16 pA0,pA1,pB0,pB1;
  int sl_prev=0,sl_cur=0,sl_next=SLOTB;
  #define ROT() do{sl_prev=sl_cur;sl_cur=sl_next;sl_next=(sl_next==(NSLOT-1)*SLOTB)?0:sl_next+SLOTB;}while(0)
  DMA_K(2,2*SLOTB);
  WAIT_BAR(3);
  qkt(pA0,pA1,Kbase,qr,negm,r32,hi);asm volatile("s_nop 15\n\ts_nop 7":"+v"(pA0),"+v"(pA1));CMASK(pA0,pA1,0);
  START(pA0,pA1);
  _Pragma("unroll") for(int r=0;r<16;++r)pA1[r]=__builtin_amdgcn_exp2f(pA1[r]);
  WAIT_BAR(0);
  DMA_K(3,0);DMA_V(1,SLOTB);
  ROT();
  kload8(kf,kp0+sl_cur);
  WAIT_BAR(3);
  s16x4 vlo[8],vhi[8]; u32x4 pw0,pw1,pw2,pw3;
  #define PKW(P,B) cvtpk_s(P[B],P[B+1])
  #define PAF(k) __builtin_bit_cast(bf16x8,pw##k)
  #define VFR(i) (bf16x8){vlo[i][0],vlo[i][1],vlo[i][2],vlo[i][3],vhi[i][0],vhi[i][1],vhi[i][2],vhi[i][3]}
  #define PIN(x) asm volatile("":"+v"(x))
  #define MX3(a,b,c) __builtin_fmaxf(__builtin_fmaxf((a),(b)),(c))
  #define GAPA(MF,A0,A1,A2,A3,W0,W1,PW) do{ MF; sacc+=A0; sacc+=A1; sacc+=A2; sacc+=A3; PIN(sacc); W0; W1; PIN(PW); SBAR(); }while(0)
  #define EX(v) __builtin_amdgcn_exp2f(v)
  #define GAPB(MF,X,B) do{ MF; X[B]=EX(X[B]); X[B+1]=EX(X[B+1]); X[B+2]=EX(X[B+2]); X[B+3]=EX(X[B+3]); PIN(X); SBAR(); }while(0)
  #define VRD(i) do{ vlo[i]=vtr(vp_+(((i)>>2)*4096+((i)&3)*1024)); vhi[i]=vtr(vp_+(((i)>>2)*4096+((i)&3)*1024+512)); }while(0)
  #define KRD(G,j) do{ if(G){ kload2(kf,kp0+sl_next,j); SBAR(); } }while(0)
  #define STEP(C0,C1,P0,P1,t,GK,GV,GL) do{ SBAR(); \
    const lds_cptr vp_=vp0+2*sl_prev; \
    VRD(0); SBAR(); float sacc=(P0[0]+P0[1]); \
    GAPA(C0=__builtin_amdgcn_mfma_f32_32x32x16_bf16(kf[0],qr[0],negm,0,0,0), P0[2],P0[3],P0[4],P0[5],     pw0[0]=PKW(P0,0), pw0[1]=PKW(P0,2), pw0); \
    VRD(4); SBAR(); GAPA(C1=__builtin_amdgcn_mfma_f32_32x32x16_bf16(kf[1],qr[0],negm,0,0,0), P0[6],P0[7],P0[8],P0[9],     pw0[2]=PKW(P0,4), pw0[3]=PKW(P0,6), pw0); \
    VRD(1); SBAR(); GAPA(C0=__builtin_amdgcn_mfma_f32_32x32x16_bf16(kf[2],qr[1],C0,0,0,0),   P0[10],P0[11],P0[12],P0[13], pw1[0]=PKW(P0,8), pw1[1]=PKW(P0,10), pw1); \
    VRD(5); SBAR(); GAPA(C1=__builtin_amdgcn_mfma_f32_32x32x16_bf16(kf[3],qr[1],C1,0,0,0),   P0[14],P0[15],P1[0],P1[1],   pw1[2]=PKW(P0,12),pw1[3]=PKW(P0,14), pw1); \
    VRD(2); SBAR(); GAPA(C0=__builtin_amdgcn_mfma_f32_32x32x16_bf16(kf[4],qr[2],C0,0,0,0),   P1[2],P1[3],P1[4],P1[5],     pw2[0]=PKW(P1,0), pw2[1]=PKW(P1,2), pw2); \
    VRD(6); SBAR(); GAPA(C1=__builtin_amdgcn_mfma_f32_32x32x16_bf16(kf[5],qr[2],C1,0,0,0),   P1[6],P1[7],P1[8],P1[9],     pw2[2]=PKW(P1,4), pw2[3]=PKW(P1,6), pw2); \
    VRD(3); SBAR(); GAPA(C0=__builtin_amdgcn_mfma_f32_32x32x16_bf16(kf[6],qr[3],C0,0,0,0),   P1[10],P1[11],P1[12],P1[13], pw3[0]=PKW(P1,8), pw3[1]=PKW(P1,10), pw3); \
    VRD(7); SBAR(); GAPA(C1=__builtin_amdgcn_mfma_f32_32x32x16_bf16(kf[7],qr[3],C1,0,0,0),   P1[14],P1[15],0.f,0.f,       pw3[2]=PKW(P1,12),pw3[3]=PKW(P1,14), pw3); \
    l_reg+=sacc; \
    if(GK){DMA_K((t)+3,sl_cur);} if(GV){DMA_V((t)+1,sl_next);} \
    CMASK(C0,C1,t); \
    { float a=MX3(C0[0],C0[1],C1[0]),b=MX3(C0[2],C0[3],C1[1]); a=MX3(a,C1[2],C1[3]); \
      _Pragma("unroll") for(int r=4;r<16;r+=4){a=MX3(a,C0[r],C0[r+1]);b=MX3(b,C0[r+2],C0[r+3]);a=MX3(a,C1[r],C1[r+1]);b=MX3(b,C1[r+2],C1[r+3]);} \
      float rm=__builtin_fmaxf(a,b); { auto rr=__builtin_amdgcn_permlane32_swap(__float_as_uint(rm),__float_as_uint(rm),false,false); rm=__builtin_fmaxf(__uint_as_float(rr[0]),__uint_as_float(rr[1])); } \
      resc=false; \
      if(__builtin_expect(__any(rm>(float)THRL),0)){ const float dl=__builtin_fmaxf(rm,0.f); mhat+=dl; \
        _Pragma("unroll") for(int r=0;r<16;++r){C0[r]-=dl;C1[r]-=dl;} \
        _Pragma("unroll") for(int r=0;r<16;++r)negm[r]=-mhat; asm volatile("":"+v"(negm)); \
        const float f=__builtin_amdgcn_exp2f(-dl); l_reg*=f; if(hi==0)wsf[r32]=f; resc=true; } } \
    SBAR(); \
    GAPB(o[0]=__builtin_amdgcn_mfma_f32_32x32x16_bf16(PAF(0),VFR(0),o[0],0,0,0), C0,0); \
    GAPB(o[1]=__builtin_amdgcn_mfma_f32_32x32x16_bf16(PAF(0),VFR(4),o[1],0,0,0), C0,4); \
    KRD(GL,0); GAPB(o[0]=__builtin_amdgcn_mfma_f32_32x32x16_bf16(PAF(1),VFR(1),o[0],0,0,0), C0,8); \
    KRD(GL,1); GAPB(o[1]=__builtin_amdgcn_mfma_f32_32x32x16_bf16(PAF(1),VFR(5),o[1],0,0,0), C0,12); \
    KRD(GL,2); GAPB(o[0]=__builtin_amdgcn_mfma_f32_32x32x16_bf16(PAF(2),VFR(2),o[0],0,0,0), C1,0); \
    KRD(GL,3); GAPB(o[1]=__builtin_amdgcn_mfma_f32_32x32x16_bf16(PAF(2),VFR(6),o[1],0,0,0), C1,4); \
    GAPB(o[0]=__builtin_amdgcn_mfma_f32_32x32x16_bf16(PAF(3),VFR(3),o[0],0,0,0), C1,8); \
    GAPB(o[1]=__builtin_amdgcn_mfma_f32_32x32x16_bf16(PAF(3),VFR(7),o[1],0,0,0), C1,12); \
    pv(o+2,vb0+2*sl_prev+SLOTB,PAF(0),PAF(1),PAF(2),PAF(3));     \
    }while(0)
  int t=1;
  #undef CMASK
  #define CMASK(P0,P1,t) do{}while(0)
  for(;t+5<NT;t+=2){
    STEP(pB0,pB1,pA0,pA1,t,true,true,true);     WAIT_BAR(3); RESC(); ROT();
    STEP(pA0,pA1,pB0,pB1,t+1,true,true,true);   WAIT_BAR(3); RESC(); ROT();
  }
  #undef CMASK
  #define CMASK(P0,P1,t) do{int jb_=(t)-(NT-4); if(jb_>=0)cmask(P0,P1,jb_,qrel,hi);}while(0)
  #define ENDW(tt) do{ if((tt)+3<NT){WAIT_BAR(3);} else if((tt)+2<NT){WAIT_BAR(2);} else {WAIT_BAR(0);} }while(0)
  for(;t+1<NT;t+=2){
    STEP(pB0,pB1,pA0,pA1,t,(t+3<NT),(t+1<NT),(t+1<NT));       ENDW(t);   RESC(); ROT();
    STEP(pA0,pA1,pB0,pB1,t+1,(t+4<NT),(t+2<NT),(t+2<NT));     ENDW(t+1); RESC(); ROT();
  }
  STEP(pB0,pB1,pA0,pA1,NT-1,false,false,false); RESC();
  { float sacc=pB0[0]+pB0[1]; _Pragma("unroll") for(int r=2;r<16;++r)sacc+=pB0[r]; _Pragma("unroll") for(int r=0;r<16;++r)sacc+=pB1[r]; l_reg+=sacc;
    pw0=(u32x4){PKW(pB0,0),PKW(pB0,2),PKW(pB0,4),PKW(pB0,6)};pw1=(u32x4){PKW(pB0,8),PKW(pB0,10),PKW(pB0,12),PKW(pB0,14)};pw2=(u32x4){PKW(pB1,0),PKW(pB1,2),PKW(pB1,4),PKW(pB1,6)};pw3=(u32x4){PKW(pB1,8),PKW(pB1,10),PKW(pB1,12),PKW(pB1,14)};
    SBAR(); pv(o,vb0+2*sl_cur,PAF(0),PAF(1),PAF(2),PAF(3)); pv(o+2,vb0+2*sl_cur+SLOTB,PAF(0),PAF(1),PAF(2),PAF(3)); }
  #undef PKW
  #undef PAF
  #undef VFR
  #undef PIN
  #undef MX3
  #undef GAPA
  #undef GAPB
  #undef EX
  #undef VRD
  #undef KRD
  #undef STEP
  #undef ENDW
  {auto rr=__builtin_amdgcn_permlane32_swap(__float_as_uint(l_reg),__float_as_uint(l_reg),false,false);l_reg=__uint_as_float(rr[0])+__uint_as_float(rr[1]);}
  if(hi==0)wsf[32+r32]=l_reg;asm volatile("s_waitcnt lgkmcnt(0)":::"memory");
  float rli[16];
  #pragma unroll
  for(int r=0;r<16;++r)rli[r]=__builtin_amdgcn_rcpf(wsf[32+crow(r,hi)]);
  bf16*Ow=O+(rowbase+q0+wid*QBLK)*DM+h*128;
  { bf16*stg=(bf16*)(shm+LDS_OST)+wid*2048;
    #pragma unroll
    for(int hh=0;hh<2;++hh){
    #pragma unroll
    for(int r=0;r<16;++r){const int orow=crow(r,hi);
      #pragma unroll
      for(int d0=0;d0<2;++d0)stg[orow*64+d0*32+r32]=__float2bfloat16(o[2*hh+d0][r]*rli[r]);}
    asm volatile("s_waitcnt lgkmcnt(0)":::"memory");
    #pragma unroll
    for(int i=0;i<4;++i){const int row=i*8+(lane>>3),ch=lane&7; const u32x4 v=*(const u32x4*)(stg+row*64+ch*8); ATTN_STORE16(Ow+(long)row*DM+hh*64+ch*8,v);}
    asm volatile("s_waitcnt lgkmcnt(0)":::"memory"); } }
  asm volatile("s_waitcnt lgkmcnt(0)\n\ts_barrier":::"memory");
  #undef DMA_K
  #undef DMA_V
  #undef CMASK
  #undef START
  #undef RESC
  #undef ROT
}
constexpr int ATTN_LDS_BYTES=LDS_BYTES;
struct AttnTensors { const bf16* Q; const bf16* K; const bf16* V; bf16* O; };
struct AttnUnit { int bh; int qb; };
struct StaticOrder {
  int vcu;
  __device__ __forceinline__ explicit StaticOrder(int grid,int block):vcu((block%8)*(grid/8)+block/8){}
  __device__ __forceinline__ bool next(int i,AttnUnit&u)const{ if(i>=2)return false; const int s=vcu&15; u.bh=vcu>>4; u.qb=(i==0)?s:31-s; return true; }
  __device__ __forceinline__ void a_ready(const AttnUnit&)const{}
  __device__ __forceinline__ void done(const AttnUnit&)const{}
};
template<class Sched,int THRL=8> __device__ __forceinline__ void attn_phase(char*lds,const AttnTensors&T,const Sched&S){
  AttnUnit u;
  for(int i=0;S.next(i,u);++i){ S.a_ready(u); attn_unit<THRL>(u.bh/NHEAD,u.bh%NHEAD,u.qb,T.Q,T.K,T.V,T.O,lds); S.done(u); }
}
#undef SBAR
#undef WAIT_BAR
}
#define GAS __attribute__((address_space(1)))
#define LAS __attribute__((address_space(3)))
typedef unsigned short bf16;
typedef unsigned v4u __attribute__((ext_vector_type(4)));
typedef float f32x4 __attribute__((ext_vector_type(4)));
typedef short bf16x8 __attribute__((ext_vector_type(8)));
typedef GAS unsigned gu32;
typedef GAS unsigned long long gu64;
#define RLX_AGENT __ATOMIC_RELAXED, __HIP_MEMORY_SCOPE_AGENT
#define LDS_WAIT() asm volatile("s_waitcnt lgkmcnt(0)" ::: "memory")
#define VM_WAIT() asm volatile("s_waitcnt vmcnt(0)" ::: "memory")
__device__ __forceinline__ unsigned long long rt() { return __builtin_amdgcn_s_memrealtime(); }
__device__ __forceinline__ unsigned f2bf(float f) { unsigned u = __builtin_bit_cast(unsigned, f); return (u + 0x7fffu + ((u >> 16) & 1u)) >> 16; }
__device__ __forceinline__ unsigned pk2(float lo, float hi) { return f2bf(lo) | (f2bf(hi) << 16); }

#define XB_TMO      128
#define XB_XCNT(j)  (256  + 64 * (j))
#define XB_XSUB(j)  (1280 + 64 * (j))
#define XB_XGEN(j)  (2304 + 64 * (j))
#define XB_TOP      3328
#define XB_TOPGEN   3392
#define XCD_BAR_WORDS 3456
#define XB_SPIN_CAP (1u << 18)

__device__ __forceinline__ unsigned xb_ld(unsigned* p)              { return __hip_atomic_load(p, __ATOMIC_RELAXED, __HIP_MEMORY_SCOPE_AGENT); }
__device__ __forceinline__ unsigned xb_add(unsigned* p, unsigned v) { return __hip_atomic_fetch_add(p, v, __ATOMIC_RELAXED, __HIP_MEMORY_SCOPE_AGENT); }
__device__ __forceinline__ unsigned xb_xcc_id() { return (unsigned)__builtin_amdgcn_s_getreg((3 << 11) | 20) & 0xFu; }
#define XB_SPIN(cond, bar) do { unsigned _sp = 0; while (cond) { __builtin_amdgcn_s_sleep(1); \
    if ((++_sp & 255u) == 0u) { if (xb_ld(&(bar)[XB_TMO])) break; if (_sp > XB_SPIN_CAP) { atomicAdd(&(bar)[XB_TMO], 1u); break; } } } } while (0)

struct XcdBarrier {
    unsigned* bar; unsigned x;
    volatile LAS unsigned* st;
};

__device__ __forceinline__ XcdBarrier xcd_barrier_post(unsigned* bar, volatile LAS unsigned* st) {
    XcdBarrier b; b.bar = bar; b.x = xb_xcc_id(); b.st = st;
    if (threadIdx.x == 0) (void)xb_add(&bar[XB_XCNT(b.x)], 1u);
    return b;
}
__device__ __forceinline__ void xcd_barrier_complete(unsigned* bar, unsigned x, unsigned& nloc, unsigned& nx) {
    const unsigned G = gridDim.x * gridDim.y * gridDim.z;
    unsigned sum, cnt, mine, sp = 0u;
    for (;;) {
        sum = 0u; cnt = 0u; mine = 0u;
#pragma unroll
        for (unsigned j = 0; j < 16; ++j) { const unsigned c = xb_ld(&bar[XB_XCNT(j)]); sum += c; cnt += (c > 0u) ? 1u : 0u; mine = (j == x) ? c : mine; }
        if (sum == G) break;
        __builtin_amdgcn_s_sleep(1);
        if ((++sp & 255u) == 0u) { if (xb_ld(&bar[XB_TMO])) break; if (sp > XB_SPIN_CAP) { atomicAdd(&bar[XB_TMO], 1u); break; } }
    }
    nloc = mine > 0u ? mine : 1u; nx = cnt > 0u ? cnt : 1u;
}

__device__ __forceinline__ void xcd_barrier(const XcdBarrier& b) {
    asm volatile("s_waitcnt vmcnt(0)" ::: "memory");
    __syncthreads();
    if (threadIdx.x == 0) {
        unsigned* bar = b.bar;
        __builtin_amdgcn_s_waitcnt(0);
        unsigned nloc = b.st[0], nx = b.st[1];
        if (nloc == 0u) { xcd_barrier_complete(bar, b.x, nloc, nx); b.st[0] = nloc; b.st[1] = nx; }
        const unsigned old = xb_add(&bar[XB_XSUB(b.x)], 1u);
        const unsigned gen = old / nloc;
        if (old + 1u == (gen + 1u) * nloc) {
            __builtin_amdgcn_fence(__ATOMIC_RELEASE, "agent");
            asm volatile("s_waitcnt vmcnt(0)" ::: "memory");
            const unsigned og = xb_add(&bar[XB_TOP], 1u);
            const unsigned tg = og / nx;
            if (og + 1u == (tg + 1u) * nx) xb_add(&bar[XB_TOPGEN], 1u);
            else XB_SPIN(xb_ld(&bar[XB_TOPGEN]) == tg, bar);
            __builtin_amdgcn_fence(__ATOMIC_ACQUIRE, "agent");
            xb_add(&bar[XB_XGEN(b.x)], 1u);
            asm volatile("s_waitcnt vmcnt(0)" ::: "memory");
        } else {
            XB_SPIN(xb_ld(&bar[XB_XGEN(b.x)]) == gen, bar);
            __builtin_amdgcn_fence(__ATOMIC_ACQUIRE, "agent");
            asm volatile("s_waitcnt vmcnt(0)" ::: "memory");
        }
    }
    __syncthreads();
}
template <bool PERMQK>
__device__ __forceinline__ void p0_transpose_item(const float* W, int K, int N, bf16* WT, LAS float* scr, int item, int lane) {
    const int nblk = N / 32, kb = item / nblk, nb = item % nblk, k0 = 64 * kb, n0 = 32 * nb;
    float wv[32];
#pragma unroll
    for (int i = 0; i < 32; ++i) { const int kk = 2 * i + (lane >> 5); wv[i] = W[(size_t)(k0 + kk) * N + n0 + (lane & 31)]; }
#pragma unroll
    for (int i = 0; i < 32; ++i) { const int kk = 2 * i + (lane >> 5); scr[kk * 33 + (lane & 31)] = wv[i]; }
    LDS_WAIT(); asm volatile("" ::: "memory");
    const int c = lane & 7;
    const int r0 = PERMQK ? win_row_of_col(n0) : n0;
#pragma unroll
    for (int j = 0; j < 4; ++j) { const int n = (lane >> 3) + 8 * j; const LAS float* s = scr + (8 * c) * 33 + n;
        v4u o; o.x = pkbf(s[0 * 33], s[1 * 33]); o.y = pkbf(s[2 * 33], s[3 * 33]); o.z = pkbf(s[4 * 33], s[5 * 33]); o.w = pkbf(s[6 * 33], s[7 * 33]);
        *(GAS v4u*)(WT + (size_t)(r0 + n) * K + k0 + 8 * c) = o; }
    LDS_WAIT(); asm volatile("" ::: "memory");
}
__device__ __forceinline__ void rms_rows4_to_bf16(const float* xp, const float* xs, const float* g, bf16* XN, int m0, int mstride, int lane) {
    f32x4 v[4][4]; bool ok[4];
#pragma unroll
    for (int r = 0; r < 4; ++r) { const int m = m0 + r * mstride; ok[r] = m < MT; const int mm = ok[r] ? m : m0;
        const GAS f32x4* xr = (const GAS f32x4*)(mm < MP ? xp + (size_t)mm * 1024 : xs + (size_t)(mm - MP) * 1024) + lane;
#pragma unroll
        for (int j = 0; j < 4; ++j) v[r][j] = xr[64 * j]; }
    f32x4 gg[4];
#pragma unroll
    for (int j = 0; j < 4; ++j) gg[j] = ((const GAS f32x4*)g + lane)[64 * j];
#pragma unroll
    for (int r = 0; r < 4; ++r) { float s = 0.f;
#pragma unroll
        for (int j = 0; j < 4; ++j) s += (v[r][j].x * v[r][j].x + v[r][j].y * v[r][j].y) + (v[r][j].z * v[r][j].z + v[r][j].w * v[r][j].w);
        const float rstd = __builtin_amdgcn_rsqf(wave_sum(s) * (1.f / 1024.f) + 1e-6f);
        if (ok[r]) { GAS unsigned long long* o8 = (GAS unsigned long long*)(XN + (size_t)(m0 + r * mstride) * 1024) + lane;
#pragma unroll
            for (int j = 0; j < 4; ++j) o8[64 * j] = (unsigned long long)pkbf(v[r][j].x * rstd * gg[j].x, v[r][j].y * rstd * gg[j].y) | ((unsigned long long)pkbf(v[r][j].z * rstd * gg[j].z, v[r][j].w * rstd * gg[j].w) << 32); } }
}
__device__ __forceinline__ void rope_entry(int pos, int i, float* tab) {
    const double rev[8] = {0.15915494309189535, 0.03086376340470123, 0.005985185712713705, 0.001160663641240061, 0.00022507907903927653, 4.364795279280289e-05, 8.464330808241401e-06, 1.6414262627950345e-06};
    double r = rev[0];
#pragma unroll
    for (int k = 1; k < 8; ++k) r = (i == k) ? rev[k] : r;
    double x = (double)pos * r; x -= __builtin_rint(x);
    const float xf = (float)x;
    tab[pos * 16 + i] = __builtin_amdgcn_cosf(xf); tab[pos * 16 + 8 + i] = __builtin_amdgcn_sinf(xf);
}
typedef short s16x4h __attribute__((ext_vector_type(4)));
typedef float f32x16h __attribute__((ext_vector_type(16)));
typedef __attribute__((address_space(3))) const unsigned char* lcptr;
constexpr int HRS = 272;
constexpr int H_VT = 0, H_QT = 17408, H_KT = 2 * 17408, H_QP = 3 * 17408, H_SS = 4 * 17408, H_HQ = H_SS + 1024, H_LF = H_HQ + 17408, LFRS = 528, H_END = H_LF + 64 * LFRS;
static_assert(H_END <= 131072, "hgrn LDS map");
__device__ __forceinline__ s16x4h h_vtr(lcptr p) { return __builtin_bit_cast(s16x4h, __builtin_amdgcn_ds_read_tr16_b64_v4i16((__attribute__((address_space(3))) s16x4h*)p)); }
__device__ __forceinline__ int h_crow(int r, int hi) { return (r & 3) + 8 * (r >> 2) + 4 * hi; }
__device__ __forceinline__ bf16x8 h_cat(s16x4h a, s16x4h b) { return (bf16x8){a[0], a[1], a[2], a[3], b[0], b[1], b[2], b[3]}; }
__device__ __forceinline__ void h_stage_tile(LAS unsigned char* L, int off, const bf16* src, int tid) {
#pragma unroll
    for (int i = 0; i < 2; ++i) { const int e = tid + 512 * i, r = e >> 4, ch = e & 15;
        const v4u v = *(const GAS v4u*)(src + (size_t)r * 512 + ch * 8); *(LAS v4u*)(L + off + r * HRS + ch * 16) = v; }
}
__device__ __forceinline__ void h_stage_lf(LAS unsigned char* L, const float* src, int tid) {
    f32x4 v[4];
#pragma unroll
    for (int i = 0; i < 4; ++i) { const int e = tid + 512 * i, r = e >> 5, ch = e & 31; v[i] = *(const GAS f32x4*)(src + (size_t)r * 512 + ch * 4); }
#pragma unroll
    for (int i = 0; i < 4; ++i) { const int e = tid + 512 * i, r = e >> 5, ch = e & 31; *(LAS f32x4*)(L + H_LF + r * LFRS + ch * 16) = v[i]; }
}
__device__ __forceinline__ void h_cumsum(const LAS unsigned char* L, int d, int kg, float (&lf)[32], float (&b)[32], float& bC, float& bMid) {
#pragma unroll
    for (int s = 0; s < 32; ++s) lf[s] = *(const LAS float*)(L + H_LF + (32 * kg + s) * LFRS + d * 4);
    float c = 0.f;
#pragma unroll
    for (int s = 0; s < 32; ++s) { c += lf[s]; b[s] = c; }
    const float Tp = __shfl_xor(c, 32);
    const float P = kg ? Tp : 0.f;
#pragma unroll
    for (int s = 0; s < 32; ++s) b[s] += P;
    bC = c + Tp; bMid = kg ? Tp : c;
}
__device__ __forceinline__ float ex(float x) { return __builtin_amdgcn_exp2f(x * LOG2E); }

__device__ __forceinline__ void hgrn_a_item(LAS unsigned char* L, int bh, int c, const float* LF, const bf16* HIb, bf16* UT, float* GC, int tid, int lane, int wave) {
    const int b = bh >> 2, h = bh & 3; const size_t t0 = (size_t)b * SEQ + (size_t)c * 64;
    h_stage_tile(L, H_VT, HIb + t0 * 512 + h * 128, tid);
    h_stage_lf(L, LF + t0 * 512 + h * 128, tid);
    __syncthreads();
    const int dblk = wave & 3, vhalf = wave >> 2, i = lane & 31, kg = lane >> 5, d = 32 * dblk + i;
    float lf[32], bb[32], bC, bMid;
    h_cumsum(L, d, kg, lf, bb, bC, bMid);
    bf16x8 kf[4];
#pragma unroll
    for (int ks = 0; ks < 4; ++ks) { unsigned w[4];
#pragma unroll
        for (int j = 0; j < 4; ++j) { const int s0 = 8 * ks + 2 * j; w[j] = pkbf((1.f - ex(lf[s0])) * ex(bC - bb[s0]), (1.f - ex(lf[s0 + 1])) * ex(bC - bb[s0 + 1])); }
        kf[ks] = __builtin_bit_cast(bf16x8, (v4u){w[0], w[1], w[2], w[3]}); }
    if (vhalf == 0 && kg == 0) GC[((size_t)bh * 128 + c) * 128 + d] = ex(bC);
    const int q = (lane & 15) >> 2, p = lane & 3, g1 = (lane >> 4) & 1;
    f32x16h acc[2];
#pragma unroll
    for (int vt = 0; vt < 2; ++vt) { acc[vt] = f32x16h{};
        const lcptr vp = (lcptr)(L + H_VT) + (32 * kg + q) * HRS + (32 * (2 * vhalf + vt) + 16 * g1 + 4 * p) * 2;
#pragma unroll
        for (int ks = 0; ks < 4; ++ks) { const s16x4h lo = h_vtr(vp + (8 * ks) * HRS), hi4 = h_vtr(vp + (8 * ks + 4) * HRS);
            acc[vt] = __builtin_amdgcn_mfma_f32_32x32x16_bf16(h_cat(lo, hi4), kf[ks], acc[vt], 0, 0, 0); } }
    bf16* U = UT + ((size_t)bh * 128 + c) * 16384;
#pragma unroll
    for (int vt = 0; vt < 2; ++vt)
#pragma unroll
        for (int r = 0; r < 16; ++r) U[(size_t)(32 * (2 * vhalf + vt) + h_crow(r, kg)) * 128 + d] = (bf16)(pkbf(acc[vt][r], 0.f) & 0xffffu);
    __syncthreads();
}

#define H_BAR() asm volatile("s_waitcnt lgkmcnt(0)\n\ts_barrier" ::: "memory")
struct HTileRegs { v4u v[2]; v4u q[2]; unsigned long long lf[4]; };
template <bool WITHQ> __device__ __forceinline__ void h_tiles_load(HTileRegs& R, const bf16* HIb, const bf16* HQb, const float* LF, size_t t0, int h, int tid) {
#pragma unroll
    for (int i = 0; i < 2; ++i) { const int e = tid + 512 * i, r = e >> 4, ch = e & 15; R.v[i] = *(const GAS v4u*)(HIb + (t0 + r) * 512 + h * 128 + ch * 8);
        if (WITHQ) R.q[i] = *(const GAS v4u*)(HQb + (t0 + r) * 512 + h * 128 + ch * 8); }
#pragma unroll
    for (int i = 0; i < 4; ++i) { const int e = tid + 512 * i, r = e >> 5, ch = e & 31; R.lf[i] = *(const GAS unsigned long long*)((const unsigned short*)LF + (t0 + r) * 512 + h * 128 + ch * 4); }
}
template <bool WITHQ> __device__ __forceinline__ void h_tiles_store(LAS unsigned char* L, const HTileRegs& R, int tid) {
#pragma unroll
    for (int i = 0; i < 2; ++i) { const int e = tid + 512 * i, r = e >> 4, ch = e & 15; *(LAS v4u*)(L + H_VT + r * HRS + ch * 16) = R.v[i];
        if (WITHQ) *(LAS v4u*)(L + H_HQ + r * HRS + ch * 16) = R.q[i]; }
#pragma unroll
    for (int i = 0; i < 4; ++i) { const int e = tid + 512 * i, r = e >> 5, ch = e & 31; const unsigned lo_ = (unsigned)R.lf[i], hi_ = (unsigned)(R.lf[i] >> 32);
        *(LAS f32x4*)(L + H_LF + r * LFRS + ch * 16) = (f32x4){h2f((unsigned short)lo_), h2f((unsigned short)(lo_ >> 16)), h2f((unsigned short)hi_), h2f((unsigned short)(hi_ >> 16))}; }
}
__device__ __forceinline__ size_t h_t0(int it) { return (size_t)(it >> 9) * SEQ + (size_t)(it & 127) * 64; }
__device__ __forceinline__ void hgrn_a_phase(LAS unsigned char* L, int it0, int step, int end, const float* LF, const bf16* HIb, bf16* UT, float* GC, int tid, int lane, int wave) {
    HTileRegs R;
    if (it0 < end) h_tiles_load<false>(R, HIb, nullptr, LF, h_t0(it0), (it0 >> 7) & 3, tid);
    for (int it = it0; it < end; it += step) {
        const int bh = it >> 7, c = it & 127;
        h_tiles_store<false>(L, R, tid);
        H_BAR();
        __builtin_amdgcn_sched_barrier(0);
        if (it + step < end) h_tiles_load<false>(R, HIb, nullptr, LF, h_t0(it + step), ((it + step) >> 7) & 3, tid);
        __builtin_amdgcn_sched_barrier(0);
        const int dblk = wave & 3, vhalf = wave >> 2, i = lane & 31, kg = lane >> 5, d = 32 * dblk + i;
        float lf[32], bb[32], bC, bMid;
        h_cumsum(L, d, kg, lf, bb, bC, bMid);
        bf16x8 kf[4];
#pragma unroll
        for (int ks = 0; ks < 4; ++ks) { unsigned w[4];
#pragma unroll
            for (int j = 0; j < 4; ++j) { const int s0 = 8 * ks + 2 * j; w[j] = pkbf((1.f - ex(lf[s0])) * ex(bC - bb[s0]), (1.f - ex(lf[s0 + 1])) * ex(bC - bb[s0 + 1])); }
            kf[ks] = __builtin_bit_cast(bf16x8, (v4u){w[0], w[1], w[2], w[3]}); }
        if (vhalf == 0 && kg == 0) GC[((size_t)bh * 128 + c) * 128 + d] = ex(bC);
        const int q = (lane & 15) >> 2, p = lane & 3, g1 = (lane >> 4) & 1;
        f32x16h acc[2];
#pragma unroll
        for (int vt = 0; vt < 2; ++vt) { acc[vt] = f32x16h{};
            const lcptr vp = (lcptr)(L + H_VT) + (32 * kg + q) * HRS + (32 * (2 * vhalf + vt) + 16 * g1 + 4 * p) * 2;
#pragma unroll
            for (int ks = 0; ks < 4; ++ks) { const s16x4h lo = h_vtr(vp + (8 * ks) * HRS), hi4 = h_vtr(vp + (8 * ks + 4) * HRS);
                acc[vt] = __builtin_amdgcn_mfma_f32_32x32x16_bf16(h_cat(lo, hi4), kf[ks], acc[vt], 0, 0, 0); } }
        bf16* U = UT + ((size_t)bh * 128 + c) * 16384;
#pragma unroll
        for (int vt = 0; vt < 2; ++vt)
#pragma unroll
            for (int r = 0; r < 16; ++r) U[(size_t)(32 * (2 * vhalf + vt) + h_crow(r, kg)) * 128 + d] = (bf16)(pkbf(acc[vt][r], 0.f) & 0xffffu);
        H_BAR();
    }
    asm volatile("s_waitcnt vmcnt(0)" ::: "memory");
}
__device__ __forceinline__ void hgrn_scan(const bf16* UT, const float* GC, bf16* ST, float* outS, int e0, int estride) {
    for (int e = e0; e < 8 * 16384; e += estride) {
        const int bh = e >> 14, vd = e & 16383, d = e & 127, v = vd >> 7;
        const bf16* U = UT + (size_t)bh * 128 * 16384 + vd; const float* Gp = GC + (size_t)bh * 128 * 128 + d; bf16* Sp = ST + (size_t)bh * 128 * 16384 + vd;
        float S = 0.f;
        unsigned short ua[32], ub[32]; float ga[32], gb[32];
#define SC_LOAD(UU, GG, C0) do { _Pragma("unroll") for (int k = 0; k < 32; ++k) { UU[k] = U[(size_t)((C0) + k) * 16384]; GG[k] = Gp[((C0) + k) * 128]; } } while (0)
#define SC_RUN(UU, GG, C0) do { _Pragma("unroll") for (int k = 0; k < 32; ++k) { Sp[(size_t)((C0) + k) * 16384] = (bf16)(pkbf(S, 0.f) & 0xffffu); S = GG[k] * S + bf2f(UU[k]); } } while (0)
        SC_LOAD(ua, ga, 0); __builtin_amdgcn_sched_barrier(0);
        SC_LOAD(ub, gb, 32); __builtin_amdgcn_sched_barrier(0);
        SC_RUN(ua, ga, 0); __builtin_amdgcn_sched_barrier(0);
        SC_LOAD(ua, ga, 64); __builtin_amdgcn_sched_barrier(0);
        SC_RUN(ub, gb, 32); __builtin_amdgcn_sched_barrier(0);
        SC_LOAD(ub, gb, 96); __builtin_amdgcn_sched_barrier(0);
        SC_RUN(ua, ga, 64); __builtin_amdgcn_sched_barrier(0);
        SC_RUN(ub, gb, 96);
#undef SC_LOAD
#undef SC_RUN
        outS[((size_t)bh * 128 + d) * 128 + v] = S;
    }
}
__device__ __forceinline__ void hgrn_c_item(LAS unsigned char* L, int bh, int c, const float* LF, const bf16* HQb, const bf16* HIb, const bf16* HGb, const bf16* ST, const float* hgn_g, bf16* MIX, int tid, int lane, int wave) {
    const int b = bh >> 2, h = bh & 3; const size_t t0 = (size_t)b * SEQ + (size_t)c * 64;
    h_stage_tile(L, H_VT, HIb + t0 * 512 + h * 128, tid);
    h_stage_tile(L, H_HQ, HQb + t0 * 512 + h * 128, tid);
    h_stage_lf(L, LF + t0 * 512 + h * 128, tid);
    __syncthreads();
    {
        const int dblk = wave & 3, i = lane & 31, kg = lane >> 5, d = 32 * dblk + i;
        float lf[32], bb[32], bC, bMid;
        h_cumsum(L, d, kg, lf, bb, bC, bMid);
        if (wave < 4) {
#pragma unroll
            for (int s = 0; s < 32; ++s) { const int t = 32 * kg + s; const float qv = bf2f(*(const LAS bf16*)(L + H_HQ + t * HRS + d * 2));
                *(LAS bf16*)(L + H_QT + t * HRS + d * 2) = (bf16)(pkbf(qv * ex(bb[s] - bMid), 0.f) & 0xffffu);
                *(LAS bf16*)(L + H_QP + t * HRS + d * 2) = (bf16)(pkbf(qv * ex(bb[s]), 0.f) & 0xffffu); }
        } else {
#pragma unroll
            for (int s = 0; s < 32; ++s) { const int t = 32 * kg + s;
                *(LAS bf16*)(L + H_KT + t * HRS + d * 2) = (bf16)(pkbf((1.f - ex(lf[s])) * ex(bMid - bb[s]), 0.f) & 0xffffu); }
        }
    }
    __syncthreads();
    const int tb = wave & 1, vb = wave >> 1, n = lane & 31, hi = lane >> 5;
    const int q = (lane & 15) >> 2, p = lane & 3, g1 = (lane >> 4) & 1;
    f32x16h o = f32x16h{};
    for (int sb = 0; sb <= tb; ++sb) {
        f32x16h at = f32x16h{};
#pragma unroll
        for (int ks = 0; ks < 8; ++ks) {
            const bf16x8 ka = *(const LAS bf16x8*)(L + H_KT + (32 * sb + n) * HRS + (16 * ks + 8 * hi) * 2);
            const bf16x8 qb = *(const LAS bf16x8*)(L + H_QT + (32 * tb + n) * HRS + (16 * ks + 8 * hi) * 2);
            at = __builtin_amdgcn_mfma_f32_32x32x16_bf16(ka, qb, at, 0, 0, 0);
        }
        if (sb == tb) {
#pragma unroll
            for (int r = 0; r < 16; ++r) if (h_crow(r, hi) > n) at[r] = 0.f;
        }
#pragma unroll
        for (int kk = 0; kk < 2; ++kk) {
            const v4u pw = {pkbf(at[8 * kk + 0], at[8 * kk + 1]), pkbf(at[8 * kk + 2], at[8 * kk + 3]), pkbf(at[8 * kk + 4], at[8 * kk + 5]), pkbf(at[8 * kk + 6], at[8 * kk + 7])};
            const lcptr vp = (lcptr)(L + H_VT) + (32 * sb + 16 * kk + 4 * hi + q) * HRS + (32 * vb + 16 * g1 + 4 * p) * 2;
            const s16x4h lo = h_vtr(vp), hi4 = h_vtr(vp + 8 * HRS);
            o = __builtin_amdgcn_mfma_f32_32x32x16_bf16(h_cat(lo, hi4), __builtin_bit_cast(bf16x8, pw), o, 0, 0, 0);
        }
    }
    {
        const bf16* Sr = ST + ((size_t)bh * 128 + c) * 16384 + (size_t)(32 * vb + n) * 128 + 8 * hi;
#pragma unroll
        for (int ks = 0; ks < 8; ++ks) {
            const bf16x8 sa = *(const GAS bf16x8*)(Sr + 16 * ks);
            const bf16x8 qb = *(const LAS bf16x8*)(L + H_QP + (32 * tb + n) * HRS + (16 * ks + 8 * hi) * 2);
            o = __builtin_amdgcn_mfma_f32_32x32x16_bf16(sa, qb, o, 0, 0, 0);
        }
    }
    float ss = 0.f;
#pragma unroll
    for (int r = 0; r < 16; ++r) ss += o[r] * o[r];
    ss += __shfl_xor(ss, 32);
    LAS float* SS = (LAS float*)(L + H_SS);
    if (hi == 0) SS[(32 * tb + n) * 4 + vb] = ss;
    __syncthreads();
    const f32x4 s4 = *(const LAS f32x4*)(SS + (32 * tb + n) * 4);
    const float rs = __builtin_amdgcn_rsqf(((s4[0] + s4[1]) + (s4[2] + s4[3])) * (1.f / 128.f) + 1e-6f);
    const size_t row = t0 + 32 * tb + n;
#pragma unroll
    for (int rg = 0; rg < 4; ++rg) { const int v = 32 * vb + 8 * rg + 4 * hi;
        const unsigned long long gz = *(const GAS unsigned long long*)(HGb + row * 512 + h * 128 + v); const f32x4 gn = *(const GAS f32x4*)(hgn_g + v);
        const float g0 = bf2f((unsigned short)gz), g1f = bf2f((unsigned short)(gz >> 16)), g2 = bf2f((unsigned short)(gz >> 32)), g3 = bf2f((unsigned short)(gz >> 48));
        const unsigned w0 = pkbf(o[4 * rg + 0] * rs * gn[0] * g0, o[4 * rg + 1] * rs * gn[1] * g1f), w1 = pkbf(o[4 * rg + 2] * rs * gn[2] * g2, o[4 * rg + 3] * rs * gn[3] * g3);
        *(GAS unsigned long long*)(MIX + row * 1024 + 512 + h * 128 + v) = (unsigned long long)w0 | ((unsigned long long)w1 << 32); }
    __syncthreads();
}
__device__ __forceinline__ void hgrn_c_phase(LAS unsigned char* L, int it0, int step, const float* LF, const bf16* HQb, const bf16* HIb, const bf16* HGb, const bf16* ST, const float* hgn_g, bf16* MIX, int tid, int lane, int wave) {
    HTileRegs R;
    const int tb = wave & 1, vb = wave >> 1, n = lane & 31, hi = lane >> 5;
    bf16x8 sfr[8], sfn[8]; unsigned long long gzr[4], gzn[4];
#define HC_LOAD_SG(IT, SF, GZ) do { const int bh_ = (IT) >> 7, c_ = (IT) & 127; const size_t t0_ = (size_t)(bh_ >> 2) * SEQ + (size_t)c_ * 64; \
        const bf16* Sr_ = ST + ((size_t)bh_ * 128 + c_) * 16384 + (size_t)(32 * vb + n) * 128 + 8 * hi; \
        _Pragma("unroll") for (int ks = 0; ks < 8; ++ks) SF[ks] = *(const GAS bf16x8*)(Sr_ + 16 * ks); \
        _Pragma("unroll") for (int rg = 0; rg < 4; ++rg) GZ[rg] = *(const GAS unsigned long long*)(HGb + (t0_ + 32 * tb + n) * 512 + (bh_ & 3) * 128 + 32 * vb + 8 * rg + 4 * hi); } while (0)
    if (it0 < 1024) { h_tiles_load<true>(R, HIb, HQb, LF, h_t0(it0), (it0 >> 7) & 3, tid); HC_LOAD_SG(it0, sfr, gzr); }
    for (int it = it0; it < 1024; it += step) {
    const int bh = it >> 7, c = it & 127;
    const int b = bh >> 2, h = bh & 3; const size_t t0 = (size_t)b * SEQ + (size_t)c * 64;
    h_tiles_store<true>(L, R, tid);
    H_BAR();
    __builtin_amdgcn_sched_barrier(0);
    if (it + step < 1024) { h_tiles_load<true>(R, HIb, HQb, LF, h_t0(it + step), ((it + step) >> 7) & 3, tid); HC_LOAD_SG(it + step, sfn, gzn); }
    __builtin_amdgcn_sched_barrier(0);
    {
        const int dblk = wave & 3, i = lane & 31, kg = lane >> 5, d = 32 * dblk + i;
        float lf[32], bb[32], bC, bMid;
        h_cumsum(L, d, kg, lf, bb, bC, bMid);
        if (wave < 4) {
#pragma unroll
            for (int s = 0; s < 32; ++s) { const int t = 32 * kg + s; const float qv = bf2f(*(const LAS bf16*)(L + H_HQ + t * HRS + d * 2));
                *(LAS bf16*)(L + H_QT + t * HRS + d * 2) = (bf16)(pkbf(qv * ex(bb[s] - bMid), 0.f) & 0xffffu);
                *(LAS bf16*)(L + H_QP + t * HRS + d * 2) = (bf16)(pkbf(qv * ex(bb[s]), 0.f) & 0xffffu); }
        } else {
#pragma unroll
            for (int s = 0; s < 32; ++s) { const int t = 32 * kg + s;
                *(LAS bf16*)(L + H_KT + t * HRS + d * 2) = (bf16)(pkbf((1.f - ex(lf[s])) * ex(bMid - bb[s]), 0.f) & 0xffffu); }
        }
    }
    H_BAR();
    const int q = (lane & 15) >> 2, p = lane & 3, g1 = (lane >> 4) & 1;
    f32x16h o = f32x16h{};
    for (int sb = 0; sb <= tb; ++sb) {
        f32x16h at = f32x16h{};
#pragma unroll
        for (int ks = 0; ks < 8; ++ks) {
            const bf16x8 ka = *(const LAS bf16x8*)(L + H_KT + (32 * sb + n) * HRS + (16 * ks + 8 * hi) * 2);
            const bf16x8 qb = *(const LAS bf16x8*)(L + H_QT + (32 * tb + n) * HRS + (16 * ks + 8 * hi) * 2);
            at = __builtin_amdgcn_mfma_f32_32x32x16_bf16(ka, qb, at, 0, 0, 0);
        }
        if (sb == tb) {
#pragma unroll
            for (int r = 0; r < 16; ++r) if (h_crow(r, hi) > n) at[r] = 0.f;
        }
#pragma unroll
        for (int kk = 0; kk < 2; ++kk) {
            const v4u pw = {pkbf(at[8 * kk + 0], at[8 * kk + 1]), pkbf(at[8 * kk + 2], at[8 * kk + 3]), pkbf(at[8 * kk + 4], at[8 * kk + 5]), pkbf(at[8 * kk + 6], at[8 * kk + 7])};
            const lcptr vp = (lcptr)(L + H_VT) + (32 * sb + 16 * kk + 4 * hi + q) * HRS + (32 * vb + 16 * g1 + 4 * p) * 2;
            const s16x4h lo = h_vtr(vp), hi4 = h_vtr(vp + 8 * HRS);
            o = __builtin_amdgcn_mfma_f32_32x32x16_bf16(h_cat(lo, hi4), __builtin_bit_cast(bf16x8, pw), o, 0, 0, 0);
        }
    }
    {
#pragma unroll
        for (int ks = 0; ks < 8; ++ks) {
            const bf16x8 sa = sfr[ks];
            const bf16x8 qb = *(const LAS bf16x8*)(L + H_QP + (32 * tb + n) * HRS + (16 * ks + 8 * hi) * 2);
            o = __builtin_amdgcn_mfma_f32_32x32x16_bf16(sa, qb, o, 0, 0, 0);
        }
    }
    float ss = 0.f;
#pragma unroll
    for (int r = 0; r < 16; ++r) ss += o[r] * o[r];
    ss += __shfl_xor(ss, 32);
    LAS float* SS = (LAS float*)(L + H_SS);
    if (hi == 0) SS[(32 * tb + n) * 4 + vb] = ss;
    H_BAR();
    const f32x4 s4 = *(const LAS f32x4*)(SS + (32 * tb + n) * 4);
    const float rs = __builtin_amdgcn_rsqf(((s4[0] + s4[1]) + (s4[2] + s4[3])) * (1.f / 128.f) + 1e-6f);
    const size_t row = t0 + 32 * tb + n;
#pragma unroll
    for (int rg = 0; rg < 4; ++rg) { const int v = 32 * vb + 8 * rg + 4 * hi;
        const unsigned long long gz = gzr[rg]; const f32x4 gn = *(const GAS f32x4*)(hgn_g + v);
        const float g0 = bf2f((unsigned short)gz), g1f = bf2f((unsigned short)(gz >> 16)), g2 = bf2f((unsigned short)(gz >> 32)), g3 = bf2f((unsigned short)(gz >> 48));
        const unsigned w0 = pkbf(o[4 * rg + 0] * rs * gn[0] * g0, o[4 * rg + 1] * rs * gn[1] * g1f), w1 = pkbf(o[4 * rg + 2] * rs * gn[2] * g2, o[4 * rg + 3] * rs * gn[3] * g3);
        *(GAS unsigned long long*)(MIX + row * 1024 + 512 + h * 128 + v) = (unsigned long long)w0 | ((unsigned long long)w1 << 32); }
    H_BAR();
#pragma unroll
    for (int ks = 0; ks < 8; ++ks) sfr[ks] = sfn[ks];
#pragma unroll
    for (int rg = 0; rg < 4; ++rg) gzr[rg] = gzn[rg];
    }
    asm volatile("s_waitcnt vmcnt(0)" ::: "memory");
#undef HC_LOAD_SG
}
constexpr int SM_COEF = 0, SM_VV = 128 * 20 * 4, SM_A = SM_VV + 8 * 128 * 4, SM_EK = SM_A + 64 * 4, SM_RED = SM_EK + 8 * 129 * 4, SM_EQ = SM_RED + 4 * 8 * 128 * 4, SM_END = SM_EQ + 8 * 129 * 4;
__device__ __forceinline__ void hgrn_s_item(LAS unsigned char* L, int b, int h, const float* LF, const bf16* HQb, const bf16* HIb, const bf16* HGb, const float* S0, const float* hgn_g, float* outS, bf16* MIX, int tid, int lane, int wave) {
    LAS float* COEF = (LAS float*)(L + SM_COEF);
    LAS float* VV = (LAS float*)(L + SM_VV);
    LAS float* AM = (LAS float*)(L + SM_A);
    LAS float* EK = (LAS float*)(L + SM_EK);
    LAS float* EQ = (LAS float*)(L + SM_EQ);
    LAS float* RED = (LAS float*)(L + SM_RED);
    const size_t r0 = (size_t)MP + (size_t)b * 8;
    if (tid < 128) { const int d = tid; float bsum = 0.f; float bt[8], kk[8];
#pragma unroll
        for (int t = 0; t < 8; ++t) { const float lf = LF[(r0 + t) * 512 + h * 128 + d]; bsum += lf; bt[t] = bsum; kk[t] = 1.f - ex(lf);
            const float qe = bf2f(HQb[(r0 + t) * 512 + h * 128 + d]) * ex(bsum); COEF[d * 20 + t] = qe; EQ[t * 129 + d] = qe; EK[t * 129 + d] = kk[t] * ex(-bsum); }
#pragma unroll
        for (int t = 0; t < 8; ++t) COEF[d * 20 + 8 + t] = kk[t] * ex(bsum - bt[t]);
        COEF[d * 20 + 16] = ex(bsum);
    } else if (tid < 256) { const int v = tid - 128;
#pragma unroll
        for (int s = 0; s < 8; ++s) VV[s * 128 + v] = bf2f(HIb[(r0 + s) * 512 + h * 128 + v]); }
    __syncthreads();
    if (tid < 64) { const int t = tid >> 3, s = tid & 7; float a = 0.f;
        if (s <= t) { for (int d = 0; d < 128; ++d) a += EQ[t * 129 + d] * EK[s * 129 + d]; }
        AM[t * 8 + s] = a; }
    {
        const int v = tid & 127, dq = tid >> 7; float vv[8], acc[8];
#pragma unroll
        for (int s = 0; s < 8; ++s) { vv[s] = VV[s * 128 + v]; acc[s] = 0.f; }
        const float* Sin = S0 + ((size_t)(b * 4 + h) * 128) * 128 + v; float* So = outS + ((size_t)(b * 4 + h) * 128) * 128 + v;
        float s0v[32];
#pragma unroll
        for (int dd = 0; dd < 32; ++dd) s0v[dd] = Sin[(size_t)(32 * dq + dd) * 128];
#pragma unroll
        for (int dd = 0; dd < 32; ++dd) { const int d = 32 * dq + dd; const float s0 = s0v[dd];
            const f32x4 c0 = *(const LAS f32x4*)(COEF + d * 20), c1 = *(const LAS f32x4*)(COEF + d * 20 + 4), c2 = *(const LAS f32x4*)(COEF + d * 20 + 8), c3 = *(const LAS f32x4*)(COEF + d * 20 + 12); const float gd = COEF[d * 20 + 16];
            float sn = gd * s0;
            sn += c2[0] * vv[0]; sn += c2[1] * vv[1]; sn += c2[2] * vv[2]; sn += c2[3] * vv[3]; sn += c3[0] * vv[4]; sn += c3[1] * vv[5]; sn += c3[2] * vv[6]; sn += c3[3] * vv[7];
            So[(size_t)d * 128] = sn;
            acc[0] += c0[0] * s0; acc[1] += c0[1] * s0; acc[2] += c0[2] * s0; acc[3] += c0[3] * s0; acc[4] += c1[0] * s0; acc[5] += c1[1] * s0; acc[6] += c1[2] * s0; acc[7] += c1[3] * s0; }
#pragma unroll
        for (int t = 0; t < 8; ++t) RED[(dq * 8 + t) * 128 + v] = acc[t];
    }
    __syncthreads();
    {
        const int t = wave; float o[2];
#pragma unroll
        for (int k = 0; k < 2; ++k) { const int v = lane + 64 * k; float a = (RED[(0 * 8 + t) * 128 + v] + RED[(1 * 8 + t) * 128 + v]) + (RED[(2 * 8 + t) * 128 + v] + RED[(3 * 8 + t) * 128 + v]);
#pragma unroll
            for (int s = 0; s < 8; ++s) a += AM[t * 8 + s] * VV[s * 128 + v];
            o[k] = a; }
        const float rs = __builtin_amdgcn_rsqf(wave_sum(o[0] * o[0] + o[1] * o[1]) * (1.f / 128.f) + 1e-6f);
#pragma unroll
        for (int k = 0; k < 2; ++k) { const int v = lane + 64 * k;
            MIX[(r0 + t) * 1024 + 512 + h * 128 + v] = (bf16)(pkbf(o[k] * rs * hgn_g[v] * bf2f(HGb[(r0 + t) * 512 + h * 128 + v]), 0.f) & 0xffffu); }
    }
    __syncthreads();
}
__device__ __forceinline__ void hgrn_s_phase(LAS unsigned char* L, int j0, int step, const float* LF, const bf16* HQb, const bf16* HIb, const bf16* HGb, const float* S0, const float* hgn_g, float* outS, bf16* MIX, int tid, int lane, int wave) {
    LAS float* COEF = (LAS float*)(L + SM_COEF);
    LAS float* VV = (LAS float*)(L + SM_VV);
    LAS float* AM = (LAS float*)(L + SM_A);
    LAS float* EK = (LAS float*)(L + SM_EK);
    LAS float* EQ = (LAS float*)(L + SM_EQ);
    LAS float* RED = (LAS float*)(L + SM_RED);
    float s0v[32];
#define HS_LOAD(J) do { const float* Sin_ = S0 + ((size_t)(J) * 128) * 128 + (tid & 127) + (size_t)(32 * (tid >> 7)) * 128; _Pragma("unroll") for (int dd = 0; dd < 32; ++dd) s0v[dd] = Sin_[(size_t)dd * 128]; } while (0)
    if (j0 < 512) HS_LOAD(j0);
    for (int j = j0; j < 512; j += step) {
    const int b = j >> 2, h = j & 3;
    const size_t r0 = (size_t)MP + (size_t)b * 8;
    if (tid < 128) { const int d = tid; float bsum = 0.f; float bt[8], kk[8];
#pragma unroll
        for (int t = 0; t < 8; ++t) { const float lf = LF[(r0 + t) * 512 + h * 128 + d]; bsum += lf; bt[t] = bsum; kk[t] = 1.f - ex(lf);
            const float qe = bf2f(HQb[(r0 + t) * 512 + h * 128 + d]) * ex(bsum); COEF[d * 20 + t] = qe; EQ[t * 129 + d] = qe; EK[t * 129 + d] = kk[t] * ex(-bsum); }
#pragma unroll
        for (int t = 0; t < 8; ++t) COEF[d * 20 + 8 + t] = kk[t] * ex(bsum - bt[t]);
        COEF[d * 20 + 16] = ex(bsum);
    } else if (tid < 256) { const int v = tid - 128;
#pragma unroll
        for (int s = 0; s < 8; ++s) VV[s * 128 + v] = bf2f(HIb[(r0 + s) * 512 + h * 128 + v]); }
    __syncthreads();
    if (tid < 64) { const int t = tid >> 3, s = tid & 7; float a = 0.f;
        if (s <= t) {
#pragma unroll 16
            for (int d = 0; d < 128; ++d) a += EQ[t * 129 + d] * EK[s * 129 + d]; }
        AM[t * 8 + s] = a; }
    {
        const int v = tid & 127, dq = tid >> 7; float vv[8], acc[8];
#pragma unroll
        for (int s = 0; s < 8; ++s) { vv[s] = VV[s * 128 + v]; acc[s] = 0.f; }
        float* So = outS + ((size_t)(b * 4 + h) * 128) * 128 + v;
#pragma unroll
        for (int dd = 0; dd < 32; ++dd) { const int d = 32 * dq + dd; const float s0 = s0v[dd];
            const f32x4 c0 = *(const LAS f32x4*)(COEF + d * 20), c1 = *(const LAS f32x4*)(COEF + d * 20 + 4), c2 = *(const LAS f32x4*)(COEF + d * 20 + 8), c3 = *(const LAS f32x4*)(COEF + d * 20 + 12); const float gd = COEF[d * 20 + 16];
            float sn = gd * s0;
            sn += c2[0] * vv[0]; sn += c2[1] * vv[1]; sn += c2[2] * vv[2]; sn += c2[3] * vv[3]; sn += c3[0] * vv[4]; sn += c3[1] * vv[5]; sn += c3[2] * vv[6]; sn += c3[3] * vv[7];
            So[(size_t)d * 128] = sn;
            acc[0] += c0[0] * s0; acc[1] += c0[1] * s0; acc[2] += c0[2] * s0; acc[3] += c0[3] * s0; acc[4] += c1[0] * s0; acc[5] += c1[1] * s0; acc[6] += c1[2] * s0; acc[7] += c1[3] * s0; }
#pragma unroll
        for (int t = 0; t < 8; ++t) RED[(dq * 8 + t) * 128 + v] = acc[t];
        __builtin_amdgcn_sched_barrier(0);
        if (j + step < 512) HS_LOAD(j + step);
        __builtin_amdgcn_sched_barrier(0);
    }
    H_BAR();
    {
        const int t = wave; float o[2];
#pragma unroll
        for (int k = 0; k < 2; ++k) { const int v = lane + 64 * k; float a = (RED[(0 * 8 + t) * 128 + v] + RED[(1 * 8 + t) * 128 + v]) + (RED[(2 * 8 + t) * 128 + v] + RED[(3 * 8 + t) * 128 + v]);
#pragma unroll
            for (int s = 0; s < 8; ++s) a += AM[t * 8 + s] * VV[s * 128 + v];
            o[k] = a; }
        const float rs = __builtin_amdgcn_rsqf(wave_sum(o[0] * o[0] + o[1] * o[1]) * (1.f / 128.f) + 1e-6f);
#pragma unroll
        for (int k = 0; k < 2; ++k) { const int v = lane + 64 * k;
            MIX[(r0 + t) * 1024 + 512 + h * 128 + v] = (bf16)(pkbf(o[k] * rs * hgn_g[v] * bf2f(HGb[(r0 + t) * 512 + h * 128 + v]), 0.f) & 0xffffu); }
    }
    H_BAR();
    }
    asm volatile("s_waitcnt vmcnt(0)" ::: "memory");
#undef HS_LOAD
}

constexpr int SR_RED = 0;
struct HsRaw { unsigned short lf[8]; unsigned short hq[8]; unsigned short hi[8][2]; unsigned short hg[2]; float s0[16][2]; };
__device__ __forceinline__ void hs_load(HsRaw& R, int j, const float* LF, const bf16* HQb, const bf16* HIb, const bf16* HGb, const float* S0, int lane, int wave) {
    const int b = j >> 2, h = j & 3; const size_t r0 = (size_t)MP + (size_t)b * 8; const int d = 16 * wave + (lane & 15);
#pragma unroll
    for (int t = 0; t < 8; ++t) { R.lf[t] = ((const unsigned short*)LF)[(r0 + t) * 512 + h * 128 + d]; R.hq[t] = HQb[(r0 + t) * 512 + h * 128 + d];
        R.hi[t][0] = HIb[(r0 + t) * 512 + h * 128 + lane]; R.hi[t][1] = HIb[(r0 + t) * 512 + h * 128 + lane + 64]; }
    R.hg[0] = HGb[(r0 + wave) * 512 + h * 128 + lane]; R.hg[1] = HGb[(r0 + wave) * 512 + h * 128 + lane + 64];
    const float* Sin_ = S0 + ((size_t)j * 128 + 16 * wave) * 128 + lane;
#pragma unroll
    for (int i = 0; i < 16; ++i) { R.s0[i][0] = Sin_[(size_t)i * 128]; R.s0[i][1] = Sin_[(size_t)i * 128 + 64]; }
}
__device__ __forceinline__ void hgrn_s_phase2(LAS unsigned char* L, int j0, int step, int end, const float* LF, const bf16* HQb, const bf16* HIb, const bf16* HGb, const float* S0, const float* hgn_g, float* outS, bf16* MIX, int tid, int lane, int wave) {
    LAS float* RED = (LAS float*)(L + SR_RED);
    HsRaw C, N;
    if (j0 < end) hs_load(C, j0, LF, HQb, HIb, HGb, S0, lane, wave);
    const float gn0 = hgn_g[lane], gn1 = hgn_g[lane + 64];
    for (int j = j0; j < end; j += step) {
        const int b = j >> 2, h = j & 3; const size_t r0 = (size_t)MP + (size_t)b * 8;
        __builtin_amdgcn_sched_barrier(0);
        if (j + step < end) hs_load(N, j + step, LF, HQb, HIb, HGb, S0, lane, wave);
        __builtin_amdgcn_sched_barrier(0);
        float ek[8], eq[8], gd; { float bsum = 0.f;
#pragma unroll
            for (int t = 0; t < 8; ++t) { const float lf = h2f(C.lf[t]); bsum += lf; ek[t] = (1.f - ex(lf)) * ex(-bsum); eq[t] = bf2f(C.hq[t]) * ex(bsum); }
            gd = ex(bsum); }
        float acc[8][2];
#pragma unroll
        for (int t = 0; t < 8; ++t) { acc[t][0] = 0.f; acc[t][1] = 0.f; }
        float* So = outS + ((size_t)j * 128 + 16 * wave) * 128 + lane;
#pragma unroll
        for (int i = 0; i < 16; ++i) {
            float w0 = C.s0[i][0], w1 = C.s0[i][1];
#pragma unroll
            for (int s = 0; s < 8; ++s) { const float ks = __uint_as_float(__builtin_amdgcn_readlane(__float_as_uint(ek[s]), i)), qs = __uint_as_float(__builtin_amdgcn_readlane(__float_as_uint(eq[s]), i));
                w0 += ks * bf2f(C.hi[s][0]); w1 += ks * bf2f(C.hi[s][1]); acc[s][0] += qs * w0; acc[s][1] += qs * w1; }
            const float gi = __uint_as_float(__builtin_amdgcn_readlane(__float_as_uint(gd), i));
            So[(size_t)i * 128] = gi * w0; So[(size_t)i * 128 + 64] = gi * w1;
        }
#pragma unroll
        for (int t = 0; t < 8; ++t) { RED[(wave * 8 + t) * 128 + lane] = acc[t][0]; RED[(wave * 8 + t) * 128 + lane + 64] = acc[t][1]; }
        H_BAR();
        {
            const int t = wave; float o[2];
#pragma unroll
            for (int k = 0; k < 2; ++k) { const int v = lane + 64 * k; float a = 0.f;
#pragma unroll
                for (int w = 0; w < 8; ++w) a += RED[(w * 8 + t) * 128 + v];
                o[k] = a; }
            const float rs = __builtin_amdgcn_rsqf(wave_sum(o[0] * o[0] + o[1] * o[1]) * (1.f / 128.f) + 1e-6f);
            MIX[(r0 + t) * 1024 + 512 + h * 128 + lane] = (bf16)(pkbf(o[0] * rs * gn0 * bf2f(C.hg[0]), 0.f) & 0xffffu);
            MIX[(r0 + t) * 1024 + 512 + h * 128 + lane + 64] = (bf16)(pkbf(o[1] * rs * gn1 * bf2f(C.hg[1]), 0.f) & 0xffffu);
        }
        H_BAR();
        C = N;
    }
    asm volatile("s_waitcnt vmcnt(0)" ::: "memory");
}
typedef float f32x4d __attribute__((ext_vector_type(4)));
constexpr int DVRS = 272, DVR = 32 * DVRS;
constexpr int DC_PO = 0, DC_PM = 8 * DVR, DC_PL = DC_PM + 8 * 16 * 4, DC_SN = DC_PL + 8 * 16 * 4, DC_SQ = DC_SN + 2 * 8 * 16 * 4, DC_END = DC_SQ + 2 * 8 * 2 * 4;
static_assert(DVR >= 128 * 16 * 4 && DC_END <= 131072, "decode LDS map");
__device__ __forceinline__ bf16x8 cvt8(const f32x4d a, const f32x4d b) { v4u w = {pkbf(a[0], a[1]), pkbf(a[2], a[3]), pkbf(b[0], b[1]), pkbf(b[2], b[3])}; return __builtin_bit_cast(bf16x8, w); }
__device__ __forceinline__ float lam_value(const float* lq1, const float* lk1, const float* lq2, const float* lk2, int lane) {
    const float a = wave_sum(lq1[lane] * lk1[lane]), b = wave_sum(lq2[lane] * lk2[lane]);
    return ex(a) - ex(b) + 0.2f;
}
__device__ __forceinline__ void dec_item(LAS unsigned char* L, int b, int hp, const float* ck, const float* cv, const int* ptab, const bf16* Qb, const bf16* Kb, const bf16* Vb, const bf16* AGb,
                                         const float* subln_g, const float* lq1, const float* lk1, const float* lq2, const float* lk2, bf16* MIX, int tid_, int lane_, int wave) {
    int tid = tid_, lane = lane_;
    const int n = lane & 15, kg = lane >> 4;
    const int h = 2 * hp + (wave & 1), tq = wave >> 1;
    const size_t r0 = (size_t)MP + (size_t)b * 8;
    bf16x8 qx[4];
#pragma unroll
    for (int kk = 0; kk < 4; ++kk) { const bool on = (n < 8) == (kk < 2);
        v4u z = {0u, 0u, 0u, 0u}; if (on) z = *(const GAS v4u*)(Qb + (r0 + (n & 7)) * 512 + h * 128 + 32 * kk + 8 * kg);
        qx[kk] = __builtin_bit_cast(bf16x8, z); }
    f32x4d O[8];
#pragma unroll
    for (int mt = 0; mt < 8; ++mt) O[mt] = (f32x4d){0.f, 0.f, 0.f, 0.f};
    float m_run = -INFINITY, l_run = 0.f;
    LAS unsigned char* vst = L + DC_PO + wave * DVR;
    const lcptr vtr0 = (lcptr)vst + (4 * kg + ((lane & 15) >> 2)) * DVRS + (lane & 3) * 8;
    f32x4d kr[2][8], vr[16];
    const int pgv = ptab[b * 16 + (lane & 15)];
#define DEC_SB() __builtin_amdgcn_sched_barrier(0)
#define DEC_LOADK(IT) do { const int pg_ = __builtin_amdgcn_readlane(pgv, (IT)); const float* kb_ = ck + (((size_t)pg_ * 128 + tq * 32) * 4 + h) * 128 + (size_t)n * 512 + 8 * kg; \
        _Pragma("unroll") for (int tl = 0; tl < 2; ++tl) _Pragma("unroll") for (int kk = 0; kk < 4; ++kk) { const float* p = kb_ + (size_t)(16 * tl) * 512 + 32 * kk; kr[tl][2 * kk] = __builtin_nontemporal_load((const GAS f32x4d*)p); kr[tl][2 * kk + 1] = __builtin_nontemporal_load((const GAS f32x4d*)(p + 4)); } } while (0)
#define DEC_LOADV(IT) do { const int pg_ = __builtin_amdgcn_readlane(pgv, (IT)); const float* vb_ = cv + (((size_t)pg_ * 128 + tq * 32) * 4 + h) * 128 + (size_t)(lane >> 5) * 512 + (lane & 31) * 4; \
        _Pragma("unroll") for (int t = 0; t < 16; ++t) vr[t] = __builtin_nontemporal_load((const GAS f32x4d*)(vb_ + (size_t)(2 * t) * 512)); } while (0)
    DEC_LOADK(0); DEC_SB(); DEC_LOADV(0); DEC_SB();
    for (int it = 0; it < 16; ++it) {
        asm volatile("s_waitcnt vmcnt(16)" ::: "memory"); DEC_SB();
        f32x4d sa = (f32x4d){0.f, 0.f, 0.f, 0.f}, sb = (f32x4d){0.f, 0.f, 0.f, 0.f};
#pragma unroll
        for (int kk = 0; kk < 4; ++kk) { sa = __builtin_amdgcn_mfma_f32_16x16x32_bf16(cvt8(kr[0][2 * kk], kr[0][2 * kk + 1]), qx[kk], sa, 0, 0, 0);
                                         sb = __builtin_amdgcn_mfma_f32_16x16x32_bf16(cvt8(kr[1][2 * kk], kr[1][2 * kk + 1]), qx[kk], sb, 0, 0, 0); }
        DEC_SB();
        if (it < 15) { DEC_LOADK(it + 1); }
        DEC_SB();
        float mx = fmaxf(fmaxf(fmaxf(sa[0], sa[1]), fmaxf(sa[2], sa[3])), fmaxf(fmaxf(sb[0], sb[1]), fmaxf(sb[2], sb[3])));
        mx = fmaxf(mx, __shfl_xor(mx, 16)); mx = fmaxf(mx, __shfl_xor(mx, 32));
        const float m_new = fmaxf(m_run, mx); const float alpha = __builtin_amdgcn_exp2f(m_run - m_new); m_run = m_new;
        f32x4d pa, pb; float ps = 0.f;
#pragma unroll
        for (int r = 0; r < 4; ++r) { pa[r] = __builtin_amdgcn_exp2f(sa[r] - m_new); pb[r] = __builtin_amdgcn_exp2f(sb[r] - m_new); ps += pa[r] + pb[r]; }
        l_run = l_run * alpha + ps;
#pragma unroll
        for (int mt = 0; mt < 8; ++mt) O[mt] = O[mt] * alpha;
        const bf16x8 pB = cvt8(pa, pb);
        DEC_SB();
        if (it < 15) asm volatile("s_waitcnt vmcnt(16)" ::: "memory"); else asm volatile("s_waitcnt vmcnt(0)" ::: "memory");
        DEC_SB();
#pragma unroll
        for (int t = 0; t < 16; ++t) { const unsigned long long w = (unsigned long long)pkbf(vr[t][0], vr[t][1]) | ((unsigned long long)pkbf(vr[t][2], vr[t][3]) << 32);
            *(LAS unsigned long long*)(vst + (2 * t + (lane >> 5)) * DVRS + (lane & 31) * 8) = w; }
        DEC_SB();
        if (it < 15) { DEC_LOADV(it + 1); }
        DEC_SB();
#pragma unroll
        for (int mt = 0; mt < 8; ++mt) { const lcptr vp = vtr0 + mt * 32; const s16x4h lo = h_vtr(vp), hi4 = h_vtr(vp + 16 * DVRS);
            O[mt] = __builtin_amdgcn_mfma_f32_16x16x32_bf16(h_cat(lo, hi4), pB, O[mt], 0, 0, 0); }
    }
    asm volatile("s_waitcnt vmcnt(0)" ::: "memory");
#undef DEC_LOADV
#undef DEC_SB
#undef DEC_LOADK
    asm volatile("" : "+v"(tid), "+v"(lane));
    l_run += __shfl_xor(l_run, 16); l_run += __shfl_xor(l_run, 32);
    LAS float* PO = (LAS float*)(L + DC_PO); LAS float* PM = (LAS float*)(L + DC_PM); LAS float* PL = (LAS float*)(L + DC_PL); LAS float* SN = (LAS float*)(L + DC_SN); LAS float* SQ = (LAS float*)(L + DC_SQ);
#pragma unroll
    for (int mt = 0; mt < 8; ++mt)
#pragma unroll
        for (int r = 0; r < 4; ++r) PO[wave * (DVR / 4) + (16 * mt + 4 * kg + r) * 16 + n] = O[mt][r];
    if (kg == 0) { PM[wave * 16 + n] = m_run; PL[wave * 16 + n] = l_run; }
    const float lam = lam_value(lq1, lk1, lq2, lk2, lane);
    if (tid < 256) {
        const int hh = tid >> 7, j = (tid >> 4) & 7, col = tid & 15, q = col & 7, mp = col >> 3, h2 = 2 * hp + hh; float s = -INFINITY;
        if (j <= q) { s = 0.f; const GAS v4u* qp = (const GAS v4u*)(Qb + (r0 + q) * 512 + h2 * 128 + mp * 64); const GAS v4u* kp = (const GAS v4u*)(Kb + (r0 + j) * 512 + h2 * 128 + mp * 64);
            v4u qv[8], kv[8];
#pragma unroll
            for (int c8 = 0; c8 < 8; ++c8) { qv[c8] = qp[c8]; kv[c8] = kp[c8]; }
#pragma unroll
            for (int c8 = 0; c8 < 8; ++c8)
#pragma unroll
                for (int e = 0; e < 4; ++e) { s += __uint_as_float(qv[c8][e] << 16) * __uint_as_float(kv[c8][e] << 16); s += __uint_as_float(qv[c8][e] & 0xffff0000u) * __uint_as_float(kv[c8][e] & 0xffff0000u); } }
        SN[(hh * 8 + j) * 16 + col] = s;
    }
    __syncthreads();
    {
        const int dv = tid & 127, qg = tid >> 7; float o2[2][2];
#pragma unroll
        for (int hh = 0; hh < 2; ++hh) { const int h2 = 2 * hp + hh;
#pragma unroll
            for (int qq = 0; qq < 2; ++qq) { const int q = 2 * qg + qq; float res[2];
#pragma unroll
                for (int mp = 0; mp < 2; ++mp) { const int col = 8 * mp + q; float M = -INFINITY;
#pragma unroll
                    for (int w4 = 0; w4 < 4; ++w4) M = fmaxf(M, PM[(2 * w4 + hh) * 16 + col]);
#pragma unroll
                    for (int j = 0; j < 8; ++j) M = fmaxf(M, SN[(hh * 8 + j) * 16 + col]);
                    float Lsum = 0.f, Osum = 0.f;
#pragma unroll
                    for (int w4 = 0; w4 < 4; ++w4) { const int w = 2 * w4 + hh; const float wg = __builtin_amdgcn_exp2f(PM[w * 16 + col] - M); Lsum += wg * PL[w * 16 + col]; Osum += wg * PO[w * (DVR / 4) + dv * 16 + col]; }
#pragma unroll
                    for (int j = 0; j < 8; ++j) { const float wg = __builtin_amdgcn_exp2f(SN[(hh * 8 + j) * 16 + col] - M); Lsum += wg; Osum += wg * bf2f(Vb[(r0 + j) * 512 + h2 * 128 + dv]); }
                    res[mp] = Osum / Lsum; }
                o2[hh][qq] = res[0] - lam * res[1]; }
            const float s0 = wave_sum(o2[hh][0] * o2[hh][0]), s1 = wave_sum(o2[hh][1] * o2[hh][1]);
            if (lane == 0) { SQ[(hh * 8 + wave) * 2] = s0; SQ[(hh * 8 + wave) * 2 + 1] = s1; } }
        __syncthreads();
        const int wp = wave ^ 1;
#pragma unroll
        for (int hh = 0; hh < 2; ++hh) { const int h2 = 2 * hp + hh;
#pragma unroll
            for (int qq = 0; qq < 2; ++qq) { const int q = 2 * qg + qq; const float rs = __builtin_amdgcn_rsqf((SQ[(hh * 8 + wave) * 2 + qq] + SQ[(hh * 8 + wp) * 2 + qq]) * (1.f / 128.f) + 1e-6f);
                MIX[(r0 + q) * 1024 + h2 * 128 + dv] = (bf16)(pkbf(o2[hh][qq] * rs * subln_g[dv] * 0.8f * bf2f(AGb[(r0 + q) * 512 + h2 * 128 + dv]), 0.f) & 0xffffu); } }
    }
    __syncthreads();
}


template <int NR> __device__ __forceinline__ void attn_merge_rowsN(const bf16* OA, const bf16* AGb, const float* subln_g, float lam, bf16* MIX, int m0, int mstride, int lane) {
    const int half = lane >> 5, c = (2 * lane) & 63;
    unsigned a[NR][4], bq[NR][4], gz[NR][4];
#pragma unroll
    for (int r = 0; r < NR; ++r) { const int m = m0 + r * mstride; const size_t row = (size_t)(m < MP ? m : m0);
#pragma unroll
        for (int h = 0; h < 4; ++h) { a[r][h] = *(const GAS unsigned*)(OA + row * 1024 + (h * 4 + half) * 64 + c); bq[r][h] = *(const GAS unsigned*)(OA + row * 1024 + (h * 4 + 2 + half) * 64 + c);
            gz[r][h] = *(const GAS unsigned*)(AGb + row * 512 + h * 128 + 2 * lane); } }
    const float sg0 = subln_g[2 * lane] * 0.8f, sg1 = subln_g[2 * lane + 1] * 0.8f;
#pragma unroll
    for (int r = 0; r < NR; ++r) { const int m = m0 + r * mstride;
#pragma unroll
        for (int h = 0; h < 4; ++h) {
            const float o0 = bf2f((unsigned short)a[r][h]) - lam * bf2f((unsigned short)bq[r][h]), o1 = bf2f((unsigned short)(a[r][h] >> 16)) - lam * bf2f((unsigned short)(bq[r][h] >> 16));
            const float rs = __builtin_amdgcn_rsqf(wave_sum(o0 * o0 + o1 * o1) * (1.f / 128.f) + 1e-6f);
            const float g0 = sg0 * bf2f((unsigned short)gz[r][h]), g1 = sg1 * bf2f((unsigned short)(gz[r][h] >> 16));
            if (m < MP) *(GAS unsigned*)(MIX + (size_t)m * 1024 + h * 128 + 2 * lane) = pkbf(o0 * rs * g0, o1 * rs * g1); } }
}
struct Args { const void* in[18]; float* out; unsigned char* ws; int ph_lo, ph_hi, li, pad; };
__global__ void __launch_bounds__(NWAVES * 64, 2) mk_fwd(Args args) {
    extern __shared__ __attribute__((aligned(16))) unsigned char lds[];
    LAS unsigned char* L = (LAS unsigned char*)lds;
    volatile LAS unsigned* MISC = (volatile LAS unsigned*)(L + MISC_OFF);
    const int tid = threadIdx.x, lane = tid & 63, wave = __builtin_amdgcn_readfirstlane(tid >> 6);
    const int G = gridDim.x; const int bx = blockIdx.x; const int vcu = (G % 8 == 0) ? (bx % 8) * (G / 8) + bx / 8 : bx;
    unsigned char* ws = args.ws;
    gu32* ctl = (gu32*)(ws + WS_CTL);
    const float* xp = (const float*)args.in[0]; const float* xs = (const float*)args.in[1];
    const float* cache_k = (const float*)args.in[2]; const float* cache_v = (const float*)args.in[3]; const float* state0 = (const float*)args.in[4];
    const int* ptab = (const int*)args.in[5]; const float* norm_g = (const float*)args.in[6]; const float* w_in = (const float*)args.in[7];
    const float* qn_g = (const float*)args.in[8]; const float* kn_g = (const float*)args.in[9];
    const float* lq1 = (const float*)args.in[10]; const float* lk1 = (const float*)args.in[11]; const float* lq2 = (const float*)args.in[12]; const float* lk2 = (const float*)args.in[13];
    const float* subln_g = (const float*)args.in[14]; const float* lbl = (const float*)args.in[15]; const float* hgn_g = (const float*)args.in[16]; const float* w_out = (const float*)args.in[17];
    float* out = args.out;
    float* ROPE = (float*)(ws + WS_ROPE);
    bf16 *WinT = (bf16*)(ws + WS_WIN), *WoutT = (bf16*)(ws + WS_WOUT), *XN = (bf16*)(ws + WS_XN), *Qb = (bf16*)(ws + WS_Q), *Kb = (bf16*)(ws + WS_K), *Vb = (bf16*)(ws + WS_V),
         *AGb = (bf16*)(ws + WS_AG), *HQb = (bf16*)(ws + WS_HQ), *HIb = (bf16*)(ws + WS_HI), *HGb = (bf16*)(ws + WS_HG), *OA = (bf16*)(ws + WS_OA), *MIX = (bf16*)(ws + WS_MIX), *ST = (bf16*)(ws + WS_ST);
    float *LF = (float*)(ws + WS_LF), *GC = (float*)(ws + WS_GC); bf16* UT = (bf16*)(ws + WS_UT);


    for (int u = tid; u < (LDS_BYTES - LDSCTL_OFF) / 4; u += NWAVES * 64) ((LAS unsigned*)(L + LDSCTL_OFF))[u] = 0u;
    __syncthreads();
    XcdBarrier bar = xcd_barrier_post((unsigned*)(ctl + CW_BAR) + args.li * XCD_BAR_WORDS, MISC + 8);
    const int lo = args.ph_lo, hi = args.ph_hi;
#define IN(k) (lo <= (k) && (k) < hi)
#define BOTH(k) (IN(k) && IN((k) + 1))
#define GRID_BAR() xcd_barrier(bar)

    if (IN(0)) {
        LAS float* scr = (LAS float*)(L + RING_OFF + wave * 16384);
        const int gw = vcu * NWAVES + wave, NGW = G * NWAVES;
        constexpr int I_IN = (1024 / 64) * (DIN / 32), I_OUT = (1024 / 64) * (1024 / 32);
        for (int it = gw; it < I_IN + I_OUT; it += NGW) {
            if (it < I_IN) p0_transpose_item<true>(w_in, 1024, DIN, WinT, scr, it, lane);
            else p0_transpose_item<false>(w_out, 1024, 1024, WoutT, scr, it - I_IN, lane);
        }
        for (int m = gw; m < MT; m += 4 * NGW) rms_rows4_to_bf16(xp, xs, norm_g, XN, m, NGW, lane);
        for (int e = bx * (NWAVES * 64) + tid; e < 8192 * 8; e += G * NWAVES * 64) rope_entry(e >> 3, e & 7, ROPE);
        if (BOTH(0)) GRID_BAR();
    }
    if (IN(1)) {
        pg8::Gemm g{XN, WinT, MT, DIN, 1024};
        pg8::EpiProj E{Qb, Kb, Vb, AGb, HQb, HIb, HGb, LF, out + O_KP, out + O_KS, out + O_VP, out + O_VS, qn_g, kn_g, lbl, ROPE};
        const bool split = (G == 256) && BOTH(1);
        { const pg8::P1Order S{G, bx, 0, split ? 4 : (1 << 20)};
          pg8::gemm_phase<pg8::EpiProj, pg8::P1Order, true, true>(L + RING_OFF, g, S, E); }
        if (BOTH(1)) GRID_BAR();
        if (split && bx < 64) { const pg8::P1Order S{G, bx, 4, 1};
          pg8::gemm_phase<pg8::EpiProj, pg8::P1Order, true, true>(L + RING_OFF, g, S, E); }
    }
    if (IN(2)) {
        int a0 = vcu, as = G, ae = 1024, s0 = vcu, ss = G, se = 512;
        if (G == 256) {
            if (bx < 64) { a0 = 1024; s0 = 448 + bx; ss = 64; }
            else if (bx < 192) { a0 = bx - 64; as = 128; ae = 768; s0 = bx - 64; ss = 128; se = 256; }
            else { a0 = 768 + (bx - 192); as = 64; s0 = 256 + (bx - 192); ss = 64; se = 448; }
        }
        hgrn_a_phase(L + RING_OFF, a0, as, ae, LF, HIb, UT, GC, tid, lane, wave);
        hgrn_s_phase2(L + RING_OFF, s0, ss, se, LF, HQb, HIb, HGb, state0, hgn_g, out + O_SS, MIX, tid, lane, wave);

        if (BOTH(2)) GRID_BAR();
    }
    if (IN(3)) {
        hgrn_scan(UT, GC, ST, out + O_SP, bx * (NWAVES * 64) + tid, G * NWAVES * 64);
        __syncthreads();
        if (G == 256) {
            const int dgrp = (vcu >> 2) & 3;
            const int nbefore = dgrp == 0 ? 0 : dgrp == 3 ? 2 : 1;
            const attn128::StaticOrder S(G, bx); attn128::AttnUnit u;
#define ATTN_UNIT_(i) do { S.next((dgrp == 2) ? 1 - (i) : (i), u); attn128::attn_unit<8>(u.bh / attn128::NHEAD, u.bh % attn128::NHEAD, u.qb, (const attn128::bf16*)Qb, (const attn128::bf16*)Kb, (const attn128::bf16*)Vb, (attn128::bf16*)OA, (char*)lds + RING_OFF); } while (0)
            for (int i = 0; i < nbefore; ++i) ATTN_UNIT_(i);
            { int jv = vcu; asm volatile("" : "+s"(jv));
              for (int j = jv; j < 256; j += G) dec_item(L + RING_OFF, j >> 1, j & 1, cache_k, cache_v, ptab, Qb, Kb, Vb, AGb, subln_g, lq1, lk1, lq2, lk2, MIX, tid, lane, wave); }
            int i2 = nbefore; asm volatile("" : "+s"(i2));
            for (int i = i2; i < 2; ++i) ATTN_UNIT_(i);
#undef ATTN_UNIT_
        }
        if (BOTH(3)) GRID_BAR();
    }
    if (IN(4)) {
        if (G == 256 && vcu < 16) {
            pg8::Gemm g{MIX, WoutT, MT, 1024, 1024}; const pg8::OneUnit S1{64 + (vcu >> 2), vcu & 3};
            pg8::EpiOut E{xp, xs, out + O_YP};
            pg8::gemm_phase<pg8::EpiOut, pg8::OneUnit, true, true>(L + RING_OFF, g, S1, E);
            __syncthreads();
        } else if (G == 256) hgrn_c_phase(L + RING_OFF, vcu - 16, G - 16, LF, HQb, HIb, HGb, ST, hgn_g, MIX, tid, lane, wave);
        else hgrn_c_phase(L + RING_OFF, vcu, G, LF, HQb, HIb, HGb, ST, hgn_g, MIX, tid, lane, wave);
        { const float lam = lam_value(lq1, lk1, lq2, lk2, lane);
          for (int m = vcu * NWAVES + wave; m < MP; m += 8 * G * NWAVES) attn_merge_rowsN<8>(OA, AGb, subln_g, lam, MIX, m, G * NWAVES, lane); }
        if (BOTH(4)) GRID_BAR();
    }
    if (IN(5)) {
        const int mrows = (G == 256) ? MP : MT;
        pg8::Gemm g{MIX, WoutT, mrows, 1024, 1024}; pg8::StaticOrder S; S.init(mrows, 1024, G, bx);
        pg8::EpiOut E{xp, xs, out + O_YP};
        pg8::gemm_phase<pg8::EpiOut, pg8::StaticOrder, true, true>(L + RING_OFF, g, S, E);
    }
#undef IN
#undef BOTH
#undef GRID_BAR
}

static int mk_grid() {
    static int grid = 0;
    if (grid == 0) {
        int dev = 0, cus = 0, per_cu = 0;
        if (hipGetDevice(&dev) != hipSuccess || hipDeviceGetAttribute(&cus, hipDeviceAttributeMultiprocessorCount, dev) != hipSuccess) { grid = -1; return grid; }
        if (hipFuncSetAttribute((const void*)mk_fwd, hipFuncAttributeMaxDynamicSharedMemorySize, LDS_BYTES) != hipSuccess) { grid = -1; return grid; }
        if (hipOccupancyMaxActiveBlocksPerMultiprocessor(&per_cu, (const void*)mk_fwd, NWAVES * 64, LDS_BYTES) != hipSuccess || per_cu < 1) { (void)hipGetLastError(); fprintf(stderr, "mk: occupancy query says %d\n", per_cu); }
        grid = cus;
        if (grid != 256) fprintf(stderr, "mk: %d CUs; this kernel's unit orders are built for 256\n", grid);
    }
    return grid;
}
static void mk_launch(void* const* d_in, float* out, void* d_ws, hipStream_t stream, int lo, int hi, int li) {
    const int grid = mk_grid(); if (grid <= 0) return;
    Args a{}; for (int i = 0; i < 18; ++i) a.in[i] = d_in[i];
    a.out = out; a.ws = (unsigned char*)d_ws; a.ph_lo = lo; a.ph_hi = hi; a.li = li; a.pad = 0;
    hipLaunchKernelGGL(mk_fwd, dim3(grid), dim3(NWAVES * 64), LDS_BYTES, stream, a);
}
extern "C" void kernel_launch(void* const* d_in, const int* in_sizes, int n_in, void* d_out, int out_size, void* d_ws, size_t ws_size, hipStream_t stream) {
    if (hipMemsetAsync((char*)d_ws + WS_CTL, 0, CTL_ZERO_BYTES, stream) != hipSuccess) return;
    mk_launch(d_in, (float*)d_out, d_ws, stream, 0, 6, 0);
}
```

```cpp
#include <hip/hip_runtime.h>
#include <cstdio>
#include <cstdint>
#include <cmath>
constexpr int NWAVES = 8;
constexpr int MP = 16384, MS = 1024, MT = 17408, DMODEL = 1024, DIN = 4096, SEQ = 8192;
constexpr float C2 = 0.125f * 1.4426950408889634f;
constexpr float LOG2E = 1.4426950408889634f, LN2 = 0.6931471805599453f;
constexpr size_t MiB = 1u << 20;
constexpr size_t WS_CTL = 0, CTL_ZERO_BYTES = 1 * MiB;
constexpr size_t WS_ROPE = 1 * MiB, WS_WIN = 2 * MiB, WS_WOUT = 10 * MiB, WS_XN = 16 * MiB, WS_Q = 52 * MiB, WS_K = 70 * MiB, WS_V = 88 * MiB,
                 WS_AG = 106 * MiB, WS_HQ = 124 * MiB, WS_HI = 142 * MiB, WS_HG = 160 * MiB, WS_LF = 178 * MiB, WS_OA = 212 * MiB, WS_MIX = 244 * MiB,
                 WS_UT = 280 * MiB, WS_GC = 344 * MiB, WS_ST = 346 * MiB, WS_FAST_END = 380 * MiB;
constexpr size_t WS_ORACLE = 1536 * MiB;
constexpr int CW_TMO = 0, CW_CODE = 1, CW_BAR = 4096, CW_DIAG = 65536;
constexpr size_t WS_FOUT = 1024 * MiB;
constexpr size_t O_YP = 0, O_YS = O_YP + (size_t)MP * 1024, O_KP = O_YS + (size_t)MS * 1024, O_VP = O_KP + (size_t)MP * 512,
                 O_SP = O_VP + (size_t)MP * 512, O_KS = O_SP + (size_t)2 * 4 * 128 * 128, O_VS = O_KS + (size_t)MS * 512,
                 O_SS = O_VS + (size_t)MS * 512;
constexpr int RING_OFF = 0, RING_BYTES = 131072, LDSCTL_OFF = RING_BYTES, MISC_OFF = LDSCTL_OFF + 320, LDS_BYTES = 147456;

__device__ __forceinline__ float wave_sum(float v) {
#pragma unroll
    for (int o = 1; o < 64; o <<= 1) v += __shfl_xor(v, o);
    return v;
}
__device__ __forceinline__ float fast_silu(float x) { return x * __builtin_amdgcn_rcpf(1.f + __builtin_amdgcn_exp2f(-x * LOG2E)); }
__device__ __forceinline__ float fast_sigmoid(float x) { return __builtin_amdgcn_rcpf(1.f + __builtin_amdgcn_exp2f(-x * LOG2E)); }
__device__ __forceinline__ unsigned pkbf(float lo, float hi) { typedef float f2 __attribute__((ext_vector_type(2))); typedef __bf16 b2 __attribute__((ext_vector_type(2)));
    f2 v = {lo, hi}; b2 b = __builtin_convertvector(v, b2); return __builtin_bit_cast(unsigned, b); }
__device__ __forceinline__ float bf2f(unsigned short b) { return __uint_as_float((unsigned)b << 16); }
__host__ __device__ __forceinline__ int win_row_of_col(int n) {
    if (n >= 1024) return n;
    const int pn = n >> 8, ca = n & 255, wc = ca >> 6, bj = (ca >> 5) & 1, r = ca & 31;
    return pn * 256 + 128 * bj + 32 * wc + r;
}
namespace pg8 {
#define PG8_LAS __attribute__((address_space(3)))
typedef unsigned short bf16_t;
typedef short bf16x8 __attribute__((ext_vector_type(8)));
typedef float f32x4 __attribute__((ext_vector_type(4)));
typedef unsigned u32x4 __attribute__((ext_vector_type(4)));
constexpr int BM = 256, BK = 64, HALF = 128, HTB = HALF * BK * 2  , STAGE_BYTES = 8 * HTB, NXCD = 8, WGM = 8;

__host__ __device__ __forceinline__ int lds_byte(int r, int c) { const int st = (r >> 4) * 2 + (c >> 5), rr = r & 15, cc = c & 31, ob = rr * 64 + cc * 2; return st * 1024 + (ob ^ (((ob >> 9) & 1) << 5)); }
__host__ __device__ __forceinline__ void stage_rc(int b, int& R, int& C) { const int st = b / 1024, sb = b % 1024, swz = sb ^ (((sb >> 9) & 1) << 5); R = (st >> 1) * 16 + swz / 64; C = (st & 1) * 32 + (swz % 64) / 2; }
__host__ __device__ __forceinline__ int perm32(int rho) { const int n = rho >> 4, i = rho & 15; return 8 * (i >> 2) + 4 * n + (i & 3); }

struct Unit { int pm, pn; };
struct Gemm { const bf16_t* A; const bf16_t* Bt; int M, N, K; };

struct StaticOrder {
    int nM, nN, nwg, G, c;
    __host__ __device__ void init(int M, int N, int G_, int c_) { nM = M / BM; nN = N / BM; nwg = nM * nN; G = G_; c = c_; }
    __host__ __device__ bool next(int i, Unit& u) const {
        const long L = (long)i * G + c; if (L >= nwg) return false;
        int wgid = (int)L; { const int q = nwg / NXCD, r = nwg % NXCD, xcd = wgid % NXCD, off = wgid / NXCD; wgid = (xcd < r ? xcd * (q + 1) : r * (q + 1) + (xcd - r) * q) + off; }
        const int nig = WGM * nN, gid = wgid / nig, fm = gid * WGM, gsz = (nM - fm) < WGM ? (nM - fm) : WGM;
        u.pm = fm + ((wgid % nig) % gsz); u.pn = (wgid % nig) / gsz; return true;
    }
    __device__ __forceinline__ void a_ready(const Unit&) const {}
    __device__ __forceinline__ void done(const Unit&) const {}
};

__device__ __forceinline__ unsigned cvt_pk_bf16(float lo, float hi) { unsigned r; asm volatile("v_cvt_pk_bf16_f32 %0, %1, %2" : "=v"(r) : "v"(lo), "v"(hi)); return r; }
typedef float f32x2 __attribute__((ext_vector_type(2)));
__device__ __forceinline__ f32x2 gelu_pk(f32x2 v) {
    const f32x2 av = __builtin_elementwise_abs(v), d = av * 0.2316418882f + 1.0f;
    f32x2 t; t.x = __builtin_amdgcn_rcpf(d.x); t.y = __builtin_amdgcn_rcpf(d.y);
    f32x2 q = t * 0.5307027145f + (-0.7265760135f); q = q * t + 0.7107068705f; q = q * t + (-0.142248368f); q = q * t + 0.127414796f; q = q * t;
    const f32x2 s = (v * v) * (-0.72134752044f);
    f32x2 e; e.x = __builtin_amdgcn_exp2f(s.x); e.y = __builtin_amdgcn_exp2f(s.y);
    const f32x2 m = v * (q * e), r = v - m;
    f32x2 o; o.x = v.x < 0.f ? m.x : r.x; o.y = v.y < 0.f ? m.y : r.y; return o;
}

template <int ACT  > struct EpiBf16 {
    static constexpr bool PERM = true, AFTER_DRAIN = false; static_assert(ACT == 0 || ACT == 1, "EpiBf16: ACT is 0 (none) or 1 (gelu_pk)");
    bf16_t* O; int ldc; const float* bias; int split_cols; size_t split_stride; float scale0;
    __device__ __forceinline__ void operator()(const f32x4 (&acc)[2][2][4][2], const Unit& u, int wr, int wc, int fr, int fq) const {
        const int row0 = u.pm * BM + wr * 64 + fr; int colt = u.pn * BM; bf16_t* base = O;
        float sc = 1.f; if (split_cols) { const int t = colt / split_cols; base += (size_t)t * split_stride; colt -= t * split_cols; if (t == 0) sc = scale0; }
        const int col0 = colt + wc * 32 + 8 * fq, bcol0 = u.pn * BM + wc * 32 + 8 * fq;
        f32x4 bv[2][2];
#pragma unroll
        for (int bj = 0; bj < 2; ++bj)
#pragma unroll
            for (int n = 0; n < 2; ++n) bv[bj][n] = bias ? *(const f32x4*)(bias + bcol0 + bj * HALF + 4 * n) : (f32x4){0.f, 0.f, 0.f, 0.f};
#pragma unroll
        for (int ai = 0; ai < 2; ++ai)
#pragma unroll
            for (int m = 0; m < 4; ++m) { bf16_t* rowp = base + (size_t)(row0 + ai * HALF + m * 16) * ldc + col0;
#pragma unroll
                for (int bj = 0; bj < 2; ++bj) { f32x4 v0 = acc[ai][bj][m][0] + bv[bj][0], v1 = acc[ai][bj][m][1] + bv[bj][1];
                    if (ACT == 1) { f32x2 a = gelu_pk((f32x2){v0[0], v0[1]}), b = gelu_pk((f32x2){v0[2], v0[3]}), c = gelu_pk((f32x2){v1[0], v1[1]}), d = gelu_pk((f32x2){v1[2], v1[3]});
                        v0 = (f32x4){a.x, a.y, b.x, b.y}; v1 = (f32x4){c.x, c.y, d.x, d.y}; }
                    v0 = v0 * sc; v1 = v1 * sc; u32x4 w; w.x = cvt_pk_bf16(v0[0], v0[1]); w.y = cvt_pk_bf16(v0[2], v0[3]); w.z = cvt_pk_bf16(v1[0], v1[1]); w.w = cvt_pk_bf16(v1[2], v1[3]);
                    *(u32x4*)(rowp + bj * HALF) = w; } }
    }
};

struct PanelStats {
    unsigned* xbuf;
    unsigned* cnt;
    unsigned* tmo;
    int ntn; float eps;
    unsigned code;
    __device__ __forceinline__ bool run(const f32x4 (&v)[2][2][4][2], const Unit& u, int wr, int wc, int fr, int fq, PG8_LAS unsigned char* lds, int wid, int lane) const {
        typedef float f32x2v __attribute__((ext_vector_type(2)));
        PG8_LAS f32x2v* P = (PG8_LAS f32x2v*)lds;
        PG8_LAS f32x2v* S = (PG8_LAS f32x2v*)(lds + 8192);
        PG8_LAS unsigned* flag = (PG8_LAS unsigned*)(lds + 8192 + 2048);
#pragma unroll
        for (int ai = 0; ai < 2; ++ai)
#pragma unroll
            for (int m = 0; m < 4; ++m) {
                float s = 0.f;
#pragma unroll
                for (int bj = 0; bj < 2; ++bj)
#pragma unroll
                    for (int n = 0; n < 2; ++n) { const f32x4 x = v[ai][bj][m][n]; s += (x[0] + x[1]) + (x[2] + x[3]); }
                s += __shfl_xor(s, 16); s += __shfl_xor(s, 32);
                const float mw = s * (1.0f / 64.0f); float q = 0.f;
#pragma unroll
                for (int bj = 0; bj < 2; ++bj)
#pragma unroll
                    for (int n = 0; n < 2; ++n) { const f32x4 d = v[ai][bj][m][n] - mw; q += (d[0] * d[0] + d[1] * d[1]) + (d[2] * d[2] + d[3] * d[3]); }
                q += __shfl_xor(q, 16); q += __shfl_xor(q, 32);
                if (fq == 0) P[(ai * HALF + wr * 64 + m * 16 + fr) * 4 + wc] = (f32x2v){mw, q};
            }
        asm volatile("s_waitcnt lgkmcnt(0)" ::: "memory"); __builtin_amdgcn_s_barrier(); asm volatile("" ::: "memory");
#if defined(BROKEN_EXCHANGE_NO_WAIT)
#warning BROKEN CONTROL BUILD: the row-statistics exchange does not wait; results are wrong by design
        if (blockIdx.x >= 64) { const long long t0_ = clock64(); while (clock64() - t0_ < 60000) __builtin_amdgcn_s_sleep(8); }
#endif
        const int row = wid * 32 + (lane & 31);
        if (lane < 32) {
            const f32x2v a = P[row * 4 + 0], b = P[row * 4 + 1], c = P[row * 4 + 2], d = P[row * 4 + 3];
            const float mt = (a.x + b.x + c.x + d.x) * 0.25f;
            const float da = a.x - mt, db = b.x - mt, dc = c.x - mt, dd = d.x - mt;
            const float m2 = (a.y + b.y) + (c.y + d.y) + 64.0f * ((da * da + db * db) + (dc * dc + dd * dd));
            unsigned long long* slot = (unsigned long long*)xbuf + ((size_t)(u.pm * BM + row) * 4 + u.pn);
            __hip_atomic_store(slot, ((unsigned long long)__float_as_uint(m2) << 32) | __float_as_uint(mt), __ATOMIC_RELAXED, __HIP_MEMORY_SCOPE_AGENT);
        }
        asm volatile("s_waitcnt vmcnt(0)" ::: "memory");
        if (lane == 0) __hip_atomic_fetch_add(cnt + 64 * u.pm, 1u, __ATOMIC_RELAXED, __HIP_MEMORY_SCOPE_AGENT);
        if (wid == 0) {
            bool dead = false; const unsigned long long t0 = __builtin_amdgcn_s_memrealtime(); const unsigned want = 8u * (unsigned)ntn;
            for (;;) {
#if defined(BROKEN_EXCHANGE_NO_WAIT)
                break;
#endif
                if ((unsigned)__builtin_amdgcn_readfirstlane(__hip_atomic_load(cnt + 64 * u.pm, __ATOMIC_RELAXED, __HIP_MEMORY_SCOPE_AGENT)) >= want) break;
                if (__builtin_amdgcn_s_memrealtime() - t0 > 2000000ull) {
                    if (lane == 0) { unsigned expect = 0u; __hip_atomic_compare_exchange_strong(tmo + 1, &expect, code | (unsigned)(u.pm & 0xff), __ATOMIC_RELAXED, __ATOMIC_RELAXED, __HIP_MEMORY_SCOPE_AGENT);
                                     __hip_atomic_store(tmo, 1u, __ATOMIC_RELAXED, __HIP_MEMORY_SCOPE_AGENT); }
                    dead = true; break; }
                __builtin_amdgcn_s_sleep(2);
            }
            __builtin_amdgcn_fence(__ATOMIC_ACQUIRE, "agent");
            if (lane == 0) flag[0] = dead ? 1u : 0u;
        }
        asm volatile("s_waitcnt vmcnt(0) lgkmcnt(0)" ::: "memory"); __builtin_amdgcn_s_barrier(); asm volatile("" ::: "memory");
        const bool bad = flag[0] != 0u;
        if (lane < 32) {
            const unsigned long long* slot = (const unsigned long long*)xbuf + (size_t)(u.pm * BM + row) * 4; float mt[4], m2[4]; float ms = 0.f;
#pragma unroll
            for (int t = 0; t < 4; ++t) { if (t < ntn) { const unsigned long long w = __hip_atomic_load(slot + t, __ATOMIC_RELAXED, __HIP_MEMORY_SCOPE_AGENT); mt[t] = __uint_as_float((unsigned)w); m2[t] = __uint_as_float((unsigned)(w >> 32)); } else { mt[t] = 0.f; m2[t] = 0.f; } ms += mt[t]; }
            const float mean = ms / (float)ntn; float q = 0.f;
#pragma unroll
            for (int t = 0; t < 4; ++t) if (t < ntn) { const float dm = mt[t] - mean; q += m2[t] + 256.0f * dm * dm; }
            S[row] = (f32x2v){mean, 1.0f / sqrtf(q / (256.0f * (float)ntn) + eps)};
        }
        asm volatile("s_waitcnt lgkmcnt(0)" ::: "memory"); __builtin_amdgcn_s_barrier(); asm volatile("" ::: "memory");
        return bad;
    }
};
struct EpiLnRes {
    static constexpr bool PERM = false, AFTER_DRAIN = true;
    const float* base; float* out; int ldc; const float* bias; PanelStats st; unsigned poison;
    __device__ __forceinline__ void fused(f32x4 (&acc)[2][2][4][2], const Unit& u, int wr, int wc, int fr, int fq, PG8_LAS unsigned char* lds, int wid, int lane) const {
        typedef float f32x2v __attribute__((ext_vector_type(2)));
        const PG8_LAS f32x2v* S = (const PG8_LAS f32x2v*)(lds + 8192);
        const int col0 = u.pn * BM + wc * 32 + 4 * fq;
#pragma unroll
        for (int bj = 0; bj < 2; ++bj)
#pragma unroll
            for (int n = 0; n < 2; ++n) { const f32x4 bv = bias ? *(const f32x4*)(bias + col0 + bj * HALF + n * 16) : (f32x4){0.f, 0.f, 0.f, 0.f};
#pragma unroll
                for (int ai = 0; ai < 2; ++ai)
#pragma unroll
                    for (int m = 0; m < 4; ++m) acc[ai][bj][m][n] += bv; }
        f32x4 pre[4][2][2];
#pragma unroll
        for (int m = 0; m < 4; ++m) { const size_t off = (size_t)(u.pm * BM + wr * 64 + m * 16 + fr) * ldc + col0;
#pragma unroll
            for (int bj = 0; bj < 2; ++bj)
#pragma unroll
                for (int n = 0; n < 2; ++n) pre[m][bj][n] = *(const f32x4*)(base + off + bj * HALF + n * 16); }
        const bool bad = st.run(acc, u, wr, wc, fr, fq, lds, wid, lane) || poison != 0u;
        const float qnan = __builtin_nanf("");
#pragma unroll
        for (int ai = 0; ai < 2; ++ai)
#pragma unroll
            for (int m = 0; m < 4; ++m) { const int r = ai * HALF + wr * 64 + m * 16 + fr; const f32x2v sr = S[r]; const size_t off = (size_t)(u.pm * BM + r) * ldc + col0;
#pragma unroll
                for (int bj = 0; bj < 2; ++bj)
#pragma unroll
                    for (int n = 0; n < 2; ++n) { const f32x4 bs = ai == 0 ? pre[m][bj][n] : *(const f32x4*)(base + off + bj * HALF + n * 16); f32x4 o = bs + (acc[ai][bj][m][n] - sr.x) * sr.y;
                        if (bad) o = (f32x4){qnan, qnan, qnan, qnan}; *(f32x4*)(out + off + bj * HALF + n * 16) = o; }
                if (m & 1) asm volatile("" ::: "memory"); }
    }
};
struct EpiLnResLn {
    static constexpr bool PERM = false, AFTER_DRAIN = true;
    const float* base; float* out; bf16_t* xn; int ldc; const float* bias; PanelStats st1, st2; unsigned poison;
    __device__ __forceinline__ void fused(f32x4 (&acc)[2][2][4][2], const Unit& u, int wr, int wc, int fr, int fq, PG8_LAS unsigned char* lds, int wid, int lane) const {
        typedef float f32x2v __attribute__((ext_vector_type(2))); typedef unsigned u32x2v __attribute__((ext_vector_type(2)));
        const PG8_LAS f32x2v* S = (const PG8_LAS f32x2v*)(lds + 8192);
        const int col0 = u.pn * BM + wc * 32 + 4 * fq;
#pragma unroll
        for (int bj = 0; bj < 2; ++bj)
#pragma unroll
            for (int n = 0; n < 2; ++n) { const f32x4 bv = bias ? *(const f32x4*)(bias + col0 + bj * HALF + n * 16) : (f32x4){0.f, 0.f, 0.f, 0.f};
#pragma unroll
                for (int ai = 0; ai < 2; ++ai)
#pragma unroll
                    for (int m = 0; m < 4; ++m) acc[ai][bj][m][n] += bv; }
        bool bad = st1.run(acc, u, wr, wc, fr, fq, lds, wid, lane) || poison != 0u;
        const float qnan = __builtin_nanf("");
#pragma unroll
        for (int ai = 0; ai < 2; ++ai)
#pragma unroll
            for (int m = 0; m < 4; ++m) { const int r = ai * HALF + wr * 64 + m * 16 + fr; const f32x2v sr = S[r]; const size_t off = (size_t)(u.pm * BM + r) * ldc + col0;
#pragma unroll
                for (int bj = 0; bj < 2; ++bj)
#pragma unroll
                    for (int n = 0; n < 2; ++n) { const f32x4 bs = *(const f32x4*)(base + off + bj * HALF + n * 16); acc[ai][bj][m][n] = bs + (acc[ai][bj][m][n] - sr.x) * sr.y; }
                asm volatile("" : "+v"(acc[ai][0][m][0]), "+v"(acc[ai][0][m][1]), "+v"(acc[ai][1][m][0]), "+v"(acc[ai][1][m][1]));
                if (m & 1) asm volatile("" ::: "memory"); }
        const bool bad1 = bad;
        bad = st2.run(acc, u, wr, wc, fr, fq, lds, wid, lane) || bad;
#pragma unroll
        for (int ai = 0; ai < 2; ++ai)
#pragma unroll
            for (int m = 0; m < 4; ++m) { const int r = ai * HALF + wr * 64 + m * 16 + fr; const f32x2v sr = S[r]; const size_t off = (size_t)(u.pm * BM + r) * ldc + col0;
#pragma unroll
                for (int bj = 0; bj < 2; ++bj)
#pragma unroll
                    for (int n = 0; n < 2; ++n) { const f32x4 x1 = acc[ai][bj][m][n]; *(f32x4*)(out + off + bj * HALF + n * 16) = bad1 ? (f32x4){qnan, qnan, qnan, qnan} : x1;
                        const f32x4 o = (x1 - sr.x) * sr.y; u32x2v w; w.x = cvt_pk_bf16(o[0], o[1]); w.y = cvt_pk_bf16(o[2], o[3]);
                        if (bad) { w.x = 0x7fc07fc0u; w.y = 0x7fc07fc0u; } *(u32x2v*)(xn + off + bj * HALF + n * 16) = w; }
                asm volatile("" ::: "memory"); }
    }
};

template <class Epi, class Sched, bool ALIGN_EPI = false, bool SP2 = false>
__device__ __forceinline__ void gemm_phase(PG8_LAS unsigned char* lds, const Gemm g, const Sched& S, const Epi& E) {
    int tid_ = threadIdx.x; asm volatile("" : "+v"(tid_));
    const int tid = tid_, wid = __builtin_amdgcn_readfirstlane(tid >> 6), lane = tid & 63, wr = wid >> 2, wc = wid & 3, fr = lane & 15, fq = lane >> 4;
    const int K = g.K, nt = K / BK;
    unsigned voffA[2], voffB[2];
#pragma unroll
    for (int i = 0; i < 2; ++i) { int R, C; stage_rc(tid * 16 + i * 8192, R, C); const int Rb = Epi::PERM ? ((R & ~31) + perm32(R & 31)) : R;
        voffA[i] = (unsigned)(R * K + C) * 2u; voffB[i] = (unsigned)(Rb * K + C) * 2u; }
    const size_t kstep = (size_t)(BK * 2);
    const size_t hstep = (size_t)HALF * K * 2;
    const size_t tstep = 2 * hstep;
    const unsigned ldsw = (unsigned)wid * 1024u;
    const int aoff = lds_byte(wr * 64 + fr, fq * 8), boff = lds_byte(wc * 32 + fr, fq * 8);
#define PG8_SA(b, h) (((b) * 2 + (h)) * HTB)
#define PG8_SB(b, h) ((4 + (b) * 2 + (h)) * HTB)
#define PG8_STAGE(bufoff, gbase, voff) do { _Pragma("unroll") for (int _i = 0; _i < 2; ++_i) \
        __builtin_amdgcn_global_load_lds((const unsigned*)((const char*)(gbase) + (voff)[_i]), (PG8_LAS unsigned*)(lds + (bufoff) + ldsw + _i * 8192), 16, 0, 0); } while (0)
#define PG8_LDA(dst, b, h) do { _Pragma("unroll") for (int m = 0; m < 4; ++m) _Pragma("unroll") for (int k = 0; k < 2; ++k) dst[m][k] = *(const PG8_LAS bf16x8*)(lds + PG8_SA(b, h) + aoff + m * 2048 + k * 1024); } while (0)
#define PG8_LDB(dst, b, h) do { _Pragma("unroll") for (int n = 0; n < 2; ++n) _Pragma("unroll") for (int k = 0; k < 2; ++k) dst[n][k] = *(const PG8_LAS bf16x8*)(lds + PG8_SB(b, h) + boff + n * 2048 + k * 1024); } while (0)
#define PG8_MMA(ai, bj, At, Bt) do { __builtin_amdgcn_s_setprio(1); _Pragma("unroll") for (int m = 0; m < 4; ++m) _Pragma("unroll") for (int n = 0; n < 2; ++n) _Pragma("unroll") for (int k = 0; k < 2; ++k) \
        acc[ai][bj][m][n] = __builtin_amdgcn_mfma_f32_16x16x32_bf16(Bt[n][k], At[m][k], acc[ai][bj][m][n], 0, 0, 0); __builtin_amdgcn_s_setprio(0); } while (0)
#define PG8_WAIT_V(n) asm volatile("s_waitcnt vmcnt(" #n ")" ::: "memory")
#define PG8_WAIT_L(n) asm volatile("s_waitcnt lgkmcnt(" #n ")" ::: "memory")
#define PG8_BAR __builtin_amdgcn_s_barrier()
#define PG8_SCHED __builtin_amdgcn_sched_barrier(0)
    Unit cur, nxt; int ui = 0;
    if (!S.next(0, cur)) return;
    f32x4 acc[2][2][4][2];
#pragma unroll
    for (int a = 0; a < 2; ++a)
#pragma unroll
        for (int b = 0; b < 2; ++b)
#pragma unroll
            for (int m = 0; m < 4; ++m)
#pragma unroll
                for (int n = 0; n < 2; ++n) acc[a][b][m][n] = (f32x4){0.f, 0.f, 0.f, 0.f};
    bf16x8 At[4][2], B0[2][2], B1[2][2];
    const char* cA = (const char*)g.A + (size_t)cur.pm * tstep; const char* cB = (const char*)g.Bt + (size_t)cur.pn * tstep;
    S.a_ready(cur);
    if constexpr (SP2) {
        PG8_STAGE(PG8_SB(0, 0), cB, voffB); PG8_STAGE(PG8_SB(0, 1), cB + hstep, voffB); PG8_STAGE(PG8_SA(0, 0), cA, voffA); PG8_STAGE(PG8_SA(0, 1), cA + hstep, voffA);
        if (wr == 1) PG8_BAR;
        PG8_WAIT_V(2); PG8_BAR;
        PG8_STAGE(PG8_SB(1, 0), cB + kstep, voffB); PG8_STAGE(PG8_SA(1, 0), cA + kstep, voffA); PG8_STAGE(PG8_SB(1, 1), cB + hstep + kstep, voffB);
        PG8_WAIT_V(6); PG8_BAR;
    } else {
        PG8_STAGE(PG8_SB(0, 0), cB, voffB); PG8_STAGE(PG8_SA(0, 0), cA, voffA); PG8_STAGE(PG8_SB(0, 1), cB + hstep, voffB); PG8_STAGE(PG8_SA(0, 1), cA + hstep, voffA);
        if (wr == 1) PG8_BAR;
        PG8_WAIT_V(4); PG8_BAR;
        PG8_STAGE(PG8_SB(1, 0), cB + kstep, voffB); PG8_STAGE(PG8_SA(1, 0), cA + kstep, voffA); PG8_STAGE(PG8_SB(1, 1), cB + hstep + kstep, voffB);
        PG8_WAIT_V(6); PG8_BAR;
    }
    for (;;) {
        const bool has_next = S.next(ui + 1, nxt);
        const char* nA = has_next ? (const char*)g.A + (size_t)nxt.pm * tstep : cA; const char* nB = has_next ? (const char*)g.Bt + (size_t)nxt.pn * tstep : cB;
        for (int t = 0; t < nt; t += 2) {
            const bool last = (t == nt - 2);
            const char* a1 = cA + (size_t)(t + 1) * kstep;
            const char* a2 = last ? nA : cA + (size_t)(t + 2) * kstep; const char* b2 = last ? nB : cB + (size_t)(t + 2) * kstep;
            const char* a3 = a2 + kstep; const char* b3 = b2 + kstep;
            if (last && has_next) S.a_ready(nxt);
            if constexpr (SP2) {
            PG8_LDB(B0, 0, 0); PG8_LDB(B1, 0, 1); PG8_SCHED; PG8_LDA(At, 0, 0); PG8_STAGE(PG8_SA(1, 1), a1 + hstep, voffA);
            PG8_WAIT_V(8); PG8_WAIT_L(0); PG8_BAR; PG8_MMA(0, 0, At, B0); PG8_MMA(0, 1, At, B1); PG8_BAR; PG8_SCHED;
            PG8_LDA(At, 0, 1); PG8_STAGE(PG8_SB(0, 0), b2, voffB); PG8_STAGE(PG8_SB(0, 1), b2 + hstep, voffB); PG8_STAGE(PG8_SA(0, 0), a2, voffA);
            PG8_WAIT_V(8); PG8_WAIT_L(0); PG8_BAR; PG8_MMA(1, 0, At, B0); PG8_MMA(1, 1, At, B1); PG8_BAR; PG8_SCHED;
            PG8_LDB(B0, 1, 0); PG8_LDB(B1, 1, 1); PG8_SCHED; PG8_LDA(At, 1, 0); PG8_STAGE(PG8_SA(0, 1), a2 + hstep, voffA);
            PG8_WAIT_V(8); PG8_WAIT_L(0); PG8_BAR; PG8_MMA(0, 0, At, B0); PG8_MMA(0, 1, At, B1); PG8_BAR; PG8_SCHED;
            PG8_LDA(At, 1, 1); PG8_STAGE(PG8_SB(1, 0), b3, voffB); PG8_STAGE(PG8_SB(1, 1), b3 + hstep, voffB); PG8_STAGE(PG8_SA(1, 0), a3, voffA);
            PG8_WAIT_V(8); PG8_WAIT_L(0); PG8_BAR; PG8_MMA(1, 0, At, B0); PG8_MMA(1, 1, At, B1); PG8_BAR; PG8_SCHED;
            } else {
            PG8_LDB(B0, 0, 0); PG8_SCHED; PG8_LDA(At, 0, 0); PG8_STAGE(PG8_SA(1, 1), a1 + hstep, voffA);
            PG8_WAIT_L(8); PG8_BAR; PG8_WAIT_L(0); PG8_MMA(0, 0, At, B0); PG8_BAR; PG8_SCHED;
            PG8_LDB(B1, 0, 1); PG8_STAGE(PG8_SB(0, 0), b2, voffB);
            PG8_BAR; PG8_WAIT_L(0); PG8_MMA(0, 1, At, B1); PG8_BAR;
            PG8_LDA(At, 0, 1); PG8_STAGE(PG8_SA(0, 0), a2, voffA);
            PG8_BAR; PG8_WAIT_L(0); PG8_MMA(1, 0, At, B0); PG8_BAR; PG8_SCHED;
            PG8_STAGE(PG8_SB(0, 1), b2 + hstep, voffB);
            PG8_WAIT_V(6); PG8_BAR; PG8_MMA(1, 1, At, B1); PG8_BAR;
            PG8_LDB(B0, 1, 0); PG8_SCHED; PG8_LDA(At, 1, 0); PG8_STAGE(PG8_SA(0, 1), a2 + hstep, voffA);
            PG8_WAIT_L(8); PG8_BAR; PG8_WAIT_L(0); PG8_MMA(0, 0, At, B0); PG8_BAR; PG8_SCHED;
            PG8_LDB(B1, 1, 1); PG8_STAGE(PG8_SB(1, 0), b3, voffB);
            PG8_BAR; PG8_WAIT_L(0); PG8_MMA(0, 1, At, B1); PG8_BAR;
            PG8_LDA(At, 1, 1); PG8_STAGE(PG8_SA(1, 0), a3, voffA);
            PG8_BAR; PG8_WAIT_L(0); PG8_MMA(1, 0, At, B0); PG8_BAR; PG8_SCHED;
            PG8_STAGE(PG8_SB(1, 1), b3 + hstep, voffB);
            PG8_WAIT_V(6); PG8_BAR; PG8_MMA(1, 1, At, B1); PG8_BAR;
            }
        }
        if constexpr (ALIGN_EPI) { if (wr == 0) PG8_BAR; }
        if constexpr (!Epi::AFTER_DRAIN) { E(acc, cur, wr, wc, fr, fq); S.done(cur); }
        if (!has_next) break;
#pragma unroll
        for (int a = 0; a < 2; ++a)
#pragma unroll
            for (int b = 0; b < 2; ++b)
#pragma unroll
                for (int m = 0; m < 4; ++m)
#pragma unroll
                    for (int n = 0; n < 2; ++n) acc[a][b][m][n] = (f32x4){0.f, 0.f, 0.f, 0.f};
        cur = nxt; cA = nA; cB = nB; ++ui;
        if constexpr (ALIGN_EPI) { if (wr == 1) PG8_BAR; }
    }
    PG8_WAIT_V(0);
    if constexpr (!ALIGN_EPI) { if (wr == 0) PG8_BAR; }
    PG8_BAR;
    if constexpr (Epi::AFTER_DRAIN) { E.fused(acc, cur, wr, wc, fr, fq, lds, wid, lane); S.done(cur); }
#undef PG8_SA
#undef PG8_SB
#undef PG8_STAGE
#undef PG8_LDA
#undef PG8_LDB
#undef PG8_MMA
#undef PG8_WAIT_V
#undef PG8_WAIT_L
#undef PG8_BAR
#undef PG8_SCHED
}
}
namespace pg8 {
__device__ __forceinline__ f32x4 shflx4(const f32x4 v, int m) { f32x4 r; r[0] = __shfl_xor(v[0], m); r[1] = __shfl_xor(v[1], m); r[2] = __shfl_xor(v[2], m); r[3] = __shfl_xor(v[3], m); return r; }
__device__ __forceinline__ u32x4 pack8(const f32x4 a, const f32x4 b) { u32x4 w; w.x = cvt_pk_bf16(a[0], a[1]); w.y = cvt_pk_bf16(a[2], a[3]); w.z = cvt_pk_bf16(b[0], b[1]); w.w = cvt_pk_bf16(b[2], b[3]); return w; }
struct EpiProj {
    static constexpr bool PERM = true, AFTER_DRAIN = false;
    bf16_t *Qb, *Kb, *Vb, *AGb, *HQb, *HIb, *HGb; float* LF;
    float *oKp, *oKs, *oVp, *oVs;
    const float *qg, *kg, *lbl, *rope;
    __device__ __forceinline__ void operator()(const f32x4 (&acc)[2][2][4][2], const Unit& u, int wr, int wc, int fr, int fq) const {
        const int seg = u.pn >> 1, half = u.pn & 1;
        const int row0 = u.pm * BM + wr * 64 + fr;
        const bool samp = (u.pm * BM) >= ::MP;
        if (seg < 2) {
            const float* g = seg ? kg : qg;
            f32x4 gv[2][2];
#pragma unroll
            for (int bj = 0; bj < 2; ++bj)
#pragma unroll
                for (int n = 0; n < 2; ++n) gv[bj][n] = *(const f32x4*)(g + 32 * bj + 8 * fq + 4 * n);
            const int gcol = (half * 4 + wc) * 64 + 8 * fq;
            const float sgn = (fq == 0) ? -1.f : 1.f;
#pragma unroll
            for (int ai = 0; ai < 2; ++ai) {
                f32x4 rc[4][4];
                if (fq < 2) {
#pragma unroll
                    for (int m = 0; m < 4; ++m) { const int row = row0 + ai * HALF + m * 16; const int pos = samp ? 2048 + ((row - ::MP) & 7) : (row & 8191); const float* rp = rope + (size_t)pos * 16;
#pragma unroll
                        for (int k4 = 0; k4 < 4; ++k4) rc[m][k4] = *(const f32x4*)(rp + 4 * k4); }
                }
                asm volatile("" ::: "memory");
#pragma unroll
                for (int m = 0; m < 4; ++m) {
                    const int row = row0 + ai * HALF + m * 16;
                    f32x4 x[2][2]; float ss = 0.f;
#pragma unroll
                    for (int bj = 0; bj < 2; ++bj)
#pragma unroll
                        for (int n = 0; n < 2; ++n) { x[bj][n] = acc[ai][bj][m][n]; const f32x4 t = x[bj][n] * x[bj][n]; ss += (t[0] + t[1]) + (t[2] + t[3]); }
                    ss += __shfl_xor(ss, 16); ss += __shfl_xor(ss, 32);
                    const float rs = __builtin_amdgcn_rsqf(ss * (1.f / 64.f) + 1e-6f);
#pragma unroll
                    for (int bj = 0; bj < 2; ++bj)
#pragma unroll
                        for (int n = 0; n < 2; ++n) x[bj][n] = x[bj][n] * rs * gv[bj][n];
                    const f32x4 o0 = shflx4(x[0][0], 16), o1 = shflx4(x[0][1], 16);
                    if (fq < 2) { x[0][0] = x[0][0] * rc[m][0] + (o0 * rc[m][2]) * sgn; x[0][1] = x[0][1] * rc[m][1] + (o1 * rc[m][3]) * sgn; }
                    if (seg == 0) {
#pragma unroll
                        for (int bj = 0; bj < 2; ++bj) *(u32x4*)(Qb + (size_t)row * 512 + gcol + 32 * bj) = pack8(x[bj][0] * ::C2, x[bj][1] * ::C2);
                    } else {
                        float* ok = samp ? oKs + (size_t)(row - ::MP) * 512 : oKp + (size_t)row * 512;
#pragma unroll
                        for (int bj = 0; bj < 2; ++bj) { *(u32x4*)(Kb + (size_t)row * 512 + gcol + 32 * bj) = pack8(x[bj][0], x[bj][1]);
                            *(f32x4*)(ok + gcol + 32 * bj) = x[bj][0]; *(f32x4*)(ok + gcol + 32 * bj + 4) = x[bj][1]; }
                    }
                }
            }
            return;
        }
        const int col0 = half * 256 + wc * 32 + 8 * fq;
        f32x4 lbv[2][2];
        if (seg == 5) {
#pragma unroll
            for (int bj = 0; bj < 2; ++bj)
#pragma unroll
                for (int n = 0; n < 2; ++n) { const f32x4 l0 = *(const f32x4*)(lbl + col0 + bj * HALF + 4 * n), l1 = *(const f32x4*)(lbl + 512 + col0 + bj * HALF + 4 * n);
#pragma unroll
                    for (int e = 0; e < 4; ++e) lbv[bj][n][e] = ::fast_sigmoid(l0[e] - l1[e]); }
        }
        bf16_t* dst = seg == 2 ? Vb : seg == 3 ? AGb : seg == 4 ? HQb : seg == 6 ? HIb : HGb;
#pragma unroll
        for (int ai = 0; ai < 2; ++ai)
#pragma unroll
            for (int m = 0; m < 4; ++m) {
                const int row = row0 + ai * HALF + m * 16;
#pragma unroll
                for (int bj = 0; bj < 2; ++bj) {
                    f32x4 v0 = acc[ai][bj][m][0], v1 = acc[ai][bj][m][1];
                    const int c = col0 + bj * HALF;
                    if (seg == 5) {
#pragma unroll
                        for (int e = 0; e < 4; ++e) { const float la = lbv[bj][0][e], lb2 = lbv[bj][1][e];
                            v0[e] = __builtin_amdgcn_logf(la + (1.f - la) * ::fast_sigmoid(v0[e])) * ::LN2; v1[e] = __builtin_amdgcn_logf(lb2 + (1.f - lb2) * ::fast_sigmoid(v1[e])) * ::LN2; }
                        *(f32x4*)(LF + (size_t)row * 512 + c) = v0; *(f32x4*)(LF + (size_t)row * 512 + c + 4) = v1;
                    } else {
                        if (seg == 3 || seg == 4 || seg == 7) {
#pragma unroll
                            for (int e = 0; e < 4; ++e) { v0[e] = ::fast_silu(v0[e]); v1[e] = ::fast_silu(v1[e]); }
                        }
                        *(u32x4*)(dst + (size_t)row * 512 + c) = pack8(v0, v1);
                        if (seg == 2) { float* ov = samp ? oVs + (size_t)(row - ::MP) * 512 : oVp + (size_t)row * 512; *(f32x4*)(ov + c) = v0; *(f32x4*)(ov + c + 4) = v1; }
                    }
                }
            }
    }
};
struct EpiOut {
    static constexpr bool PERM = false, AFTER_DRAIN = false;
    const float *xp, *xs; float* out;
    __device__ __forceinline__ void operator()(const f32x4 (&acc)[2][2][4][2], const Unit& u, int wr, int wc, int fr, int fq) const {
        const int row0 = u.pm * BM + wr * 64 + fr, col0 = u.pn * BM + wc * 32 + 4 * fq;
        const bool samp = (u.pm * BM) >= ::MP;
        const float* xbase = samp ? xs + (size_t)(row0 - ::MP) * 1024 : xp + (size_t)row0 * 1024; float* obase = out + (size_t)row0 * 1024;
#pragma unroll
        for (int ai = 0; ai < 2; ++ai) {
            f32x4 xv[4][2][2];
#pragma unroll
            for (int m = 0; m < 4; ++m)
#pragma unroll
                for (int bj = 0; bj < 2; ++bj)
#pragma unroll
                    for (int n = 0; n < 2; ++n) xv[m][bj][n] = *(const f32x4*)(xbase + (size_t)(ai * HALF + m * 16) * 1024 + col0 + bj * HALF + n * 16);
            asm volatile("" ::: "memory");
#pragma unroll
            for (int m = 0; m < 4; ++m)
#pragma unroll
                for (int bj = 0; bj < 2; ++bj)
#pragma unroll
                    for (int n = 0; n < 2; ++n) *(f32x4*)(obase + (size_t)(ai * HALF + m * 16) * 1024 + col0 + bj * HALF + n * 16) = xv[m][bj][n] + acc[ai][bj][m][n];
            asm volatile("" ::: "memory");
        }
    }
};
struct OneUnit {
    int pm, pn;
    __device__ __forceinline__ bool next(int i, Unit& u) const { if (i != 0) return false; u.pm = pm; u.pn = pn; return true; }
    __device__ __forceinline__ void a_ready(const Unit&) const {}
    __device__ __forceinline__ void done(const Unit&) const {}
};
struct P1Order {
    int G, c, i0, n;
    __device__ __forceinline__ bool next(int i, Unit& u) const {
        if (i >= n) return false;
        const int L = (i0 + i) * G + c; if (L >= 1088) return false;
        int wgid = (L & 7) * 136 + (L >> 3);
        if (G == 256) { if (wgid >= 1024 && wgid < 1032) wgid += 56; else if (wgid >= 1080) wgid -= 56; }
        const int gid = wgid >> 7, rem = wgid & 127;
        if (gid < 8) { u.pm = gid * 8 + (rem & 7); u.pn = rem >> 3; } else { u.pm = 64 + (rem & 3); u.pn = rem >> 2; }
        return true;
    }
    __device__ __forceinline__ void a_ready(const Unit&) const {}
    __device__ __forceinline__ void done(const Unit&) const {}
};
}
#include <hip/hip_bf16.h>
#include <cmath>
namespace attn128 {
using bf16=__hip_bfloat16;
using bf16x8=__attribute__((ext_vector_type(8)))short;
using s16x4=__attribute__((ext_vector_type(4)))short;
using f32x16=__attribute__((ext_vector_type(16)))float;
using u32x4=__attribute__((ext_vector_type(4)))unsigned;
constexpr int BATCH=2,NHEAD=8,SEQ=8192,D=64,DM=1024;
constexpr int NW=8,QBLK=32,QB=QBLK*NW,KVBLK=64,NQB=SEQ/QB;
constexpr int ATTN_PITCH=DM, ATTN_UNIT_ROWS=QB, QKP=512;
__device__ __forceinline__ int crow(int r,int hi){return (r&3)+8*(r>>2)+4*hi;}
#define SBAR() __builtin_amdgcn_sched_barrier(0)
__device__ __forceinline__ void cmask(f32x16&p0,f32x16&p1,int jb,int qrel,int hi){
  const float NEG=-INFINITY; int kb=64*jb+4*hi;
  #pragma unroll
  for(int r=0;r<16;++r){int kv=kb+(r&3)+8*(r>>2); if(kv>qrel)p0[r]=NEG; if(kv+32>qrel)p1[r]=NEG;}
}

constexpr int NSLOT=3, SLOTB=8192;
constexpr int LDS_K=0, LDS_V=NSLOT*SLOTB, LDS_WS=3*NSLOT*SLOTB, LDS_OST=LDS_WS+NW*64*4, LDS_BYTES=LDS_OST+NW*4096;
constexpr float C2=0.125f*1.4426950408889634f;
__device__ __forceinline__ void glds16(const void*gsrc,unsigned lds_dst){unsigned keep;
  asm volatile("s_mov_b32 %0, m0\n\ts_mov_b32 m0, %2\n\ts_nop 0\n\tglobal_load_lds_dwordx4 %1, off\n\ts_mov_b32 m0, %0":"=&s"(keep):"v"(gsrc),"s"(lds_dst):"memory");}
__device__ __forceinline__ float max3f(float a,float b,float c){float r;asm("v_max3_f32 %0, %1, %2, %3":"=v"(r):"v"(a),"v"(b),"v"(c));return r;}
__device__ __forceinline__ float max2f(float a,float b){float r;asm("v_max_f32_e32 %0, %1, %2":"=v"(r):"v"(a),"v"(b));return r;}
__device__ __forceinline__ float fadd_s(float a,float b){float r;asm("v_add_f32_e32 %0, %1, %2":"=v"(r):"v"(a),"v"(b));return r;}
__device__ __forceinline__ float fsub_s(float a,float b){float r;asm("v_sub_f32_e32 %0, %1, %2":"=v"(r):"v"(a),"v"(b));return r;}
typedef float f32x2_t __attribute__((ext_vector_type(2))); typedef __bf16 bf16x2_t __attribute__((ext_vector_type(2)));
__device__ __forceinline__ unsigned cvtpk_s(float lo,float hi){f32x2_t v={lo,hi};bf16x2_t b=__builtin_convertvector(v,bf16x2_t);return __builtin_bit_cast(unsigned,b);}
#define WAIT_BAR(N) asm volatile("s_waitcnt vmcnt(" #N ") lgkmcnt(0)\n\ts_barrier":::"memory")

__device__ __forceinline__ void qkt(f32x16&p0,f32x16&p1,const char*Kslot,const bf16x8*qr,const f32x16&negm,int r32,int hi){
  const char*kb=Kslot+hi*1024+r32*16;
  #pragma unroll
  for(int d0=0;d0<4;++d0){
    const bf16x8 b0=*reinterpret_cast<const bf16x8*>(kb+d0*2048);
    const bf16x8 b1=*reinterpret_cast<const bf16x8*>(kb+d0*2048+512);
    if(d0==0){p0=__builtin_amdgcn_mfma_f32_32x32x16_bf16(b0,qr[0],negm,0,0,0);p1=__builtin_amdgcn_mfma_f32_32x32x16_bf16(b1,qr[0],negm,0,0,0);}
    else{p0=__builtin_amdgcn_mfma_f32_32x32x16_bf16(b0,qr[d0],p0,0,0,0);p1=__builtin_amdgcn_mfma_f32_32x32x16_bf16(b1,qr[d0],p1,0,0,0);}}
}
typedef __attribute__((address_space(3))) const char* lds_cptr;
typedef short v4i16_t __attribute__((ext_vector_type(4)));
__device__ __forceinline__ void kload8(bf16x8*kf,lds_cptr kp){
  kf[0]=*(const __attribute__((address_space(3))) bf16x8*)(kp);      kf[1]=*(const __attribute__((address_space(3))) bf16x8*)(kp+512);
  kf[2]=*(const __attribute__((address_space(3))) bf16x8*)(kp+2048); kf[3]=*(const __attribute__((address_space(3))) bf16x8*)(kp+2560);
  kf[4]=*(const __attribute__((address_space(3))) bf16x8*)(kp+4096); kf[5]=*(const __attribute__((address_space(3))) bf16x8*)(kp+4608);
  kf[6]=*(const __attribute__((address_space(3))) bf16x8*)(kp+6144); kf[7]=*(const __attribute__((address_space(3))) bf16x8*)(kp+6656);
}
__device__ __forceinline__ void kload2(bf16x8*kf,lds_cptr kp,int j){ kf[2*j]=*(const __attribute__((address_space(3))) bf16x8*)(kp+j*2048); kf[2*j+1]=*(const __attribute__((address_space(3))) bf16x8*)(kp+j*2048+512); }
__device__ __forceinline__ s16x4 vtr(lds_cptr p){ return __builtin_bit_cast(s16x4,__builtin_amdgcn_ds_read_tr16_b64_v4i16((__attribute__((address_space(3))) v4i16_t*)p)); }
__device__ __forceinline__ float rowmax(const f32x16&p0,const f32x16&p1){
  float a=max3f(p0[0],p0[1],p1[0]),b=max3f(p0[2],p0[3],p1[1]);a=max3f(a,p1[2],p1[3]);
  #pragma unroll
  for(int r=4;r<16;r+=4){a=max3f(a,p0[r],p0[r+1]);b=max3f(b,p0[r+2],p0[r+3]);a=max3f(a,p1[r],p1[r+1]);b=max3f(b,p1[r+2],p1[r+3]);}
  const float m=max2f(a,b);
  auto rr=__builtin_amdgcn_permlane32_swap(__float_as_uint(m),__float_as_uint(m),false,false);
  return max2f(__uint_as_float(rr[0]),__uint_as_float(rr[1]));
}
__device__ __forceinline__ void pv(f32x16*o,int vb,bf16x8 pa0,bf16x8 pa1,bf16x8 pa2,bf16x8 pa3){
  #pragma unroll
  for(int d0=0;d0<2;++d0){s16x4 lo[4],hi[4];
    #pragma unroll
    for(int ks=0;ks<4;++ks){
      asm volatile("ds_read_b64_tr_b16 %0,%1 offset:%c2":"=&v"(lo[ks]):"v"(vb),"i"(d0*4096+ks*1024):"memory");
      asm volatile("ds_read_b64_tr_b16 %0,%1 offset:%c2":"=&v"(hi[ks]):"v"(vb),"i"(d0*4096+ks*1024+512):"memory");}
    asm volatile("s_waitcnt lgkmcnt(0)":::"memory");SBAR();
    #define PK(k) (bf16x8){lo[k][0],lo[k][1],lo[k][2],lo[k][3],hi[k][0],hi[k][1],hi[k][2],hi[k][3]}
    o[d0]=__builtin_amdgcn_mfma_f32_32x32x16_bf16(pa0,PK(0),o[d0],0,0,0);
    o[d0]=__builtin_amdgcn_mfma_f32_32x32x16_bf16(pa1,PK(1),o[d0],0,0,0);
    o[d0]=__builtin_amdgcn_mfma_f32_32x32x16_bf16(pa2,PK(2),o[d0],0,0,0);
    o[d0]=__builtin_amdgcn_mfma_f32_32x32x16_bf16(pa3,PK(3),o[d0],0,0,0);
    #undef PK
  }
}

#ifndef ATTN_STORE16
#define ATTN_STORE16(p,v) (*(u32x4*)(p)=(v))
#endif
template<int THRL> __device__ __forceinline__ void attn_unit(int b,int h,int qb,const bf16*Q,const bf16*__restrict__ K,const bf16*__restrict__ V,bf16*O,char*shm){
  int tid_=threadIdx.x; asm volatile("":"+v"(tid_));
  const int tid=tid_,lane=tid&63,r32=lane&31,hi=lane>>5; const int wid=__builtin_amdgcn_readfirstlane(tid>>6);
  const long rowbase=(long)b*SEQ; const int q0=qb*QB;
  const int hq_=h;
  const bf16*Qw=Q+(rowbase+q0+wid*QBLK)*QKP+hq_*D;
  const bf16*Kh=K+rowbase*QKP+hq_*D,*Vh=V+rowbase*QKP+(h>>1)*128;
  const unsigned lds0=(unsigned)(uintptr_t)shm;
  float*wsf=(float*)(shm+LDS_WS)+wid*64;
  const bf16*ksrc=Kh+(long)lane*QKP+wid*8;
  const bf16*vsrc=Vh+(long)(16*(wid&3)+(lane>>2))*QKP+(wid>>2)*32+(lane&3)*8;
  const unsigned kdst=lds0+LDS_K+wid*1024, vdst=lds0+LDS_V+wid*1024;
  #define DMA_K(t,slot) glds16(ksrc+(long)(t)*KVBLK*QKP,(unsigned)__builtin_amdgcn_readfirstlane(kdst+(slot)))
  #define DMA_V(t,slot) do{ glds16(vsrc+(long)(t)*KVBLK*QKP,(unsigned)__builtin_amdgcn_readfirstlane(vdst+2*(slot))); glds16(vsrc+(long)(t)*KVBLK*QKP+64,(unsigned)__builtin_amdgcn_readfirstlane(vdst+2*(slot)+SLOTB)); }while(0)
  const int vb0=(int)(lds0+LDS_V)+((lane>>4)&1)*32+(lane&3)*8+(4*hi+((lane&15)>>2))*64;
  const char*Kbase=shm+LDS_K; bf16x8 kf[8];
  const lds_cptr shm3=(lds_cptr)shm; const lds_cptr kp0=shm3+LDS_K+hi*1024+r32*16; const lds_cptr vp0=shm3+LDS_V+((lane>>4)&1)*32+(lane&3)*8+(4*hi+((lane&15)>>2))*64;
  const int NT=(q0+QB)/KVBLK;
  DMA_K(0,0);DMA_V(0,0);DMA_K(1,SLOTB);
  bf16x8 qr[4];
  #pragma unroll
  for(int d0=0;d0<4;++d0)qr[d0]=*reinterpret_cast<const bf16x8*>(&Qw[(long)r32*QKP+d0*16+hi*8]);
  float mhat=0.f,l_reg=0.f;f32x16 o[4];{float z_=0.f;asm volatile("":"+v"(z_));
  _Pragma("unroll") for(int d_=0;d_<4;++d_) _Pragma("unroll") for(int r=0;r<16;++r)o[d_][r]=z_;}
  f32x16 negm; {float z_=0.f;asm volatile("":"+v"(z_)); _Pragma("unroll") for(int r=0;r<16;++r)negm[r]=z_;}
  const int qrel=wid*QBLK+r32;
  #define CMASK(P0,P1,t) do{int jb_=(t)-(NT-4); if(jb_>=0)cmask(P0,P1,jb_,qrel,hi);}while(0)
  bool resc=false;
  #define START(P0,P1) do{ const float rm=rowmax(P0,P1); resc=false; \
    { const float dl=rm; mhat=fadd_s(mhat,dl); \
      _Pragma("unroll") for(int r=0;r<16;++r){P0[r]=fsub_s(P0[r],dl);P1[r]=fsub_s(P1[r],dl);} \
      _Pragma("unroll") for(int r=0;r<16;++r)negm[r]=-mhat; asm volatile("":"+v"(negm)); } \
    _Pragma("unroll") for(int r=0;r<16;++r)P0[r]=__builtin_amdgcn_exp2f(P0[r]); }while(0)
  #define RESC() do{ if(resc){ asm volatile("s_waitcnt lgkmcnt(0)":::"memory"); \
      _Pragma("unroll") for(int d_=0;d_<4;++d_) _Pragma("unroll") for(int r=0;r<16;++r)o[d_][r]*=wsf[crow(r,hi)]; } }while(0)
  f32x16 pA0,pA1,pB0,pB1;
  int sl_prev=0,sl_cur=0,sl_next=SLOTB;
  #define ROT() do{sl_prev=sl_cur;sl_cur=sl_next;sl_next=(sl_next==(NSLOT-1)*SLOTB)?0:sl_next+SLOTB;}while(0)
  DMA_K(2,2*SLOTB);
  WAIT_BAR(3);
  qkt(pA0,pA1,Kbase,qr,negm,r32,hi);asm volatile("s_nop 15\n\ts_nop 7":"+v"(pA0),"+v"(pA1));CMASK(pA0,pA1,0);
  START(pA0,pA1);
  _Pragma("unroll") for(int r=0;r<16;++r)pA1[r]=__builtin_amdgcn_exp2f(pA1[r]);
  WAIT_BAR(0);
  DMA_K(3,0);DMA_V(1,SLOTB);
  ROT();
  kload8(kf,kp0+sl_cur);
  WAIT_BAR(3);
  s16x4 vlo[8],vhi[8]; u32x4 pw0,pw1,pw2,pw3;
  #define PKW(P,B) cvtpk_s(P[B],P[B+1])
  #define PAF(k) __builtin_bit_cast(bf16x8,pw##k)
  #define VFR(i) (bf16x8){vlo[i][0],vlo[i][1],vlo[i][2],vlo[i][3],vhi[i][0],vhi[i][1],vhi[i][2],vhi[i][3]}
  #define PIN(x) asm volatile("":"+v"(x))
  #define MX3(a,b,c) __builtin_fmaxf(__builtin_fmaxf((a),(b)),(c))
  #define GAPA(MF,A0,A1,A2,A3,W0,W1,PW) do{ MF; sacc+=A0; sacc+=A1; sacc+=A2; sacc+=A3; PIN(sacc); W0; W1; PIN(PW); SBAR(); }while(0)
  #define EX(v) __builtin_amdgcn_exp2f(v)
  #define GAPB(MF,X,B) do{ MF; X[B]=EX(X[B]); X[B+1]=EX(X[B+1]); X[B+2]=EX(X[B+2]); X[B+3]=EX(X[B+3]); PIN(X); SBAR(); }while(0)
  #define VRD(i) do{ vlo[i]=vtr(vp_+(((i)>>2)*4096+((i)&3)*1024)); vhi[i]=vtr(vp_+(((i)>>2)*4096+((i)&3)*1024+512)); }while(0)
  #define KRD(G,j) do{ if(G){ kload2(kf,kp0+sl_next,j); SBAR(); } }while(0)
  #define STEP(C0,C1,P0,P1,t,GK,GV,GL) do{ SBAR(); \
    const lds_cptr vp_=vp0+2*sl_prev; \
    VRD(0); SBAR(); float sacc=(P0[0]+P0[1]); \
    GAPA(C0=__builtin_amdgcn_mfma_f32_32x32x16_bf16(kf[0],qr[0],negm,0,0,0), P0[2],P0[3],P0[4],P0[5],     pw0[0]=PKW(P0,0), pw0[1]=PKW(P0,2), pw0); \
    VRD(4); SBAR(); GAPA(C1=__builtin_amdgcn_mfma_f32_32x32x16_bf16(kf[1],qr[0],negm,0,0,0), P0[6],P0[7],P0[8],P0[9],     pw0[2]=PKW(P0,4), pw0[3]=PKW(P0,6), pw0); \
    VRD(1); SBAR(); GAPA(C0=__builtin_amdgcn_mfma_f32_32x32x16_bf16(kf[2],qr[1],C0,0,0,0),   P0[10],P0[11],P0[12],P0[13], pw1[0]=PKW(P0,8), pw1[1]=PKW(P0,10), pw1); \
    VRD(5); SBAR(); GAPA(C1=__builtin_amdgcn_mfma_f32_32x32x16_bf16(kf[3],qr[1],C1,0,0,0),   P0[14],P0[15],P1[0],P1[1],   pw1[2]=PKW(P0,12),pw1[3]=PKW(P0,14), pw1); \
    VRD(2); SBAR(); GAPA(C0=__builtin_amdgcn_mfma_f32_32x32x16_bf16(kf[4],qr[2],C0,0,0,0),   P1[2],P1[3],P1[4],P1[5],     pw2[0]=PKW(P1,0), pw2[1]=PKW(P1,2), pw2); \
    VRD(6); SBAR(); GAPA(C1=__builtin_amdgcn_mfma_f32_32x32x16_bf16(kf[5],qr[2],C1,0,0,0),   P1[6],P1[7],P1[8],P1[9],     pw2[2]=PKW(P1,4), pw2[3]=PKW(P1,6), pw2); \
    VRD(3); SBAR(); GAPA(C0=__builtin_amdgcn_mfma_f32_32x32x16_bf16(kf[6],qr[3],C0,0,0,0),   P1[10],P1[11],P1[12],P1[13], pw3[0]=PKW(P1,8), pw3[1]=PKW(P1,10), pw3); \
    VRD(7); SBAR(); GAPA(C1=__builtin_amdgcn_mfma_f32_32x32x16_bf16(kf[7],qr[3],C1,0,0,0),   P1[14],P1[15],0.f,0.f,       pw3[2]=PKW(P1,12),pw3[3]=PKW(P1,14), pw3); \
    l_reg+=sacc; \
    if(GK){DMA_K((t)+3,sl_cur);} if(GV){DMA_V((t)+1,sl_next);} \
    CMASK(C0,C1,t); \
    { float a=MX3(C0[0],C0[1],C1[0]),b=MX3(C0[2],C0[3],C1[1]); a=MX3(a,C1[2],C1[3]); \
      _Pragma("unroll") for(int r=4;r<16;r+=4){a=MX3(a,C0[r],C0[r+1]);b=MX3(b,C0[r+2],C0[r+3]);a=MX3(a,C1[r],C1[r+1]);b=MX3(b,C1[r+2],C1[r+3]);} \
      float rm=__builtin_fmaxf(a,b); { auto rr=__builtin_amdgcn_permlane32_swap(__float_as_uint(rm),__float_as_uint(rm),false,false); rm=__builtin_fmaxf(__uint_as_float(rr[0]),__uint_as_float(rr[1])); } \
      resc=false; \
      if(__builtin_expect(__any(rm>(float)THRL),0)){ const float dl=__builtin_fmaxf(rm,0.f); mhat+=dl; \
        _Pragma("unroll") for(int r=0;r<16;++r){C0[r]-=dl;C1[r]-=dl;} \
        _Pragma("unroll") for(int r=0;r<16;++r)negm[r]=-mhat; asm volatile("":"+v"(negm)); \
        const float f=__builtin_amdgcn_exp2f(-dl); l_reg*=f; if(hi==0)wsf[r32]=f; resc=true; } } \
    SBAR(); \
    GAPB(o[0]=__builtin_amdgcn_mfma_f32_32x32x16_bf16(PAF(0),VFR(0),o[0],0,0,0), C0,0); \
    GAPB(o[1]=__builtin_amdgcn_mfma_f32_32x32x16_bf16(PAF(0),VFR(4),o[1],0,0,0), C0,4); \
    KRD(GL,0); GAPB(o[0]=__builtin_amdgcn_mfma_f32_32x32x16_bf16(PAF(1),VFR(1),o[0],0,0,0), C0,8); \
    KRD(GL,1); GAPB(o[1]=__builtin_amdgcn_mfma_f32_32x32x16_bf16(PAF(1),VFR(5),o[1],0,0,0), C0,12); \
    KRD(GL,2); GAPB(o[0]=__builtin_amdgcn_mfma_f32_32x32x16_bf16(PAF(2),VFR(2),o[0],0,0,0), C1,0); \
    KRD(GL,3); GAPB(o[1]=__builtin_amdgcn_mfma_f32_32x32x16_bf16(PAF(2),VFR(6),o[1],0,0,0), C1,4); \
    GAPB(o[0]=__builtin_amdgcn_mfma_f32_32x32x16_bf16(PAF(3),VFR(3),o[0],0,0,0), C1,8); \
    GAPB(o[1]=__builtin_amdgcn_mfma_f32_32x32x16_bf16(PAF(3),VFR(7),o[1],0,0,0), C1,12); \
    pv(o+2,vb0+2*sl_prev+SLOTB,PAF(0),PAF(1),PAF(2),PAF(3));     \
    }while(0)
  int t=1;
  #undef CMASK
  #define CMASK(P0,P1,t) do{}while(0)
  for(;t+5<NT;t+=2){
    STEP(pB0,pB1,pA0,pA1,t,true,true,true);     WAIT_BAR(3); RESC(); ROT();
    STEP(pA0,pA1,pB0,pB1,t+1,true,true,true);   WAIT_BAR(3); RESC(); ROT();
  }
  #undef CMASK
  #define CMASK(P0,P1,t) do{int jb_=(t)-(NT-4); if(jb_>=0)cmask(P0,P1,jb_,qrel,hi);}while(0)
  #define ENDW(tt) do{ if((tt)+3<NT){WAIT_BAR(3);} else if((tt)+2<NT){WAIT_BAR(2);} else {WAIT_BAR(0);} }while(0)
  for(;t+1<NT;t+=2){
    STEP(pB0,pB1,pA0,pA1,t,(t+3<NT),(t+1<NT),(t+1<NT));       ENDW(t);   RESC(); ROT();
    STEP(pA0,pA1,pB0,pB1,t+1,(t+4<NT),(t+2<NT),(t+2<NT));     ENDW(t+1); RESC(); ROT();
  }
  STEP(pB0,pB1,pA0,pA1,NT-1,false,false,false); RESC();
  { float sacc=pB0[0]+pB0[1]; _Pragma("unroll") for(int r=2;r<16;++r)sacc+=pB0[r]; _Pragma("unroll") for(int r=0;r<16;++r)sacc+=pB1[r]; l_reg+=sacc;
    pw0=(u32x4){PKW(pB0,0),PKW(pB0,2),PKW(pB0,4),PKW(pB0,6)};pw1=(u32x4){PKW(pB0,8),PKW(pB0,10),PKW(pB0,12),PKW(pB0,14)};pw2=(u32x4){PKW(pB1,0),PKW(pB1,2),PKW(pB1,4),PKW(pB1,6)};pw3=(u32x4){PKW(pB1,8),PKW(pB1,10),PKW(pB1,12),PKW(pB1,14)};
    SBAR(); pv(o,vb0+2*sl_cur,PAF(0),PAF(1),PAF(2),PAF(3)); pv(o+2,vb0+2*sl_cur+SLOTB,PAF(0),PAF(1),PAF(2),PAF(3)); }
  #undef PKW
  #undef PAF
  #undef VFR
  #undef PIN
  #undef MX3
  #undef GAPA
  #undef GAPB
  #undef EX
  #undef VRD
  #undef KRD
  #undef STEP
  #undef ENDW
  {auto rr=__builtin_amdgcn_permlane32_swap(__float_as_uint(l_reg),__float_as_uint(l_reg),false,false);l_reg=__uint_as_float(rr[0])+__uint_as_float(rr[1]);}
  if(hi==0)wsf[32+r32]=l_reg;asm volatile("s_waitcnt lgkmcnt(0)":::"memory");
  float rli[16];
  #pragma unroll
  for(int r=0;r<16;++r)rli[r]=__builtin_amdgcn_rcpf(wsf[32+crow(r,hi)]);
  bf16*Ow=O+(rowbase+q0+wid*QBLK)*DM+h*128;
  { bf16*stg=(bf16*)(shm+LDS_OST)+wid*2048;
    #pragma unroll
    for(int hh=0;hh<2;++hh){
    #pragma unroll
    for(int r=0;r<16;++r){const int orow=crow(r,hi);
      #pragma unroll
      for(int d0=0;d0<2;++d0)stg[orow*64+d0*32+r32]=__float2bfloat16(o[2*hh+d0][r]*rli[r]);}
    asm volatile("s_waitcnt lgkmcnt(0)":::"memory");
    #pragma unroll
    for(int i=0;i<4;++i){const int row=i*8+(lane>>3),ch=lane&7; const u32x4 v=*(const u32x4*)(stg+row*64+ch*8); ATTN_STORE16(Ow+(long)row*DM+hh*64+ch*8,v);}
    asm volatile("s_waitcnt lgkmcnt(0)":::"memory"); } }
  asm volatile("s_waitcnt lgkmcnt(0)\n\ts_barrier":::"memory");
  #undef DMA_K
  #undef DMA_V
  #undef CMASK
  #undef START
  #undef RESC
  #undef ROT
}
constexpr int ATTN_LDS_BYTES=LDS_BYTES;
struct AttnTensors { const bf16* Q; const bf16* K; const bf16* V; bf16* O; };
struct AttnUnit { int bh; int qb; };
struct StaticOrder {
  int vcu;
  __device__ __forceinline__ explicit StaticOrder(int grid,int block):vcu((block%8)*(grid/8)+block/8){}
  __device__ __forceinline__ bool next(int i,AttnUnit&u)const{ if(i>=2)return false; const int s=vcu&15; u.bh=vcu>>4; u.qb=(i==0)?s:31-s; return true; }
  __device__ __forceinline__ void a_ready(const AttnUnit&)const{}
  __device__ __forceinline__ void done(const AttnUnit&)const{}
};
template<class Sched,int THRL=8> __device__ __forceinline__ void attn_phase(char*lds,const AttnTensors&T,const Sched&S){
  AttnUnit u;
  for(int i=0;S.next(i,u);++i){ S.a_ready(u); attn_unit<THRL>(u.bh/NHEAD,u.bh%NHEAD,u.qb,T.Q,T.K,T.V,T.O,lds); S.done(u); }
}
#undef SBAR
#undef WAIT_BAR
}
#define GAS __attribute__((address_space(1)))
#define LAS __attribute__((address_space(3)))
typedef unsigned short bf16;
typedef unsigned v4u __attribute__((ext_vector_type(4)));
typedef float f32x4 __attribute__((ext_vector_type(4)));
typedef short bf16x8 __attribute__((ext_vector_type(8)));
typedef GAS unsigned gu32;
typedef GAS unsigned long long gu64;
#define RLX_AGENT __ATOMIC_RELAXED, __HIP_MEMORY_SCOPE_AGENT
#define LDS_WAIT() asm volatile("s_waitcnt lgkmcnt(0)" ::: "memory")
#define VM_WAIT() asm volatile("s_waitcnt vmcnt(0)" ::: "memory")
__device__ __forceinline__ unsigned long long rt() { return __builtin_amdgcn_s_memrealtime(); }
__device__ __forceinline__ unsigned f2bf(float f) { unsigned u = __builtin_bit_cast(unsigned, f); return (u + 0x7fffu + ((u >> 16) & 1u)) >> 16; }
__device__ __forceinline__ unsigned pk2(float lo, float hi) { return f2bf(lo) | (f2bf(hi) << 16); }

#define XB_TMO      128
#define XB_XCNT(j)  (256  + 64 * (j))
#define XB_XSUB(j)  (1280 + 64 * (j))
#define XB_XGEN(j)  (2304 + 64 * (j))
#define XB_TOP      3328
#define XB_TOPGEN   3392
#define XCD_BAR_WORDS 3456
#define XB_SPIN_CAP (1u << 18)

__device__ __forceinline__ unsigned xb_ld(unsigned* p)              { return __hip_atomic_load(p, __ATOMIC_RELAXED, __HIP_MEMORY_SCOPE_AGENT); }
__device__ __forceinline__ unsigned xb_add(unsigned* p, unsigned v) { return __hip_atomic_fetch_add(p, v, __ATOMIC_RELAXED, __HIP_MEMORY_SCOPE_AGENT); }
__device__ __forceinline__ unsigned xb_xcc_id() { return (unsigned)__builtin_amdgcn_s_getreg((3 << 11) | 20) & 0xFu; }
#define XB_SPIN(cond, bar) do { unsigned _sp = 0; while (cond) { __builtin_amdgcn_s_sleep(1); \
    if ((++_sp & 255u) == 0u) { if (xb_ld(&(bar)[XB_TMO])) break; if (_sp > XB_SPIN_CAP) { atomicAdd(&(bar)[XB_TMO], 1u); break; } } } } while (0)

struct XcdBarrier {
    unsigned* bar; unsigned x;
    volatile LAS unsigned* st;
};

__device__ __forceinline__ XcdBarrier xcd_barrier_post(unsigned* bar, volatile LAS unsigned* st) {
    XcdBarrier b; b.bar = bar; b.x = xb_xcc_id(); b.st = st;
    if (threadIdx.x == 0) (void)xb_add(&bar[XB_XCNT(b.x)], 1u);
    return b;
}
__device__ __forceinline__ void xcd_barrier_complete(unsigned* bar, unsigned x, unsigned& nloc, unsigned& nx) {
    const unsigned G = gridDim.x * gridDim.y * gridDim.z;
    unsigned sum, cnt, mine, sp = 0u;
    for (;;) {
        sum = 0u; cnt = 0u; mine = 0u;
#pragma unroll
        for (unsigned j = 0; j < 16; ++j) { const unsigned c = xb_ld(&bar[XB_XCNT(j)]); sum += c; cnt += (c > 0u) ? 1u : 0u; mine = (j == x) ? c : mine; }
        if (sum == G) break;
        __builtin_amdgcn_s_sleep(1);
        if ((++sp & 255u) == 0u) { if (xb_ld(&bar[XB_TMO])) break; if (sp > XB_SPIN_CAP) { atomicAdd(&bar[XB_TMO], 1u); break; } }
    }
    nloc = mine > 0u ? mine : 1u; nx = cnt > 0u ? cnt : 1u;
}

__device__ __forceinline__ void xcd_barrier(const XcdBarrier& b) {
    asm volatile("s_waitcnt vmcnt(0)" ::: "memory");
    __syncthreads();
    if (threadIdx.x == 0) {
        unsigned* bar = b.bar;
        __builtin_amdgcn_s_waitcnt(0);
        unsigned nloc = b.st[0], nx = b.st[1];
        if (nloc == 0u) { xcd_barrier_complete(bar, b.x, nloc, nx); b.st[0] = nloc; b.st[1] = nx; }
        const unsigned old = xb_add(&bar[XB_XSUB(b.x)], 1u);
        const unsigned gen = old / nloc;
        if (old + 1u == (gen + 1u) * nloc) {
            __builtin_amdgcn_fence(__ATOMIC_RELEASE, "agent");
            asm volatile("s_waitcnt vmcnt(0)" ::: "memory");
            const unsigned og = xb_add(&bar[XB_TOP], 1u);
            const unsigned tg = og / nx;
            if (og + 1u == (tg + 1u) * nx) xb_add(&bar[XB_TOPGEN], 1u);
            else XB_SPIN(xb_ld(&bar[XB_TOPGEN]) == tg, bar);
            __builtin_amdgcn_fence(__ATOMIC_ACQUIRE, "agent");
            xb_add(&bar[XB_XGEN(b.x)], 1u);
            asm volatile("s_waitcnt vmcnt(0)" ::: "memory");
        } else {
            XB_SPIN(xb_ld(&bar[XB_XGEN(b.x)]) == gen, bar);
            __builtin_amdgcn_fence(__ATOMIC_ACQUIRE, "agent");
            asm volatile("s_waitcnt vmcnt(0)" ::: "memory");
        }
    }
    __syncthreads();
}
template <bool PERMQK>
__device__ __forceinline__ void p0_transpose_item(const float* W, int K, int N, bf16* WT, LAS float* scr, int item, int lane) {
    const int nblk = N / 32, kb = item / nblk, nb = item % nblk, k0 = 64 * kb, n0 = 32 * nb;
    float wv[32];
#pragma unroll
    for (int i = 0; i < 32; ++i) { const int kk = 2 * i + (lane >> 5); wv[i] = W[(size_t)(k0 + kk) * N + n0 + (lane & 31)]; }
#pragma unroll
    for (int i = 0; i < 32; ++i) { const int kk = 2 * i + (lane >> 5); scr[kk * 33 + (lane & 31)] = wv[i]; }
    LDS_WAIT(); asm volatile("" ::: "memory");
    const int c = lane & 7;
    const int r0 = PERMQK ? win_row_of_col(n0) : n0;
#pragma unroll
    for (int j = 0; j < 4; ++j) { const int n = (lane >> 3) + 8 * j; const LAS float* s = scr + (8 * c) * 33 + n;
        v4u o; o.x = pkbf(s[0 * 33], s[1 * 33]); o.y = pkbf(s[2 * 33], s[3 * 33]); o.z = pkbf(s[4 * 33], s[5 * 33]); o.w = pkbf(s[6 * 33], s[7 * 33]);
        *(GAS v4u*)(WT + (size_t)(r0 + n) * K + k0 + 8 * c) = o; }
    LDS_WAIT(); asm volatile("" ::: "memory");
}
__device__ __forceinline__ void rms_rows4_to_bf16(const float* xp, const float* xs, const float* g, bf16* XN, int m0, int mstride, int lane) {
    f32x4 v[4][4]; bool ok[4];
#pragma unroll
    for (int r = 0; r < 4; ++r) { const int m = m0 + r * mstride; ok[r] = m < MT; const int mm = ok[r] ? m : m0;
        const GAS f32x4* xr = (const GAS f32x4*)(mm < MP ? xp + (size_t)mm * 1024 : xs + (size_t)(mm - MP) * 1024) + lane;
#pragma unroll
        for (int j = 0; j < 4; ++j) v[r][j] = xr[64 * j]; }
    f32x4 gg[4];
#pragma unroll
    for (int j = 0; j < 4; ++j) gg[j] = ((const GAS f32x4*)g + lane)[64 * j];
#pragma unroll
    for (int r = 0; r < 4; ++r) { float s = 0.f;
#pragma unroll
        for (int j = 0; j < 4; ++j) s += (v[r][j].x * v[r][j].x + v[r][j].y * v[r][j].y) + (v[r][j].z * v[r][j].z + v[r][j].w * v[r][j].w);
        const float rstd = __builtin_amdgcn_rsqf(wave_sum(s) * (1.f / 1024.f) + 1e-6f);
        if (ok[r]) { GAS unsigned long long* o8 = (GAS unsigned long long*)(XN + (size_t)(m0 + r * mstride) * 1024) + lane;
#pragma unroll
            for (int j = 0; j < 4; ++j) o8[64 * j] = (unsigned long long)pkbf(v[r][j].x * rstd * gg[j].x, v[r][j].y * rstd * gg[j].y) | ((unsigned long long)pkbf(v[r][j].z * rstd * gg[j].z, v[r][j].w * rstd * gg[j].w) << 32); } }
}
__device__ __forceinline__ void rope_entry(int pos, int i, float* tab) {
    const double rev[8] = {0.15915494309189535, 0.03086376340470123, 0.005985185712713705, 0.001160663641240061, 0.00022507907903927653, 4.364795279280289e-05, 8.464330808241401e-06, 1.6414262627950345e-06};
    double r = rev[0];
#pragma unroll
    for (int k = 1; k < 8; ++k) r = (i == k) ? rev[k] : r;
    double x = (double)pos * r; x -= __builtin_rint(x);
    const float xf = (float)x;
    tab[pos * 16 + i] = __builtin_amdgcn_cosf(xf); tab[pos * 16 + 8 + i] = __builtin_amdgcn_sinf(xf);
}
typedef short s16x4h __attribute__((ext_vector_type(4)));
typedef float f32x16h __attribute__((ext_vector_type(16)));
typedef __attribute__((address_space(3))) const unsigned char* lcptr;
constexpr int HRS = 272;
constexpr int H_VT = 0, H_QT = 17408, H_KT = 2 * 17408, H_QP = 3 * 17408, H_SS = 4 * 17408, H_HQ = H_SS + 1024, H_LF = H_HQ + 17408, LFRS = 528, H_END = H_LF + 64 * LFRS;
static_assert(H_END <= 131072, "hgrn LDS map");
__device__ __forceinline__ s16x4h h_vtr(lcptr p) { return __builtin_bit_cast(s16x4h, __builtin_amdgcn_ds_read_tr16_b64_v4i16((__attribute__((address_space(3))) s16x4h*)p)); }
__device__ __forceinline__ int h_crow(int r, int hi) { return (r & 3) + 8 * (r >> 2) + 4 * hi; }
__device__ __forceinline__ bf16x8 h_cat(s16x4h a, s16x4h b) { return (bf16x8){a[0], a[1], a[2], a[3], b[0], b[1], b[2], b[3]}; }
__device__ __forceinline__ void h_stage_tile(LAS unsigned char* L, int off, const bf16* src, int tid) {
#pragma unroll
    for (int i = 0; i < 2; ++i) { const int e = tid + 512 * i, r = e >> 4, ch = e & 15;
        const v4u v = *(const GAS v4u*)(src + (size_t)r * 512 + ch * 8); *(LAS v4u*)(L + off + r * HRS + ch * 16) = v; }
}
__device__ __forceinline__ void h_stage_lf(LAS unsigned char* L, const float* src, int tid) {
    f32x4 v[4];
#pragma unroll
    for (int i = 0; i < 4; ++i) { const int e = tid + 512 * i, r = e >> 5, ch = e & 31; v[i] = *(const GAS f32x4*)(src + (size_t)r * 512 + ch * 4); }
#pragma unroll
    for (int i = 0; i < 4; ++i) { const int e = tid + 512 * i, r = e >> 5, ch = e & 31; *(LAS f32x4*)(L + H_LF + r * LFRS + ch * 16) = v[i]; }
}
__device__ __forceinline__ void h_cumsum(const LAS unsigned char* L, int d, int kg, float (&lf)[32], float (&b)[32], float& bC, float& bMid) {
#pragma unroll
    for (int s = 0; s < 32; ++s) lf[s] = *(const LAS float*)(L + H_LF + (32 * kg + s) * LFRS + d * 4);
    float c = 0.f;
#pragma unroll
    for (int s = 0; s < 32; ++s) { c += lf[s]; b[s] = c; }
    const float Tp = __shfl_xor(c, 32);
    const float P = kg ? Tp : 0.f;
#pragma unroll
    for (int s = 0; s < 32; ++s) b[s] += P;
    bC = c + Tp; bMid = kg ? Tp : c;
}
__device__ __forceinline__ float ex(float x) { return __builtin_amdgcn_exp2f(x * LOG2E); }

__device__ __forceinline__ void hgrn_a_item(LAS unsigned char* L, int bh, int c, const float* LF, const bf16* HIb, bf16* UT, float* GC, int tid, int lane, int wave) {
    const int b = bh >> 2, h = bh & 3; const size_t t0 = (size_t)b * SEQ + (size_t)c * 64;
    h_stage_tile(L, H_VT, HIb + t0 * 512 + h * 128, tid);
    h_stage_lf(L, LF + t0 * 512 + h * 128, tid);
    __syncthreads();
    const int dblk = wave & 3, vhalf = wave >> 2, i = lane & 31, kg = lane >> 5, d = 32 * dblk + i;
    float lf[32], bb[32], bC, bMid;
    h_cumsum(L, d, kg, lf, bb, bC, bMid);
    bf16x8 kf[4];
#pragma unroll
    for (int ks = 0; ks < 4; ++ks) { unsigned w[4];
#pragma unroll
        for (int j = 0; j < 4; ++j) { const int s0 = 8 * ks + 2 * j; w[j] = pkbf((1.f - ex(lf[s0])) * ex(bC - bb[s0]), (1.f - ex(lf[s0 + 1])) * ex(bC - bb[s0 + 1])); }
        kf[ks] = __builtin_bit_cast(bf16x8, (v4u){w[0], w[1], w[2], w[3]}); }
    if (vhalf == 0 && kg == 0) GC[((size_t)bh * 128 + c) * 128 + d] = ex(bC);
    const int q = (lane & 15) >> 2, p = lane & 3, g1 = (lane >> 4) & 1;
    f32x16h acc[2];
#pragma unroll
    for (int vt = 0; vt < 2; ++vt) { acc[vt] = f32x16h{};
        const lcptr vp = (lcptr)(L + H_VT) + (32 * kg + q) * HRS + (32 * (2 * vhalf + vt) + 16 * g1 + 4 * p) * 2;
#pragma unroll
        for (int ks = 0; ks < 4; ++ks) { const s16x4h lo = h_vtr(vp + (8 * ks) * HRS), hi4 = h_vtr(vp + (8 * ks + 4) * HRS);
            acc[vt] = __builtin_amdgcn_mfma_f32_32x32x16_bf16(h_cat(lo, hi4), kf[ks], acc[vt], 0, 0, 0); } }
    bf16* U = UT + ((size_t)bh * 128 + c) * 16384;
#pragma unroll
    for (int vt = 0; vt < 2; ++vt)
#pragma unroll
        for (int r = 0; r < 16; ++r) U[(size_t)(32 * (2 * vhalf + vt) + h_crow(r, kg)) * 128 + d] = (bf16)(pkbf(acc[vt][r], 0.f) & 0xffffu);
    __syncthreads();
}

#define H_BAR() asm volatile("s_waitcnt lgkmcnt(0)\n\ts_barrier" ::: "memory")
struct HTileRegs { v4u v[2]; v4u q[2]; f32x4 lf[4]; };
template <bool WITHQ> __device__ __forceinline__ void h_tiles_load(HTileRegs& R, const bf16* HIb, const bf16* HQb, const float* LF, size_t t0, int h, int tid) {
#pragma unroll
    for (int i = 0; i < 2; ++i) { const int e = tid + 512 * i, r = e >> 4, ch = e & 15; R.v[i] = *(const GAS v4u*)(HIb + (t0 + r) * 512 + h * 128 + ch * 8);
        if (WITHQ) R.q[i] = *(const GAS v4u*)(HQb + (t0 + r) * 512 + h * 128 + ch * 8); }
#pragma unroll
    for (int i = 0; i < 4; ++i) { const int e = tid + 512 * i, r = e >> 5, ch = e & 31; R.lf[i] = *(const GAS f32x4*)(LF + (t0 + r) * 512 + h * 128 + ch * 4); }
}
template <bool WITHQ> __device__ __forceinline__ void h_tiles_store(LAS unsigned char* L, const HTileRegs& R, int tid) {
#pragma unroll
    for (int i = 0; i < 2; ++i) { const int e = tid + 512 * i, r = e >> 4, ch = e & 15; *(LAS v4u*)(L + H_VT + r * HRS + ch * 16) = R.v[i];
        if (WITHQ) *(LAS v4u*)(L + H_HQ + r * HRS + ch * 16) = R.q[i]; }
#pragma unroll
    for (int i = 0; i < 4; ++i) { const int e = tid + 512 * i, r = e >> 5, ch = e & 31; *(LAS f32x4*)(L + H_LF + r * LFRS + ch * 16) = R.lf[i]; }
}
__device__ __forceinline__ size_t h_t0(int it) { return (size_t)(it >> 9) * SEQ + (size_t)(it & 127) * 64; }
__device__ __forceinline__ void hgrn_a_phase(LAS unsigned char* L, int it0, int step, int end, const float* LF, const bf16* HIb, bf16* UT, float* GC, int tid, int lane, int wave) {
    HTileRegs R;
    if (it0 < end) h_tiles_load<false>(R, HIb, nullptr, LF, h_t0(it0), (it0 >> 7) & 3, tid);
    for (int it = it0; it < end; it += step) {
        const int bh = it >> 7, c = it & 127;
        h_tiles_store<false>(L, R, tid);
        H_BAR();
        __builtin_amdgcn_sched_barrier(0);
        if (it + step < end) h_tiles_load<false>(R, HIb, nullptr, LF, h_t0(it + step), ((it + step) >> 7) & 3, tid);
        __builtin_amdgcn_sched_barrier(0);
        const int dblk = wave & 3, vhalf = wave >> 2, i = lane & 31, kg = lane >> 5, d = 32 * dblk + i;
        float lf[32], bb[32], bC, bMid;
        h_cumsum(L, d, kg, lf, bb, bC, bMid);
        bf16x8 kf[4];
#pragma unroll
        for (int ks = 0; ks < 4; ++ks) { unsigned w[4];
#pragma unroll
            for (int j = 0; j < 4; ++j) { const int s0 = 8 * ks + 2 * j; w[j] = pkbf((1.f - ex(lf[s0])) * ex(bC - bb[s0]), (1.f - ex(lf[s0 + 1])) * ex(bC - bb[s0 + 1])); }
            kf[ks] = __builtin_bit_cast(bf16x8, (v4u){w[0], w[1], w[2], w[3]}); }
        if (vhalf == 0 && kg == 0) GC[((size_t)bh * 128 + c) * 128 + d] = ex(bC);
        const int q = (lane & 15) >> 2, p = lane & 3, g1 = (lane >> 4) & 1;
        f32x16h acc[2];
#pragma unroll
        for (int vt = 0; vt < 2; ++vt) { acc[vt] = f32x16h{};
            const lcptr vp = (lcptr)(L + H_VT) + (32 * kg + q) * HRS + (32 * (2 * vhalf + vt) + 16 * g1 + 4 * p) * 2;
#pragma unroll
            for (int ks = 0; ks < 4; ++ks) { const s16x4h lo = h_vtr(vp + (8 * ks) * HRS), hi4 = h_vtr(vp + (8 * ks + 4) * HRS);
                acc[vt] = __builtin_amdgcn_mfma_f32_32x32x16_bf16(h_cat(lo, hi4), kf[ks], acc[vt], 0, 0, 0); } }
        bf16* U = UT + ((size_t)bh * 128 + c) * 16384;
#pragma unroll
        for (int vt = 0; vt < 2; ++vt)
#pragma unroll
            for (int r = 0; r < 16; ++r) U[(size_t)(32 * (2 * vhalf + vt) + h_crow(r, kg)) * 128 + d] = (bf16)(pkbf(acc[vt][r], 0.f) & 0xffffu);
        H_BAR();
    }
    asm volatile("s_waitcnt vmcnt(0)" ::: "memory");
}
__device__ __forceinline__ void hgrn_scan(const bf16* UT, const float* GC, bf16* ST, float* outS, int e0, int estride) {
    for (int e = e0; e < 8 * 16384; e += estride) {
        const int bh = e >> 14, vd = e & 16383, d = e & 127, v = vd >> 7;
        const bf16* U = UT + (size_t)bh * 128 * 16384 + vd; const float* Gp = GC + (size_t)bh * 128 * 128 + d; bf16* Sp = ST + (size_t)bh * 128 * 16384 + vd;
        float S = 0.f;
        unsigned short ua[32], ub[32]; float ga[32], gb[32];
#define SC_LOAD(UU, GG, C0) do { _Pragma("unroll") for (int k = 0; k < 32; ++k) { UU[k] = U[(size_t)((C0) + k) * 16384]; GG[k] = Gp[((C0) + k) * 128]; } } while (0)
#define SC_RUN(UU, GG, C0) do { _Pragma("unroll") for (int k = 0; k < 32; ++k) { Sp[(size_t)((C0) + k) * 16384] = (bf16)(pkbf(S, 0.f) & 0xffffu); S = GG[k] * S + bf2f(UU[k]); } } while (0)
        SC_LOAD(ua, ga, 0); __builtin_amdgcn_sched_barrier(0);
        SC_LOAD(ub, gb, 32); __builtin_amdgcn_sched_barrier(0);
        SC_RUN(ua, ga, 0); __builtin_amdgcn_sched_barrier(0);
        SC_LOAD(ua, ga, 64); __builtin_amdgcn_sched_barrier(0);
        SC_RUN(ub, gb, 32); __builtin_amdgcn_sched_barrier(0);
        SC_LOAD(ub, gb, 96); __builtin_amdgcn_sched_barrier(0);
        SC_RUN(ua, ga, 64); __builtin_amdgcn_sched_barrier(0);
        SC_RUN(ub, gb, 96);
#undef SC_LOAD
#undef SC_RUN
        outS[((size_t)bh * 128 + d) * 128 + v] = S;
    }
}
__device__ __forceinline__ void hgrn_c_item(LAS unsigned char* L, int bh, int c, const float* LF, const bf16* HQb, const bf16* HIb, const bf16* HGb, const bf16* ST, const float* hgn_g, bf16* MIX, int tid, int lane, int wave) {
    const int b = bh >> 2, h = bh & 3; const size_t t0 = (size_t)b * SEQ + (size_t)c * 64;
    h_stage_tile(L, H_VT, HIb + t0 * 512 + h * 128, tid);
    h_stage_tile(L, H_HQ, HQb + t0 * 512 + h * 128, tid);
    h_stage_lf(L, LF + t0 * 512 + h * 128, tid);
    __syncthreads();
    {
        const int dblk = wave & 3, i = lane & 31, kg = lane >> 5, d = 32 * dblk + i;
        float lf[32], bb[32], bC, bMid;
        h_cumsum(L, d, kg, lf, bb, bC, bMid);
        if (wave < 4) {
#pragma unroll
            for (int s = 0; s < 32; ++s) { const int t = 32 * kg + s; const float qv = bf2f(*(const LAS bf16*)(L + H_HQ + t * HRS + d * 2));
                *(LAS bf16*)(L + H_QT + t * HRS + d * 2) = (bf16)(pkbf(qv * ex(bb[s] - bMid), 0.f) & 0xffffu);
                *(LAS bf16*)(L + H_QP + t * HRS + d * 2) = (bf16)(pkbf(qv * ex(bb[s]), 0.f) & 0xffffu); }
        } else {
#pragma unroll
            for (int s = 0; s < 32; ++s) { const int t = 32 * kg + s;
                *(LAS bf16*)(L + H_KT + t * HRS + d * 2) = (bf16)(pkbf((1.f - ex(lf[s])) * ex(bMid - bb[s]), 0.f) & 0xffffu); }
        }
    }
    __syncthreads();
    const int tb = wave & 1, vb = wave >> 1, n = lane & 31, hi = lane >> 5;
    const int q = (lane & 15) >> 2, p = lane & 3, g1 = (lane >> 4) & 1;
    f32x16h o = f32x16h{};
    for (int sb = 0; sb <= tb; ++sb) {
        f32x16h at = f32x16h{};
#pragma unroll
        for (int ks = 0; ks < 8; ++ks) {
            const bf16x8 ka = *(const LAS bf16x8*)(L + H_KT + (32 * sb + n) * HRS + (16 * ks + 8 * hi) * 2);
            const bf16x8 qb = *(const LAS bf16x8*)(L + H_QT + (32 * tb + n) * HRS + (16 * ks + 8 * hi) * 2);
            at = __builtin_amdgcn_mfma_f32_32x32x16_bf16(ka, qb, at, 0, 0, 0);
        }
        if (sb == tb) {
#pragma unroll
            for (int r = 0; r < 16; ++r) if (h_crow(r, hi) > n) at[r] = 0.f;
        }
#pragma unroll
        for (int kk = 0; kk < 2; ++kk) {
            const v4u pw = {pkbf(at[8 * kk + 0], at[8 * kk + 1]), pkbf(at[8 * kk + 2], at[8 * kk + 3]), pkbf(at[8 * kk + 4], at[8 * kk + 5]), pkbf(at[8 * kk + 6], at[8 * kk + 7])};
            const lcptr vp = (lcptr)(L + H_VT) + (32 * sb + 16 * kk + 4 * hi + q) * HRS + (32 * vb + 16 * g1 + 4 * p) * 2;
            const s16x4h lo = h_vtr(vp), hi4 = h_vtr(vp + 8 * HRS);
            o = __builtin_amdgcn_mfma_f32_32x32x16_bf16(h_cat(lo, hi4), __builtin_bit_cast(bf16x8, pw), o, 0, 0, 0);
        }
    }
    {
        const bf16* Sr = ST + ((size_t)bh * 128 + c) * 16384 + (size_t)(32 * vb + n) * 128 + 8 * hi;
#pragma unroll
        for (int ks = 0; ks < 8; ++ks) {
            const bf16x8 sa = *(const GAS bf16x8*)(Sr + 16 * ks);
            const bf16x8 qb = *(const LAS bf16x8*)(L + H_QP + (32 * tb + n) * HRS + (16 * ks + 8 * hi) * 2);
            o = __builtin_amdgcn_mfma_f32_32x32x16_bf16(sa, qb, o, 0, 0, 0);
        }
    }
    float ss = 0.f;
#pragma unroll
    for (int r = 0; r < 16; ++r) ss += o[r] * o[r];
    ss += __shfl_xor(ss, 32);
    LAS float* SS = (LAS float*)(L + H_SS);
    if (hi == 0) SS[(32 * tb + n) * 4 + vb] = ss;
    __syncthreads();
    const f32x4 s4 = *(const LAS f32x4*)(SS + (32 * tb + n) * 4);
    const float rs = __builtin_amdgcn_rsqf(((s4[0] + s4[1]) + (s4[2] + s4[3])) * (1.f / 128.f) + 1e-6f);
    const size_t row = t0 + 32 * tb + n;
#pragma unroll
    for (int rg = 0; rg < 4; ++rg) { const int v = 32 * vb + 8 * rg + 4 * hi;
        const unsigned long long gz = *(const GAS unsigned long long*)(HGb + row * 512 + h * 128 + v); const f32x4 gn = *(const GAS f32x4*)(hgn_g + v);
        const float g0 = bf2f((unsigned short)gz), g1f = bf2f((unsigned short)(gz >> 16)), g2 = bf2f((unsigned short)(gz >> 32)), g3 = bf2f((unsigned short)(gz >> 48));
        const unsigned w0 = pkbf(o[4 * rg + 0] * rs * gn[0] * g0, o[4 * rg + 1] * rs * gn[1] * g1f), w1 = pkbf(o[4 * rg + 2] * rs * gn[2] * g2, o[4 * rg + 3] * rs * gn[3] * g3);
        *(GAS unsigned long long*)(MIX + row * 1024 + 512 + h * 128 + v) = (unsigned long long)w0 | ((unsigned long long)w1 << 32); }
    __syncthreads();
}
__device__ __forceinline__ void hgrn_c_phase(LAS unsigned char* L, int it0, int step, const float* LF, const bf16* HQb, const bf16* HIb, const bf16* HGb, const bf16* ST, const float* hgn_g, bf16* MIX, int tid, int lane, int wave) {
    HTileRegs R;
    const int tb = wave & 1, vb = wave >> 1, n = lane & 31, hi = lane >> 5;
    bf16x8 sfr[8], sfn[8]; unsigned long long gzr[4], gzn[4];
#define HC_LOAD_SG(IT, SF, GZ) do { const int bh_ = (IT) >> 7, c_ = (IT) & 127; const size_t t0_ = (size_t)(bh_ >> 2) * SEQ + (size_t)c_ * 64; \
        const bf16* Sr_ = ST + ((size_t)bh_ * 128 + c_) * 16384 + (size_t)(32 * vb + n) * 128 + 8 * hi; \
        _Pragma("unroll") for (int ks = 0; ks < 8; ++ks) SF[ks] = *(const GAS bf16x8*)(Sr_ + 16 * ks); \
        _Pragma("unroll") for (int rg = 0; rg < 4; ++rg) GZ[rg] = *(const GAS unsigned long long*)(HGb + (t0_ + 32 * tb + n) * 512 + (bh_ & 3) * 128 + 32 * vb + 8 * rg + 4 * hi); } while (0)
    if (it0 < 1024) { h_tiles_load<true>(R, HIb, HQb, LF, h_t0(it0), (it0 >> 7) & 3, tid); HC_LOAD_SG(it0, sfr, gzr); }
    for (int it = it0; it < 1024; it += step) {
    const int bh = it >> 7, c = it & 127;
    const int b = bh >> 2, h = bh & 3; const size_t t0 = (size_t)b * SEQ + (size_t)c * 64;
    h_tiles_store<true>(L, R, tid);
    H_BAR();
    __builtin_amdgcn_sched_barrier(0);
    if (it + step < 1024) { h_tiles_load<true>(R, HIb, HQb, LF, h_t0(it + step), ((it + step) >> 7) & 3, tid); HC_LOAD_SG(it + step, sfn, gzn); }
    __builtin_amdgcn_sched_barrier(0);
    {
        const int dblk = wave & 3, i = lane & 31, kg = lane >> 5, d = 32 * dblk + i;
        float lf[32], bb[32], bC, bMid;
        h_cumsum(L, d, kg, lf, bb, bC, bMid);
        if (wave < 4) {
#pragma unroll
            for (int s = 0; s < 32; ++s) { const int t = 32 * kg + s; const float qv = bf2f(*(const LAS bf16*)(L + H_HQ + t * HRS + d * 2));
                *(LAS bf16*)(L + H_QT + t * HRS + d * 2) = (bf16)(pkbf(qv * ex(bb[s] - bMid), 0.f) & 0xffffu);
                *(LAS bf16*)(L + H_QP + t * HRS + d * 2) = (bf16)(pkbf(qv * ex(bb[s]), 0.f) & 0xffffu); }
        } else {
#pragma unroll
            for (int s = 0; s < 32; ++s) { const int t = 32 * kg + s;
                *(LAS bf16*)(L + H_KT + t * HRS + d * 2) = (bf16)(pkbf((1.f - ex(lf[s])) * ex(bMid - bb[s]), 0.f) & 0xffffu); }
        }
    }
    H_BAR();
    const int q = (lane & 15) >> 2, p = lane & 3, g1 = (lane >> 4) & 1;
    f32x16h o = f32x16h{};
    for (int sb = 0; sb <= tb; ++sb) {
        f32x16h at = f32x16h{};
#pragma unroll
        for (int ks = 0; ks < 8; ++ks) {
            const bf16x8 ka = *(const LAS bf16x8*)(L + H_KT + (32 * sb + n) * HRS + (16 * ks + 8 * hi) * 2);
            const bf16x8 qb = *(const LAS bf16x8*)(L + H_QT + (32 * tb + n) * HRS + (16 * ks + 8 * hi) * 2);
            at = __builtin_amdgcn_mfma_f32_32x32x16_bf16(ka, qb, at, 0, 0, 0);
        }
        if (sb == tb) {
#pragma unroll
            for (int r = 0; r < 16; ++r) if (h_crow(r, hi) > n) at[r] = 0.f;
        }
#pragma unroll
        for (int kk = 0; kk < 2; ++kk) {
            const v4u pw = {pkbf(at[8 * kk + 0], at[8 * kk + 1]), pkbf(at[8 * kk + 2], at[8 * kk + 3]), pkbf(at[8 * kk + 4], at[8 * kk + 5]), pkbf(at[8 * kk + 6], at[8 * kk + 7])};
            const lcptr vp = (lcptr)(L + H_VT) + (32 * sb + 16 * kk + 4 * hi + q) * HRS + (32 * vb + 16 * g1 + 4 * p) * 2;
            const s16x4h lo = h_vtr(vp), hi4 = h_vtr(vp + 8 * HRS);
            o = __builtin_amdgcn_mfma_f32_32x32x16_bf16(h_cat(lo, hi4), __builtin_bit_cast(bf16x8, pw), o, 0, 0, 0);
        }
    }
    {
#pragma unroll
        for (int ks = 0; ks < 8; ++ks) {
            const bf16x8 sa = sfr[ks];
            const bf16x8 qb = *(const LAS bf16x8*)(L + H_QP + (32 * tb + n) * HRS + (16 * ks + 8 * hi) * 2);
            o = __builtin_amdgcn_mfma_f32_32x32x16_bf16(sa, qb, o, 0, 0, 0);
        }
    }
    float ss = 0.f;
#pragma unroll
    for (int r = 0; r < 16; ++r) ss += o[r] * o[r];
    ss += __shfl_xor(ss, 32);
    LAS float* SS = (LAS float*)(L + H_SS);
    if (hi == 0) SS[(32 * tb + n) * 4 + vb] = ss;
    H_BAR();
    const f32x4 s4 = *(const LAS f32x4*)(SS + (32 * tb + n) * 4);
    const float rs = __builtin_amdgcn_rsqf(((s4[0] + s4[1]) + (s4[2] + s4[3])) * (1.f / 128.f) + 1e-6f);
    const size_t row = t0 + 32 * tb + n;
#pragma unroll
    for (int rg = 0; rg < 4; ++rg) { const int v = 32 * vb + 8 * rg + 4 * hi;
        const unsigned long long gz = gzr[rg]; const f32x4 gn = *(const GAS f32x4*)(hgn_g + v);
        const float g0 = bf2f((unsigned short)gz), g1f = bf2f((unsigned short)(gz >> 16)), g2 = bf2f((unsigned short)(gz >> 32)), g3 = bf2f((unsigned short)(gz >> 48));
        const unsigned w0 = pkbf(o[4 * rg + 0] * rs * gn[0] * g0, o[4 * rg + 1] * rs * gn[1] * g1f), w1 = pkbf(o[4 * rg + 2] * rs * gn[2] * g2, o[4 * rg + 3] * rs * gn[3] * g3);
        *(GAS unsigned long long*)(MIX + row * 1024 + 512 + h * 128 + v) = (unsigned long long)w0 | ((unsigned long long)w1 << 32); }
    H_BAR();
#pragma unroll
    for (int ks = 0; ks < 8; ++ks) sfr[ks] = sfn[ks];
#pragma unroll
    for (int rg = 0; rg < 4; ++rg) gzr[rg] = gzn[rg];
    }
    asm volatile("s_waitcnt vmcnt(0)" ::: "memory");
#undef HC_LOAD_SG
}
constexpr int SM_COEF = 0, SM_VV = 128 * 20 * 4, SM_A = SM_VV + 8 * 128 * 4, SM_EK = SM_A + 64 * 4, SM_RED = SM_EK + 8 * 129 * 4, SM_EQ = SM_RED + 4 * 8 * 128 * 4, SM_END = SM_EQ + 8 * 129 * 4;
__device__ __forceinline__ void hgrn_s_item(LAS unsigned char* L, int b, int h, const float* LF, const bf16* HQb, const bf16* HIb, const bf16* HGb, const float* S0, const float* hgn_g, float* outS, bf16* MIX, int tid, int lane, int wave) {
    LAS float* COEF = (LAS float*)(L + SM_COEF);
    LAS float* VV = (LAS float*)(L + SM_VV);
    LAS float* AM = (LAS float*)(L + SM_A);
    LAS float* EK = (LAS float*)(L + SM_EK);
    LAS float* EQ = (LAS float*)(L + SM_EQ);
    LAS float* RED = (LAS float*)(L + SM_RED);
    const size_t r0 = (size_t)MP + (size_t)b * 8;
    if (tid < 128) { const int d = tid; float bsum = 0.f; float bt[8], kk[8];
#pragma unroll
        for (int t = 0; t < 8; ++t) { const float lf = LF[(r0 + t) * 512 + h * 128 + d]; bsum += lf; bt[t] = bsum; kk[t] = 1.f - ex(lf);
            const float qe = bf2f(HQb[(r0 + t) * 512 + h * 128 + d]) * ex(bsum); COEF[d * 20 + t] = qe; EQ[t * 129 + d] = qe; EK[t * 129 + d] = kk[t] * ex(-bsum); }
#pragma unroll
        for (int t = 0; t < 8; ++t) COEF[d * 20 + 8 + t] = kk[t] * ex(bsum - bt[t]);
        COEF[d * 20 + 16] = ex(bsum);
    } else if (tid < 256) { const int v = tid - 128;
#pragma unroll
        for (int s = 0; s < 8; ++s) VV[s * 128 + v] = bf2f(HIb[(r0 + s) * 512 + h * 128 + v]); }
    __syncthreads();
    if (tid < 64) { const int t = tid >> 3, s = tid & 7; float a = 0.f;
        if (s <= t) { for (int d = 0; d < 128; ++d) a += EQ[t * 129 + d] * EK[s * 129 + d]; }
        AM[t * 8 + s] = a; }
    {
        const int v = tid & 127, dq = tid >> 7; float vv[8], acc[8];
#pragma unroll
        for (int s = 0; s < 8; ++s) { vv[s] = VV[s * 128 + v]; acc[s] = 0.f; }
        const float* Sin = S0 + ((size_t)(b * 4 + h) * 128) * 128 + v; float* So = outS + ((size_t)(b * 4 + h) * 128) * 128 + v;
        float s0v[32];
#pragma unroll
        for (int dd = 0; dd < 32; ++dd) s0v[dd] = Sin[(size_t)(32 * dq + dd) * 128];
#pragma unroll
        for (int dd = 0; dd < 32; ++dd) { const int d = 32 * dq + dd; const float s0 = s0v[dd];
            const f32x4 c0 = *(const LAS f32x4*)(COEF + d * 20), c1 = *(const LAS f32x4*)(COEF + d * 20 + 4), c2 = *(const LAS f32x4*)(COEF + d * 20 + 8), c3 = *(const LAS f32x4*)(COEF + d * 20 + 12); const float gd = COEF[d * 20 + 16];
            float sn = gd * s0;
            sn += c2[0] * vv[0]; sn += c2[1] * vv[1]; sn += c2[2] * vv[2]; sn += c2[3] * vv[3]; sn += c3[0] * vv[4]; sn += c3[1] * vv[5]; sn += c3[2] * vv[6]; sn += c3[3] * vv[7];
            So[(size_t)d * 128] = sn;
            acc[0] += c0[0] * s0; acc[1] += c0[1] * s0; acc[2] += c0[2] * s0; acc[3] += c0[3] * s0; acc[4] += c1[0] * s0; acc[5] += c1[1] * s0; acc[6] += c1[2] * s0; acc[7] += c1[3] * s0; }
#pragma unroll
        for (int t = 0; t < 8; ++t) RED[(dq * 8 + t) * 128 + v] = acc[t];
    }
    __syncthreads();
    {
        const int t = wave; float o[2];
#pragma unroll
        for (int k = 0; k < 2; ++k) { const int v = lane + 64 * k; float a = (RED[(0 * 8 + t) * 128 + v] + RED[(1 * 8 + t) * 128 + v]) + (RED[(2 * 8 + t) * 128 + v] + RED[(3 * 8 + t) * 128 + v]);
#pragma unroll
            for (int s = 0; s < 8; ++s) a += AM[t * 8 + s] * VV[s * 128 + v];
            o[k] = a; }
        const float rs = __builtin_amdgcn_rsqf(wave_sum(o[0] * o[0] + o[1] * o[1]) * (1.f / 128.f) + 1e-6f);
#pragma unroll
        for (int k = 0; k < 2; ++k) { const int v = lane + 64 * k;
            MIX[(r0 + t) * 1024 + 512 + h * 128 + v] = (bf16)(pkbf(o[k] * rs * hgn_g[v] * bf2f(HGb[(r0 + t) * 512 + h * 128 + v]), 0.f) & 0xffffu); }
    }
    __syncthreads();
}
__device__ __forceinline__ void hgrn_s_phase(LAS unsigned char* L, int j0, int step, const float* LF, const bf16* HQb, const bf16* HIb, const bf16* HGb, const float* S0, const float* hgn_g, float* outS, bf16* MIX, int tid, int lane, int wave) {
    LAS float* COEF = (LAS float*)(L + SM_COEF);
    LAS float* VV = (LAS float*)(L + SM_VV);
    LAS float* AM = (LAS float*)(L + SM_A);
    LAS float* EK = (LAS float*)(L + SM_EK);
    LAS float* EQ = (LAS float*)(L + SM_EQ);
    LAS float* RED = (LAS float*)(L + SM_RED);
    float s0v[32];
#define HS_LOAD(J) do { const float* Sin_ = S0 + ((size_t)(J) * 128) * 128 + (tid & 127) + (size_t)(32 * (tid >> 7)) * 128; _Pragma("unroll") for (int dd = 0; dd < 32; ++dd) s0v[dd] = Sin_[(size_t)dd * 128]; } while (0)
    if (j0 < 512) HS_LOAD(j0);
    for (int j = j0; j < 512; j += step) {
    const int b = j >> 2, h = j & 3;
    const size_t r0 = (size_t)MP + (size_t)b * 8;
    if (tid < 128) { const int d = tid; float bsum = 0.f; float bt[8], kk[8];
#pragma unroll
        for (int t = 0; t < 8; ++t) { const float lf = LF[(r0 + t) * 512 + h * 128 + d]; bsum += lf; bt[t] = bsum; kk[t] = 1.f - ex(lf);
            const float qe = bf2f(HQb[(r0 + t) * 512 + h * 128 + d]) * ex(bsum); COEF[d * 20 + t] = qe; EQ[t * 129 + d] = qe; EK[t * 129 + d] = kk[t] * ex(-bsum); }
#pragma unroll
        for (int t = 0; t < 8; ++t) COEF[d * 20 + 8 + t] = kk[t] * ex(bsum - bt[t]);
        COEF[d * 20 + 16] = ex(bsum);
    } else if (tid < 256) { const int v = tid - 128;
#pragma unroll
        for (int s = 0; s < 8; ++s) VV[s * 128 + v] = bf2f(HIb[(r0 + s) * 512 + h * 128 + v]); }
    __syncthreads();
    if (tid < 64) { const int t = tid >> 3, s = tid & 7; float a = 0.f;
        if (s <= t) {
#pragma unroll 16
            for (int d = 0; d < 128; ++d) a += EQ[t * 129 + d] * EK[s * 129 + d]; }
        AM[t * 8 + s] = a; }
    {
        const int v = tid & 127, dq = tid >> 7; float vv[8], acc[8];
#pragma unroll
        for (int s = 0; s < 8; ++s) { vv[s] = VV[s * 128 + v]; acc[s] = 0.f; }
        float* So = outS + ((size_t)(b * 4 + h) * 128) * 128 + v;
#pragma unroll
        for (int dd = 0; dd < 32; ++dd) { const int d = 32 * dq + dd; const float s0 = s0v[dd];
            const f32x4 c0 = *(const LAS f32x4*)(COEF + d * 20), c1 = *(const LAS f32x4*)(COEF + d * 20 + 4), c2 = *(const LAS f32x4*)(COEF + d * 20 + 8), c3 = *(const LAS f32x4*)(COEF + d * 20 + 12); const float gd = COEF[d * 20 + 16];
            float sn = gd * s0;
            sn += c2[0] * vv[0]; sn += c2[1] * vv[1]; sn += c2[2] * vv[2]; sn += c2[3] * vv[3]; sn += c3[0] * vv[4]; sn += c3[1] * vv[5]; sn += c3[2] * vv[6]; sn += c3[3] * vv[7];
            So[(size_t)d * 128] = sn;
            acc[0] += c0[0] * s0; acc[1] += c0[1] * s0; acc[2] += c0[2] * s0; acc[3] += c0[3] * s0; acc[4] += c1[0] * s0; acc[5] += c1[1] * s0; acc[6] += c1[2] * s0; acc[7] += c1[3] * s0; }
#pragma unroll
        for (int t = 0; t < 8; ++t) RED[(dq * 8 + t) * 128 + v] = acc[t];
        __builtin_amdgcn_sched_barrier(0);
        if (j + step < 512) HS_LOAD(j + step);
        __builtin_amdgcn_sched_barrier(0);
    }
    H_BAR();
    {
        const int t = wave; float o[2];
#pragma unroll
        for (int k = 0; k < 2; ++k) { const int v = lane + 64 * k; float a = (RED[(0 * 8 + t) * 128 + v] + RED[(1 * 8 + t) * 128 + v]) + (RED[(2 * 8 + t) * 128 + v] + RED[(3 * 8 + t) * 128 + v]);
#pragma unroll
            for (int s = 0; s < 8; ++s) a += AM[t * 8 + s] * VV[s * 128 + v];
            o[k] = a; }
        const float rs = __builtin_amdgcn_rsqf(wave_sum(o[0] * o[0] + o[1] * o[1]) * (1.f / 128.f) + 1e-6f);
#pragma unroll
        for (int k = 0; k < 2; ++k) { const int v = lane + 64 * k;
            MIX[(r0 + t) * 1024 + 512 + h * 128 + v] = (bf16)(pkbf(o[k] * rs * hgn_g[v] * bf2f(HGb[(r0 + t) * 512 + h * 128 + v]), 0.f) & 0xffffu); }
    }
    H_BAR();
    }
    asm volatile("s_waitcnt vmcnt(0)" ::: "memory");
#undef HS_LOAD
}

constexpr int SR_RED = 0;
struct HsRaw { float lf[8]; unsigned short hq[8]; unsigned short hi[8][2]; unsigned short hg[2]; float s0[16][2]; };
__device__ __forceinline__ void hs_load(HsRaw& R, int j, const float* LF, const bf16* HQb, const bf16* HIb, const bf16* HGb, const float* S0, int lane, int wave) {
    const int b = j >> 2, h = j & 3; const size_t r0 = (size_t)MP + (size_t)b * 8; const int d = 16 * wave + (lane & 15);
#pragma unroll
    for (int t = 0; t < 8; ++t) { R.lf[t] = LF[(r0 + t) * 512 + h * 128 + d]; R.hq[t] = HQb[(r0 + t) * 512 + h * 128 + d];
        R.hi[t][0] = HIb[(r0 + t) * 512 + h * 128 + lane]; R.hi[t][1] = HIb[(r0 + t) * 512 + h * 128 + lane + 64]; }
    R.hg[0] = HGb[(r0 + wave) * 512 + h * 128 + lane]; R.hg[1] = HGb[(r0 + wave) * 512 + h * 128 + lane + 64];
    const float* Sin_ = S0 + ((size_t)j * 128 + 16 * wave) * 128 + lane;
#pragma unroll
    for (int i = 0; i < 16; ++i) { R.s0[i][0] = Sin_[(size_t)i * 128]; R.s0[i][1] = Sin_[(size_t)i * 128 + 64]; }
}
__device__ __forceinline__ void hgrn_s_phase2(LAS unsigned char* L, int j0, int step, int end, const float* LF, const bf16* HQb, const bf16* HIb, const bf16* HGb, const float* S0, const float* hgn_g, float* outS, bf16* MIX, int tid, int lane, int wave) {
    LAS float* RED = (LAS float*)(L + SR_RED);
    HsRaw C, N;
    if (j0 < end) hs_load(C, j0, LF, HQb, HIb, HGb, S0, lane, wave);
    const float gn0 = hgn_g[lane], gn1 = hgn_g[lane + 64];
    for (int j = j0; j < end; j += step) {
        const int b = j >> 2, h = j & 3; const size_t r0 = (size_t)MP + (size_t)b * 8;
        __builtin_amdgcn_sched_barrier(0);
        if (j + step < end) hs_load(N, j + step, LF, HQb, HIb, HGb, S0, lane, wave);
        __builtin_amdgcn_sched_barrier(0);
        float ek[8], eq[8], gd; { float bsum = 0.f;
#pragma unroll
            for (int t = 0; t < 8; ++t) { const float lf = C.lf[t]; bsum += lf; ek[t] = (1.f - ex(lf)) * ex(-bsum); eq[t] = bf2f(C.hq[t]) * ex(bsum); }
            gd = ex(bsum); }
        float acc[8][2];
#pragma unroll
        for (int t = 0; t < 8; ++t) { acc[t][0] = 0.f; acc[t][1] = 0.f; }
        float* So = outS + ((size_t)j * 128 + 16 * wave) * 128 + lane;
#pragma unroll
        for (int i = 0; i < 16; ++i) {
            float w0 = C.s0[i][0], w1 = C.s0[i][1];
#pragma unroll
            for (int s = 0; s < 8; ++s) { const float ks = __uint_as_float(__builtin_amdgcn_readlane(__float_as_uint(ek[s]), i)), qs = __uint_as_float(__builtin_amdgcn_readlane(__float_as_uint(eq[s]), i));
                w0 += ks * bf2f(C.hi[s][0]); w1 += ks * bf2f(C.hi[s][1]); acc[s][0] += qs * w0; acc[s][1] += qs * w1; }
            const float gi = __uint_as_float(__builtin_amdgcn_readlane(__float_as_uint(gd), i));
            So[(size_t)i * 128] = gi * w0; So[(size_t)i * 128 + 64] = gi * w1;
        }
#pragma unroll
        for (int t = 0; t < 8; ++t) { RED[(wave * 8 + t) * 128 + lane] = acc[t][0]; RED[(wave * 8 + t) * 128 + lane + 64] = acc[t][1]; }
        H_BAR();
        {
            const int t = wave; float o[2];
#pragma unroll
            for (int k = 0; k < 2; ++k) { const int v = lane + 64 * k; float a = 0.f;
#pragma unroll
                for (int w = 0; w < 8; ++w) a += RED[(w * 8 + t) * 128 + v];
                o[k] = a; }
            const float rs = __builtin_amdgcn_rsqf(wave_sum(o[0] * o[0] + o[1] * o[1]) * (1.f / 128.f) + 1e-6f);
            MIX[(r0 + t) * 1024 + 512 + h * 128 + lane] = (bf16)(pkbf(o[0] * rs * gn0 * bf2f(C.hg[0]), 0.f) & 0xffffu);
            MIX[(r0 + t) * 1024 + 512 + h * 128 + lane + 64] = (bf16)(pkbf(o[1] * rs * gn1 * bf2f(C.hg[1]), 0.f) & 0xffffu);
        }
        H_BAR();
        C = N;
    }
    asm volatile("s_waitcnt vmcnt(0)" ::: "memory");
}
typedef float f32x4d __attribute__((ext_vector_type(4)));
constexpr int DVRS = 272, DVR = 32 * DVRS;
constexpr int DC_PO = 0, DC_PM = 8 * DVR, DC_PL = DC_PM + 8 * 16 * 4, DC_SN = DC_PL + 8 * 16 * 4, DC_SQ = DC_SN + 2 * 8 * 16 * 4, DC_END = DC_SQ + 2 * 8 * 2 * 4;
static_assert(DVR >= 128 * 16 * 4 && DC_END <= 131072, "decode LDS map");
__device__ __forceinline__ bf16x8 cvt8(const f32x4d a, const f32x4d b) { v4u w = {pkbf(a[0], a[1]), pkbf(a[2], a[3]), pkbf(b[0], b[1]), pkbf(b[2], b[3])}; return __builtin_bit_cast(bf16x8, w); }
__device__ __forceinline__ float lam_value(const float* lq1, const float* lk1, const float* lq2, const float* lk2, int lane) {
    const float a = wave_sum(lq1[lane] * lk1[lane]), b = wave_sum(lq2[lane] * lk2[lane]);
    return ex(a) - ex(b) + 0.2f;
}
__device__ __forceinline__ void dec_item(LAS unsigned char* L, int b, int hp, const float* ck, const float* cv, const int* ptab, const bf16* Qb, const bf16* Kb, const bf16* Vb, const bf16* AGb,
                                         const float* subln_g, const float* lq1, const float* lk1, const float* lq2, const float* lk2, bf16* MIX, int tid_, int lane_, int wave) {
    int tid = tid_, lane = lane_;
    const int n = lane & 15, kg = lane >> 4;
    const int h = 2 * hp + (wave & 1), tq = wave >> 1;
    const size_t r0 = (size_t)MP + (size_t)b * 8;
    bf16x8 qx[4];
#pragma unroll
    for (int kk = 0; kk < 4; ++kk) { const bool on = (n < 8) == (kk < 2);
        v4u z = {0u, 0u, 0u, 0u}; if (on) z = *(const GAS v4u*)(Qb + (r0 + (n & 7)) * 512 + h * 128 + 32 * kk + 8 * kg);
        qx[kk] = __builtin_bit_cast(bf16x8, z); }
    f32x4d O[8];
#pragma unroll
    for (int mt = 0; mt < 8; ++mt) O[mt] = (f32x4d){0.f, 0.f, 0.f, 0.f};
    float m_run = -INFINITY, l_run = 0.f;
    LAS unsigned char* vst = L + DC_PO + wave * DVR;
    const lcptr vtr0 = (lcptr)vst + (4 * kg + ((lane & 15) >> 2)) * DVRS + (lane & 3) * 8;
    f32x4d kr[2][8], vr[16];
    const int pgv = ptab[b * 16 + (lane & 15)];
#define DEC_SB() __builtin_amdgcn_sched_barrier(0)
#define DEC_LOADK(IT) do { const int pg_ = __builtin_amdgcn_readlane(pgv, (IT)); const float* kb_ = ck + (((size_t)pg_ * 128 + tq * 32) * 4 + h) * 128 + (size_t)n * 512 + 8 * kg; \
        _Pragma("unroll") for (int tl = 0; tl < 2; ++tl) _Pragma("unroll") for (int kk = 0; kk < 4; ++kk) { const float* p = kb_ + (size_t)(16 * tl) * 512 + 32 * kk; kr[tl][2 * kk] = __builtin_nontemporal_load((const GAS f32x4d*)p); kr[tl][2 * kk + 1] = __builtin_nontemporal_load((const GAS f32x4d*)(p + 4)); } } while (0)
#define DEC_LOADV(IT) do { const int pg_ = __builtin_amdgcn_readlane(pgv, (IT)); const float* vb_ = cv + (((size_t)pg_ * 128 + tq * 32) * 4 + h) * 128 + (size_t)(lane >> 5) * 512 + (lane & 31) * 4; \
        _Pragma("unroll") for (int t = 0; t < 16; ++t) vr[t] = __builtin_nontemporal_load((const GAS f32x4d*)(vb_ + (size_t)(2 * t) * 512)); } while (0)
    DEC_LOADK(0); DEC_SB(); DEC_LOADV(0); DEC_SB();
    for (int it = 0; it < 16; ++it) {
        asm volatile("s_waitcnt vmcnt(16)" ::: "memory"); DEC_SB();
        f32x4d sa = (f32x4d){0.f, 0.f, 0.f, 0.f}, sb = (f32x4d){0.f, 0.f, 0.f, 0.f};
#pragma unroll
        for (int kk = 0; kk < 4; ++kk) { sa = __builtin_amdgcn_mfma_f32_16x16x32_bf16(cvt8(kr[0][2 * kk], kr[0][2 * kk + 1]), qx[kk], sa, 0, 0, 0);
                                         sb = __builtin_amdgcn_mfma_f32_16x16x32_bf16(cvt8(kr[1][2 * kk], kr[1][2 * kk + 1]), qx[kk], sb, 0, 0, 0); }
        DEC_SB();
        if (it < 15) { DEC_LOADK(it + 1); }
        DEC_SB();
        float mx = fmaxf(fmaxf(fmaxf(sa[0], sa[1]), fmaxf(sa[2], sa[3])), fmaxf(fmaxf(sb[0], sb[1]), fmaxf(sb[2], sb[3])));
        mx = fmaxf(mx, __shfl_xor(mx, 16)); mx = fmaxf(mx, __shfl_xor(mx, 32));
        const float m_new = fmaxf(m_run, mx); const float alpha = __builtin_amdgcn_exp2f(m_run - m_new); m_run = m_new;
        f32x4d pa, pb; float ps = 0.f;
#pragma unroll
        for (int r = 0; r < 4; ++r) { pa[r] = __builtin_amdgcn_exp2f(sa[r] - m_new); pb[r] = __builtin_amdgcn_exp2f(sb[r] - m_new); ps += pa[r] + pb[r]; }
        l_run = l_run * alpha + ps;
#pragma unroll
        for (int mt = 0; mt < 8; ++mt) O[mt] = O[mt] * alpha;
        const bf16x8 pB = cvt8(pa, pb);
        DEC_SB();
        if (it < 15) asm volatile("s_waitcnt vmcnt(16)" ::: "memory"); else asm volatile("s_waitcnt vmcnt(0)" ::: "memory");
        DEC_SB();
#pragma unroll
        for (int t = 0; t < 16; ++t) { const unsigned long long w = (unsigned long long)pkbf(vr[t][0], vr[t][1]) | ((unsigned long long)pkbf(vr[t][2], vr[t][3]) << 32);
            *(LAS unsigned long long*)(vst + (2 * t + (lane >> 5)) * DVRS + (lane & 31) * 8) = w; }
        DEC_SB();
        if (it < 15) { DEC_LOADV(it + 1); }
        DEC_SB();
#pragma unroll
        for (int mt = 0; mt < 8; ++mt) { const lcptr vp = vtr0 + mt * 32; const s16x4h lo = h_vtr(vp), hi4 = h_vtr(vp + 16 * DVRS);
            O[mt] = __builtin_amdgcn_mfma_f32_16x16x32_bf16(h_cat(lo, hi4), pB, O[mt], 0, 0, 0); }
    }
    asm volatile("s_waitcnt vmcnt(0)" ::: "memory");
#undef DEC_LOADV
#undef DEC_SB
#undef DEC_LOADK
    asm volatile("" : "+v"(tid), "+v"(lane));
    l_run += __shfl_xor(l_run, 16); l_run += __shfl_xor(l_run, 32);
    LAS float* PO = (LAS float*)(L + DC_PO); LAS float* PM = (LAS float*)(L + DC_PM); LAS float* PL = (LAS float*)(L + DC_PL); LAS float* SN = (LAS float*)(L + DC_SN); LAS float* SQ = (LAS float*)(L + DC_SQ);
#pragma unroll
    for (int mt = 0; mt < 8; ++mt)
#pragma unroll
        for (int r = 0; r < 4; ++r) PO[wave * (DVR / 4) + (16 * mt + 4 * kg + r) * 16 + n] = O[mt][r];
    if (kg == 0) { PM[wave * 16 + n] = m_run; PL[wave * 16 + n] = l_run; }
    const float lam = lam_value(lq1, lk1, lq2, lk2, lane);
    if (tid < 256) {
        const int hh = tid >> 7, j = (tid >> 4) & 7, col = tid & 15, q = col & 7, mp = col >> 3, h2 = 2 * hp + hh; float s = -INFINITY;
        if (j <= q) { s = 0.f; const GAS v4u* qp = (const GAS v4u*)(Qb + (r0 + q) * 512 + h2 * 128 + mp * 64); const GAS v4u* kp = (const GAS v4u*)(Kb + (r0 + j) * 512 + h2 * 128 + mp * 64);
            v4u qv[8], kv[8];
#pragma unroll
            for (int c8 = 0; c8 < 8; ++c8) { qv[c8] = qp[c8]; kv[c8] = kp[c8]; }
#pragma unroll
            for (int c8 = 0; c8 < 8; ++c8)
#pragma unroll
                for (int e = 0; e < 4; ++e) { s += __uint_as_float(qv[c8][e] << 16) * __uint_as_float(kv[c8][e] << 16); s += __uint_as_float(qv[c8][e] & 0xffff0000u) * __uint_as_float(kv[c8][e] & 0xffff0000u); } }
        SN[(hh * 8 + j) * 16 + col] = s;
    }
    __syncthreads();
    {
        const int dv = tid & 127, qg = tid >> 7; float o2[2][2];
#pragma unroll
        for (int hh = 0; hh < 2; ++hh) { const int h2 = 2 * hp + hh;
#pragma unroll
            for (int qq = 0; qq < 2; ++qq) { const int q = 2 * qg + qq; float res[2];
#pragma unroll
                for (int mp = 0; mp < 2; ++mp) { const int col = 8 * mp + q; float M = -INFINITY;
#pragma unroll
                    for (int w4 = 0; w4 < 4; ++w4) M = fmaxf(M, PM[(2 * w4 + hh) * 16 + col]);
#pragma unroll
                    for (int j = 0; j < 8; ++j) M = fmaxf(M, SN[(hh * 8 + j) * 16 + col]);
                    float Lsum = 0.f, Osum = 0.f;
#pragma unroll
                    for (int w4 = 0; w4 < 4; ++w4) { const int w = 2 * w4 + hh; const float wg = __builtin_amdgcn_exp2f(PM[w * 16 + col] - M); Lsum += wg * PL[w * 16 + col]; Osum += wg * PO[w * (DVR / 4) + dv * 16 + col]; }
#pragma unroll
                    for (int j = 0; j < 8; ++j) { const float wg = __builtin_amdgcn_exp2f(SN[(hh * 8 + j) * 16 + col] - M); Lsum += wg; Osum += wg * bf2f(Vb[(r0 + j) * 512 + h2 * 128 + dv]); }
                    res[mp] = Osum / Lsum; }
                o2[hh][qq] = res[0] - lam * res[1]; }
            const float s0 = wave_sum(o2[hh][0] * o2[hh][0]), s1 = wave_sum(o2[hh][1] * o2[hh][1]);
            if (lane == 0) { SQ[(hh * 8 + wave) * 2] = s0; SQ[(hh * 8 + wave) * 2 + 1] = s1; } }
        __syncthreads();
        const int wp = wave ^ 1;
#pragma unroll
        for (int hh = 0; hh < 2; ++hh) { const int h2 = 2 * hp + hh;
#pragma unroll
            for (int qq = 0; qq < 2; ++qq) { const int q = 2 * qg + qq; const float rs = __builtin_amdgcn_rsqf((SQ[(hh * 8 + wave) * 2 + qq] + SQ[(hh * 8 + wp) * 2 + qq]) * (1.f / 128.f) + 1e-6f);
                MIX[(r0 + q) * 1024 + h2 * 128 + dv] = (bf16)(pkbf(o2[hh][qq] * rs * subln_g[dv] * 0.8f * bf2f(AGb[(r0 + q) * 512 + h2 * 128 + dv]), 0.f) & 0xffffu); } }
    }
    __syncthreads();
}


template <int NR> __device__ __forceinline__ void attn_merge_rowsN(const bf16* OA, const bf16* AGb, const float* subln_g, float lam, bf16* MIX, int m0, int mstride, int lane) {
    const int half = lane >> 5, c = (2 * lane) & 63;
    unsigned a[NR][4], bq[NR][4], gz[NR][4];
#pragma unroll
    for (int r = 0; r < NR; ++r) { const int m = m0 + r * mstride; const size_t row = (size_t)(m < MP ? m : m0);
#pragma unroll
        for (int h = 0; h < 4; ++h) { a[r][h] = *(const GAS unsigned*)(OA + row * 1024 + (h * 4 + half) * 64 + c); bq[r][h] = *(const GAS unsigned*)(OA + row * 1024 + (h * 4 + 2 + half) * 64 + c);
            gz[r][h] = *(const GAS unsigned*)(AGb + row * 512 + h * 128 + 2 * lane); } }
    const float sg0 = subln_g[2 * lane] * 0.8f, sg1 = subln_g[2 * lane + 1] * 0.8f;
#pragma unroll
    for (int r = 0; r < NR; ++r) { const int m = m0 + r * mstride;
#pragma unroll
        for (int h = 0; h < 4; ++h) {
            const float o0 = bf2f((unsigned short)a[r][h]) - lam * bf2f((unsigned short)bq[r][h]), o1 = bf2f((unsigned short)(a[r][h] >> 16)) - lam * bf2f((unsigned short)(bq[r][h] >> 16));
            const float rs = __builtin_amdgcn_rsqf(wave_sum(o0 * o0 + o1 * o1) * (1.f / 128.f) + 1e-6f);
            const float g0 = sg0 * bf2f((unsigned short)gz[r][h]), g1 = sg1 * bf2f((unsigned short)(gz[r][h] >> 16));
            if (m < MP) *(GAS unsigned*)(MIX + (size_t)m * 1024 + h * 128 + 2 * lane) = pkbf(o0 * rs * g0, o1 * rs * g1); } }
}
struct Args { const void* in[18]; float* out; unsigned char* ws; int ph_lo, ph_hi, li, pad; };
__global__ void __launch_bounds__(NWAVES * 64, 2) mk_fwd(Args args) {
    extern __shared__ __attribute__((aligned(16))) unsigned char lds[];
    LAS unsigned char* L = (LAS unsigned char*)lds;
    volatile LAS unsigned* MISC = (volatile LAS unsigned*)(L + MISC_OFF);
    const int tid = threadIdx.x, lane = tid & 63, wave = __builtin_amdgcn_readfirstlane(tid >> 6);
    const int G = gridDim.x; const int bx = blockIdx.x; const int vcu = (G % 8 == 0) ? (bx % 8) * (G / 8) + bx / 8 : bx;
    unsigned char* ws = args.ws;
    gu32* ctl = (gu32*)(ws + WS_CTL);
    const float* xp = (const float*)args.in[0]; const float* xs = (const float*)args.in[1];
    const float* cache_k = (const float*)args.in[2]; const float* cache_v = (const float*)args.in[3]; const float* state0 = (const float*)args.in[4];
    const int* ptab = (const int*)args.in[5]; const float* norm_g = (const float*)args.in[6]; const float* w_in = (const float*)args.in[7];
    const float* qn_g = (const float*)args.in[8]; const float* kn_g = (const float*)args.in[9];
    const float* lq1 = (const float*)args.in[10]; const float* lk1 = (const float*)args.in[11]; const float* lq2 = (const float*)args.in[12]; const float* lk2 = (const float*)args.in[13];
    const float* subln_g = (const float*)args.in[14]; const float* lbl = (const float*)args.in[15]; const float* hgn_g = (const float*)args.in[16]; const float* w_out = (const float*)args.in[17];
    float* out = args.out;
    float* ROPE = (float*)(ws + WS_ROPE);
    bf16 *WinT = (bf16*)(ws + WS_WIN), *WoutT = (bf16*)(ws + WS_WOUT), *XN = (bf16*)(ws + WS_XN), *Qb = (bf16*)(ws + WS_Q), *Kb = (bf16*)(ws + WS_K), *Vb = (bf16*)(ws + WS_V),
         *AGb = (bf16*)(ws + WS_AG), *HQb = (bf16*)(ws + WS_HQ), *HIb = (bf16*)(ws + WS_HI), *HGb = (bf16*)(ws + WS_HG), *OA = (bf16*)(ws + WS_OA), *MIX = (bf16*)(ws + WS_MIX), *ST = (bf16*)(ws + WS_ST);
    float *LF = (float*)(ws + WS_LF), *GC = (float*)(ws + WS_GC); bf16* UT = (bf16*)(ws + WS_UT);


    for (int u = tid; u < (LDS_BYTES - LDSCTL_OFF) / 4; u += NWAVES * 64) ((LAS unsigned*)(L + LDSCTL_OFF))[u] = 0u;
    __syncthreads();
    XcdBarrier bar = xcd_barrier_post((unsigned*)(ctl + CW_BAR) + args.li * XCD_BAR_WORDS, MISC + 8);
    const int lo = args.ph_lo, hi = args.ph_hi;
#define IN(k) (lo <= (k) && (k) < hi)
#define BOTH(k) (IN(k) && IN((k) + 1))
#define GRID_BAR() xcd_barrier(bar)

    if (IN(0)) {
        LAS float* scr = (LAS float*)(L + RING_OFF + wave * 16384);
        const int gw = vcu * NWAVES + wave, NGW = G * NWAVES;
        constexpr int I_IN = (1024 / 64) * (DIN / 32), I_OUT = (1024 / 64) * (1024 / 32);
        for (int it = gw; it < I_IN + I_OUT; it += NGW) {
            if (it < I_IN) p0_transpose_item<true>(w_in, 1024, DIN, WinT, scr, it, lane);
            else p0_transpose_item<false>(w_out, 1024, 1024, WoutT, scr, it - I_IN, lane);
        }
        for (int m = gw; m < MT; m += 4 * NGW) rms_rows4_to_bf16(xp, xs, norm_g, XN, m, NGW, lane);
        for (int e = bx * (NWAVES * 64) + tid; e < 8192 * 8; e += G * NWAVES * 64) rope_entry(e >> 3, e & 7, ROPE);
        if (BOTH(0)) GRID_BAR();
    }
    if (IN(1)) {
        pg8::Gemm g{XN, WinT, MT, DIN, 1024};
        pg8::EpiProj E{Qb, Kb, Vb, AGb, HQb, HIb, HGb, LF, out + O_KP, out + O_KS, out + O_VP, out + O_VS, qn_g, kn_g, lbl, ROPE};
        const bool split = (G == 256) && BOTH(1);
        { const pg8::P1Order S{G, bx, 0, split ? 4 : (1 << 20)};
          pg8::gemm_phase<pg8::EpiProj, pg8::P1Order, true, true>(L + RING_OFF, g, S, E); }
        if (BOTH(1)) GRID_BAR();
        if (split && bx < 64) { const pg8::P1Order S{G, bx, 4, 1};
          pg8::gemm_phase<pg8::EpiProj, pg8::P1Order, true, true>(L + RING_OFF, g, S, E); }
    }
    if (IN(2)) {
        int a0 = vcu, as = G, ae = 1024, s0 = vcu, ss = G, se = 512;
        if (G == 256) {
            if (bx < 64) { a0 = 1024; s0 = 448 + bx; ss = 64; }
            else if (bx < 192) { a0 = bx - 64; as = 128; ae = 768; s0 = bx - 64; ss = 128; se = 256; }
            else { a0 = 768 + (bx - 192); as = 64; s0 = 256 + (bx - 192); ss = 64; se = 448; }
        }
        hgrn_a_phase(L + RING_OFF, a0, as, ae, LF, HIb, UT, GC, tid, lane, wave);
        hgrn_s_phase2(L + RING_OFF, s0, ss, se, LF, HQb, HIb, HGb, state0, hgn_g, out + O_SS, MIX, tid, lane, wave);

        if (BOTH(2)) GRID_BAR();
    }
    if (IN(3)) {
        hgrn_scan(UT, GC, ST, out + O_SP, bx * (NWAVES * 64) + tid, G * NWAVES * 64);
        __syncthreads();
        if (G == 256) {
            const int dgrp = (vcu >> 2) & 3;
            const int nbefore = dgrp < 2 ? 0 : 2;
            const attn128::StaticOrder S(G, bx); attn128::AttnUnit u;
#define ATTN_UNIT_(i) do { S.next((dgrp == 2) ? 1 - (i) : (i), u); attn128::attn_unit<8>(u.bh / attn128::NHEAD, u.bh % attn128::NHEAD, u.qb, (const attn128::bf16*)Qb, (const attn128::bf16*)Kb, (const attn128::bf16*)Vb, (attn128::bf16*)OA, (char*)lds + RING_OFF); } while (0)
            for (int i = 0; i < nbefore; ++i) ATTN_UNIT_(i);
            { int jv = vcu; asm volatile("" : "+s"(jv));
              for (int j = jv; j < 256; j += G) dec_item(L + RING_OFF, j >> 1, j & 1, cache_k, cache_v, ptab, Qb, Kb, Vb, AGb, subln_g, lq1, lk1, lq2, lk2, MIX, tid, lane, wave); }
            int i2 = nbefore; asm volatile("" : "+s"(i2));
            for (int i = i2; i < 2; ++i) ATTN_UNIT_(i);
#undef ATTN_UNIT_
        }
        if (BOTH(3)) GRID_BAR();
    }
    if (IN(4)) {
        if (G == 256 && vcu < 16) {
            pg8::Gemm g{MIX, WoutT, MT, 1024, 1024}; const pg8::OneUnit S1{64 + (vcu >> 2), vcu & 3};
            pg8::EpiOut E{xp, xs, out + O_YP};
            pg8::gemm_phase<pg8::EpiOut, pg8::OneUnit, true, true>(L + RING_OFF, g, S1, E);
            __syncthreads();
        } else if (G == 256) hgrn_c_phase(L + RING_OFF, vcu - 16, G - 16, LF, HQb, HIb, HGb, ST, hgn_g, MIX, tid, lane, wave);
        else hgrn_c_phase(L + RING_OFF, vcu, G, LF, HQb, HIb, HGb, ST, hgn_g, MIX, tid, lane, wave);
        { const float lam = lam_value(lq1, lk1, lq2, lk2, lane);
          for (int m = vcu * NWAVES + wave; m < MP; m += 8 * G * NWAVES) attn_merge_rowsN<8>(OA, AGb, subln_g, lam, MIX, m, G * NWAVES, lane); }
        if (BOTH(4)) GRID_BAR();
    }
    if (IN(5)) {
        const int mrows = (G == 256) ? MP : MT;
        pg8::Gemm g{MIX, WoutT, mrows, 1024, 1024}; pg8::StaticOrder S; S.init(mrows, 1024, G, bx);
        pg8::EpiOut E{xp, xs, out + O_YP};
        pg8::gemm_phase<pg8::EpiOut, pg8::StaticOrder, true, true>(L + RING_OFF, g, S, E);
    }
#undef IN
#undef BOTH
#undef GRID_BAR
}

static int mk_grid() {
    static int grid = 0;
    if (grid == 0) {
        int dev = 0, cus = 0, per_cu = 0;
        if (hipGetDevice(&dev) != hipSuccess || hipDeviceGetAttribute(&cus, hipDeviceAttributeMultiprocessorCount, dev) != hipSuccess) { grid = -1; return grid; }
        if (hipFuncSetAttribute((const void*)mk_fwd, hipFuncAttributeMaxDynamicSharedMemorySize, LDS_BYTES) != hipSuccess) { grid = -1; return grid; }
        if (hipOccupancyMaxActiveBlocksPerMultiprocessor(&per_cu, (const void*)mk_fwd, NWAVES * 64, LDS_BYTES) != hipSuccess || per_cu < 1) { (void)hipGetLastError(); fprintf(stderr, "mk: occupancy query says %d\n", per_cu); }
        grid = cus;
        if (grid != 256) fprintf(stderr, "mk: %d CUs; this kernel's unit orders are built for 256\n", grid);
    }
    return grid;
}
static void mk_launch(void* const* d_in, float* out, void* d_ws, hipStream_t stream, int lo, int hi, int li) {
    const int grid = mk_grid(); if (grid <= 0) return;
    Args a{}; for (int i = 0; i < 18; ++i) a.in[i] = d_in[i];
    a.out = out; a.ws = (unsigned char*)d_ws; a.ph_lo = lo; a.ph_hi = hi; a.li = li; a.pad = 0;
    hipLaunchKernelGGL(mk_fwd, dim3(grid), dim3(NWAVES * 64), LDS_BYTES, stream, a);
}
extern "C" void kernel_launch(void* const* d_in, const int* in_sizes, int n_in, void* d_out, int out_size, void* d_ws, size_t ws_size, hipStream_t stream) {
    if (hipMemsetAsync((char*)d_ws + WS_CTL, 0, CTL_ZERO_BYTES, stream) != hipSuccess) return;
    mk_launch(d_in, (float*)d_out, d_ws, stream, 0, 6, 0);
}
```
